# Optimizing an MI355X kernel written in HIP

```python
import jax
import jax.numpy as jnp
from jax import lax
import numpy as np

D_MODEL = 1024
BATCH = 16
SEQ = 2048
DEPTH = 2

GRID_W = 64
CTX_LEN = 256
HEAD_DIM = 64
N_BRANCH = 4
BRANCH_W = 256
MLA_HEADS = 4
MLA_NOPE = 64
MLA_ROPE = 32
MLA_V = 64
MLA_Q_RANK = 256
MLA_KV_RANK = 256
ML_HEADS = 4
ML_HEAD_DIM = 64
ML_CHUNK = 128
WG_HEADS = 4
WG_KV_HEADS = 2
WINDOW = 128
Q_BLOCK = 128
FN_GROUPS = 4
FN_GROUP_W = 64
D_FF = 2816
ROPE_BASE = 10000.0
EPS = 1e-6
IN_SPLITS = (MLA_Q_RANK, MLA_KV_RANK, MLA_ROPE,
             ML_HEADS * ML_HEAD_DIM, ML_HEADS * ML_HEAD_DIM, ML_HEADS * ML_HEAD_DIM, ML_HEADS * ML_HEAD_DIM, 4 * ML_HEADS,
             WG_HEADS * HEAD_DIM, WG_KV_HEADS * HEAD_DIM, WG_KV_HEADS * HEAD_DIM,
             FN_GROUPS * FN_GROUP_W)
D_IN = sum(IN_SPLITS)

kernel_name = "hybrid_dit_mla_mlstm_swa_fnet"


def rmsnorm(x, g):
    x32 = x.astype(jnp.float32)
    y = x32 * lax.rsqrt(jnp.mean(x32 * x32, axis=-1, keepdims=True) + EPS)
    return (y * g.astype(jnp.float32)).astype(x.dtype)


def split_cols(u, sizes):
    idx = [int(i) for i in np.cumsum(sizes)[:-1]]
    return jnp.split(u, idx, axis=-1)


def to_heads(u, n_heads):
    b, n, _ = u.shape
    return u.reshape(b, n, n_heads, -1).transpose(0, 2, 1, 3)


def from_heads(y):
    b, h, n, d = y.shape
    return y.transpose(0, 2, 1, 3).reshape(b, n, h * d)


def axial_rope(x, row, col):
    d = x.shape[-1]
    half = d // 2
    nf = half // 2
    inv = ROPE_BASE ** (-jnp.arange(nf, dtype=jnp.float32) / nf)
    ang_r = row.astype(jnp.float32)[:, None] * inv
    ang_c = col.astype(jnp.float32)[:, None] * inv

    def rot(xh, ang):
        x1, x2 = xh[..., :nf], xh[..., nf:]
        cos, sin = jnp.cos(ang), jnp.sin(ang)
        return jnp.concatenate([x1 * cos - x2 * sin, x1 * sin + x2 * cos], axis=-1)

    x32 = x.astype(jnp.float32)
    out = jnp.concatenate([rot(x32[..., :half], ang_r), rot(x32[..., half:], ang_c)], axis=-1)
    return out.astype(x.dtype)


def dwconv3(x, w):
    xp = jnp.pad(x, ((0, 0), (1, 1), (0, 0)))
    return xp[:, :-2] * w[0] + xp[:, 1:-1] * w[1] + xp[:, 2:] * w[2]


def softmax_attend(q, k, v, scale):
    s = jnp.einsum('bhqd,bhkd->bhqk', q, k).astype(jnp.float32) * scale
    p = jax.nn.softmax(s, axis=-1).astype(v.dtype)
    return jnp.einsum('bhqk,bhkd->bhqd', p, v)


def blocked_dense_attend(q, k, v, scale):
    b, h, n, d = q.shape
    nb = n // Q_BLOCK
    qb = q.reshape(b, h, nb, Q_BLOCK, d).transpose(2, 0, 1, 3, 4)
    out = lax.map(lambda qi: softmax_attend(qi, k, v, scale), qb)
    return out.transpose(1, 2, 0, 3, 4).reshape(b, h, n, -1)


def window_attend(q, k, v, kc, vc, sink):
    b, hq, n, d = q.shape
    hkv = k.shape[1]
    g = hq // hkv
    nb = n // Q_BLOCK
    scale = d ** -0.5
    qb = q.reshape(b, hkv, g, nb, Q_BLOCK, d)

    def band(t):
        tp = jnp.pad(t, ((0, 0), (0, 0), (WINDOW, WINDOW), (0, 0))).reshape(b, hkv, nb + 2, Q_BLOCK, d)
        return jnp.concatenate([tp[:, :, :-2], tp[:, :, 1:-1], tp[:, :, 2:]], axis=3)

    kb, vb = band(k), band(v)
    blk = jnp.arange(nb)[:, None, None]
    qpos = blk * Q_BLOCK + jnp.arange(Q_BLOCK)[None, :, None]
    kpos = blk * Q_BLOCK - WINDOW + jnp.arange(3 * Q_BLOCK)[None, None, :]
    valid = (jnp.abs(kpos - qpos) <= WINDOW) & (kpos >= 0) & (kpos < n)
    s_loc = jnp.einsum('bhgnqd,bhnkd->bhgnqk', qb, kb).astype(jnp.float32) * scale
    s_loc = jnp.where(valid, s_loc, -jnp.inf)
    s_ctx = jnp.einsum('bhgnqd,bhcd->bhgnqc', qb, kc).astype(jnp.float32) * scale
    c_len = kc.shape[2]
    s_sink = jnp.broadcast_to(sink.astype(jnp.float32).reshape(1, hkv, g, 1, 1, 1), (b, hkv, g, nb, Q_BLOCK, 1))
    p = jax.nn.softmax(jnp.concatenate([s_sink, s_ctx, s_loc], axis=-1), axis=-1).astype(v.dtype)
    out = (jnp.einsum('bhgnqc,bhcd->bhgnqd', p[..., 1:1 + c_len], vc)
           + jnp.einsum('bhgnqk,bhnkd->bhgnqd', p[..., 1 + c_len:], vb))
    return out.reshape(b, hq, n, d)


def ctx_sink_attend(q, kc, vc, sink):
    b, hq, c_len, d = q.shape
    hkv = kc.shape[1]
    g = hq // hkv
    qg = q.reshape(b, hkv, g, c_len, d)
    s = jnp.einsum('bhgqd,bhkd->bhgqk', qg, kc).astype(jnp.float32) * d ** -0.5
    s_sink = jnp.broadcast_to(sink.astype(jnp.float32).reshape(1, hkv, g, 1, 1), (b, hkv, g, c_len, 1))
    p = jax.nn.softmax(jnp.concatenate([s_sink, s], axis=-1), axis=-1)[..., 1:].astype(vc.dtype)
    return jnp.einsum('bhgqk,bhkd->bhgqd', p, vc).reshape(b, hq, c_len, d)


def mla_q(cq, g_qa, w_uq, pos):
    q = to_heads(rmsnorm(cq, g_qa) @ w_uq, MLA_HEADS)
    if pos is not None:
        q = jnp.concatenate([q[..., :MLA_NOPE], axial_rope(q[..., MLA_NOPE:], *pos)], axis=-1)
    return q


def mla_kv(ckv, kr, g_kva, w_ukv, pos):
    kv = to_heads(rmsnorm(ckv, g_kva) @ w_ukv, MLA_HEADS)
    k_nope, v = kv[..., :MLA_NOPE], kv[..., MLA_NOPE:]
    kr = kr[:, None]
    if pos is not None:
        kr = axial_rope(kr, *pos)
    k = jnp.concatenate([k_nope, jnp.broadcast_to(kr, k_nope.shape[:3] + (MLA_ROPE,))], axis=-1)
    return k, v


def mlstm_scan(q, k, v, log_i, log_f, state):
    bsz, nh, n, d = q.shape
    nc = n // ML_CHUNK

    def chunks(t):
        t = t.astype(jnp.float32)
        return jnp.moveaxis(t.reshape(t.shape[:2] + (nc, ML_CHUNK) + t.shape[3:]), 2, 0)

    tril = jnp.tril(jnp.ones((ML_CHUNK, ML_CHUNK), dtype=bool))

    def step(carry, xs):
        c_st, n_st, m_st = carry
        qc, kc, vc, li, lf = xs
        cum = jnp.cumsum(lf, axis=-1)
        log_d = jnp.where(tril, cum[..., :, None] - cum[..., None, :] + li[..., None, :], -jnp.inf)
        log_inter = cum + m_st[..., None]
        m_t = jnp.maximum(log_inter, jnp.max(log_d, axis=-1))
        w_intra = jnp.exp(log_d - m_t[..., None])
        w_inter = jnp.exp(log_inter - m_t)
        s = jnp.einsum('bhtd,bhsd->bhts', qc, kc) * w_intra
        num = jnp.einsum('bhts,bhse->bhte', s, vc) + w_inter[..., None] * jnp.einsum('bhtd,bhde->bhte', qc, c_st)
        den = jnp.sum(s, axis=-1) + w_inter * jnp.einsum('bhtd,bhd->bht', qc, n_st)
        h = num / jnp.maximum(jnp.abs(den), jnp.exp(-m_t))[..., None]
        c_last = cum[..., -1]
        log_w = c_last[..., None] - cum + li
        m_new = jnp.maximum(c_last + m_st, jnp.max(log_w, axis=-1))
        w = jnp.exp(log_w - m_new[..., None])
        decay = jnp.exp(c_last + m_st - m_new)
        c_new = decay[..., None, None] * c_st + jnp.einsum('bhs,bhsd,bhse->bhde', w, kc, vc)
        n_new = decay[..., None] * n_st + jnp.einsum('bhs,bhsd->bhd', w, kc)
        return (c_new, n_new, m_new), h

    xs = (chunks(q), chunks(k), chunks(v), chunks(log_i), chunks(log_f))
    state, h = lax.scan(step, state, xs)
    return jnp.moveaxis(h, 0, 2).reshape(bsz, nh, n, d).astype(q.dtype), state


def mlstm_prep(uq, uk, uv, ug, w_conv, b_gates):
    qk = jax.nn.silu(dwconv3(jnp.concatenate([uq, uk], axis=-1), w_conv))
    q, k = jnp.split(qk, 2, axis=-1)
    q = to_heads(q, ML_HEADS)
    k = to_heads(k, ML_HEADS) * ML_HEAD_DIM ** -0.5
    v = to_heads(uv, ML_HEADS)
    bsz, n, _ = ug.shape
    gt = (ug.astype(jnp.float32) + b_gates.astype(jnp.float32)).reshape(bsz, n, 4, ML_HEADS).transpose(2, 0, 3, 1)
    return q, k, v, gt[0], jax.nn.log_sigmoid(gt[1]), gt[2], jax.nn.log_sigmoid(gt[3])


def mlstm_branch(lat, ctx, w_conv, b_gates, ctx_out):
    uq, uk, uv, uo, ug = lat
    cq, ck, cv, co, cg = ctx
    q, k, v, i_f, f_f, i_b, f_b = mlstm_prep(uq, uk, uv, ug, w_conv, b_gates)
    qc, kc, vc, ic_f, fc_f, ic_b, fc_b = mlstm_prep(cq, ck, cv, cg, w_conv, b_gates)
    bsz = q.shape[0]
    zero = (jnp.zeros((bsz, ML_HEADS, ML_HEAD_DIM, ML_HEAD_DIM), jnp.float32),
            jnp.zeros((bsz, ML_HEADS, ML_HEAD_DIM), jnp.float32),
            jnp.zeros((bsz, ML_HEADS), jnp.float32))
    flip = lambda t: jnp.flip(t, axis=2)
    hc_f, st_f = mlstm_scan(qc, kc, vc, ic_f, fc_f, zero)
    h_f, _ = mlstm_scan(q, k, v, i_f, f_f, st_f)
    hc_b, st_b = mlstm_scan(flip(qc), flip(kc), flip(vc), flip(ic_b), flip(fc_b), zero)
    h_b, _ = mlstm_scan(flip(q), flip(k), flip(v), flip(i_b), flip(f_b), st_b)
    y = jax.nn.sigmoid(uo) * from_heads(h_f + flip(h_b))
    if not ctx_out:
        return y, None
    yc = jax.nn.sigmoid(co) * from_heads(hc_f + flip(hc_b))
    return y, yc


def fourier_mix(u):
    bsz, n, _ = u.shape
    z = jnp.fft.fftn(u.astype(jnp.float32).reshape(bsz, n, FN_GROUPS, FN_GROUP_W), axes=(1, 3), norm="ortho")
    return jnp.real(z).reshape(bsz, n, FN_GROUPS * FN_GROUP_W).astype(u.dtype)


def merge(h, ys, w_gate, b_gate, w_branch, w_out):
    acc = jax.nn.sigmoid(h @ w_gate[0] + b_gate[0]) * (ys[0] @ w_branch[0])
    for s in range(1, N_BRANCH):
        acc = acc + jax.nn.sigmoid(h @ w_gate[s] + b_gate[s]) * (ys[s] @ w_branch[s])
    return acc @ w_out


def token_mixer(h, hc, lp, row, col, ctx_out):
    u = split_cols(h @ lp["w_in"], IN_SPLITS)
    uc = split_cols(hc @ lp["w_in"], IN_SPLITS)
    pos = (row, col)
    scale_a = (MLA_NOPE + MLA_ROPE) ** -0.5
    qa = mla_q(u[0], lp["g_qa"], lp["w_uq"], pos)
    ka, va = mla_kv(u[1], u[2], lp["g_kva"], lp["w_ukv"], pos)
    kca, vca = mla_kv(uc[1], uc[2], lp["g_kva"], lp["w_ukv"], None)
    ya = from_heads(blocked_dense_attend(qa, jnp.concatenate([kca, ka], axis=2),
                                         jnp.concatenate([vca, va], axis=2), scale_a))
    yb, ybc = mlstm_branch(tuple(u[3:8]), tuple(uc[3:8]), lp["w_ml_conv"], lp["b_ml_gates"], ctx_out)
    qw = axial_rope(to_heads(u[8], WG_HEADS), row, col)
    kw = axial_rope(to_heads(u[9], WG_KV_HEADS), row, col)
    vw = to_heads(u[10], WG_KV_HEADS)
    kcw, vcw = to_heads(uc[9], WG_KV_HEADS), to_heads(uc[10], WG_KV_HEADS)
    yc = from_heads(window_attend(qw, kw, vw, kcw, vcw, lp["wg_sink"]))
    yd = fourier_mix(u[11])
    y = merge(h, [ya, yb, yc, yd], lp["w_gate"], lp["b_gate"], lp["w_branch"], lp["w_out"])
    if not ctx_out:
        return y, None
    yca = from_heads(softmax_attend(mla_q(uc[0], lp["g_qa"], lp["w_uq"], None), kca, vca, scale_a))
    ycc = from_heads(ctx_sink_attend(to_heads(uc[8], WG_HEADS), kcw, vcw, lp["wg_sink"]))
    ycd = fourier_mix(uc[11])
    y_ctx = merge(hc, [yca, ybc, ycc, ycd], lp["w_gate"], lp["b_gate"], lp["w_branch"], lp["w_out"])
    return y, y_ctx


def conv_ffn(h, w_up, w_conv, b_conv, w_down):
    a, v = jnp.split(h @ w_up, 2, axis=-1)
    a = dwconv3(a, w_conv) + b_conv
    return (jax.nn.silu(a) * v) @ w_down


def setup_inputs(seed: int = 0) -> dict:
    key = jax.random.key(seed)
    ks = jax.random.split(key, 32)
    f32 = jnp.float32
    L, D = DEPTH, D_MODEL

    def nrm(k, shape, scale=1.0):
        return jax.random.normal(k, shape, f32) * scale

    def gain(k, shape):
        return 1.0 + nrm(k, shape, 0.05)

    f_bias = jnp.linspace(3.0, 6.0, ML_HEADS, dtype=f32)
    b_ml_gates = jnp.concatenate([
        nrm(ks[14], (L, ML_HEADS), 0.1),
        f_bias + nrm(ks[15], (L, ML_HEADS), 0.1),
        nrm(ks[16], (L, ML_HEADS), 0.1),
        f_bias + nrm(ks[17], (L, ML_HEADS), 0.1)], axis=-1)
    return {
        "x": nrm(ks[0], (BATCH, SEQ, D)),
        "c": nrm(ks[1], (BATCH, D)),
        "ctx": nrm(ks[2], (BATCH, CTX_LEN, D)),
        "c_ctx": nrm(ks[3], (D,)),
        "w_mod": nrm(ks[4], (L, D, 6 * D), 0.5 * D ** -0.5),
        "b_mod": nrm(ks[5], (L, 6 * D), 0.02),
        "g_pre_mix": gain(ks[6], (L, D)),
        "g_post_mix": gain(ks[7], (L, D)),
        "g_pre_ffn": gain(ks[8], (L, D)),
        "g_post_ffn": gain(ks[9], (L, D)),
        "w_in": nrm(ks[10], (L, D, D_IN), D ** -0.5),
        "g_qa": gain(ks[11], (L, MLA_Q_RANK)),
        "w_uq": nrm(ks[12], (L, MLA_Q_RANK, MLA_HEADS * (MLA_NOPE + MLA_ROPE)), MLA_Q_RANK ** -0.5),
        "g_kva": gain(ks[13], (L, MLA_KV_RANK)),
        "w_ukv": nrm(ks[18], (L, MLA_KV_RANK, MLA_HEADS * (MLA_NOPE + MLA_V)), MLA_KV_RANK ** -0.5),
        "w_ml_conv": nrm(ks[19], (L, 3, 2 * ML_HEADS * ML_HEAD_DIM), 3 ** -0.5),
        "b_ml_gates": b_ml_gates,
        "wg_sink": nrm(ks[20], (L, WG_HEADS), 0.5),
        "w_gate": nrm(ks[21], (L, N_BRANCH, D, D), D ** -0.5),
        "b_gate": nrm(ks[22], (L, N_BRANCH, D), 0.02),
        "w_branch": nrm(ks[23], (L, N_BRANCH, BRANCH_W, D), BRANCH_W ** -0.5),
        "w_out": nrm(ks[24], (L, D, D), D ** -0.5),
        "w_up": nrm(ks[25], (L, D, 2 * D_FF), D ** -0.5),
        "w_ffn_conv": nrm(ks[26], (L, 3, D_FF), 3 ** -0.5),
        "b_ffn_conv": nrm(ks[27], (L, D_FF), 0.02),
        "w_down": nrm(ks[28], (L, D_FF, D), D_FF ** -0.5),
    }


def reference(x, c, ctx, c_ctx, w_mod, b_mod, g_pre_mix, g_post_mix, g_pre_ffn, g_post_ffn,
              w_in, g_qa, w_uq, g_kva, w_ukv, w_ml_conv, b_ml_gates, wg_sink,
              w_gate, b_gate, w_branch, w_out, w_up, w_ffn_conv, b_ffn_conv, w_down):
    n = x.shape[1]
    rows = n // GRID_W
    row = jnp.repeat(jnp.arange(rows, dtype=jnp.int32), GRID_W)
    col = jnp.tile(jnp.arange(GRID_W, dtype=jnp.int32), rows)
    xc = ctx
    for l in range(DEPTH):
        ctx_out = l < DEPTH - 1
        mod = jax.nn.silu(c) @ w_mod[l] + b_mod[l]
        mod_c = jax.nn.silu(c_ctx) @ w_mod[l] + b_mod[l]
        sh1, sc1, g1, sh2, sc2, g2 = jnp.split(mod[:, None, :], 6, axis=-1)
        shc1, scc1, gc1, shc2, scc2, gc2 = jnp.split(mod_c, 6, axis=-1)
        lp = {"w_in": w_in[l], "g_qa": g_qa[l], "w_uq": w_uq[l], "g_kva": g_kva[l], "w_ukv": w_ukv[l],
              "w_ml_conv": w_ml_conv[l], "b_ml_gates": b_ml_gates[l], "wg_sink": wg_sink[l],
              "w_gate": w_gate[l], "b_gate": b_gate[l], "w_branch": w_branch[l], "w_out": w_out[l]}
        h = rmsnorm(x, g_pre_mix[l]) * (1 + sc1) + sh1
        hc = rmsnorm(xc, g_pre_mix[l]) * (1 + scc1) + shc1
        y, y_ctx = token_mixer(h, hc, lp, row, col, ctx_out)
        x = x + g1 * rmsnorm(y, g_post_mix[l])
        h2 = rmsnorm(x, g_pre_ffn[l]) * (1 + sc2) + sh2
        x = x + g2 * rmsnorm(conv_ffn(h2, w_up[l], w_ffn_conv[l], b_ffn_conv[l], w_down[l]), g_post_ffn[l])
        if ctx_out:
            xc = xc + gc1 * rmsnorm(y_ctx, g_post_mix[l])
            hc2 = rmsnorm(xc, g_pre_ffn[l]) * (1 + scc2) + shc2
            xc = xc + gc2 * rmsnorm(conv_ffn(hc2, w_up[l], w_ffn_conv[l], b_ffn_conv[l], w_down[l]), g_post_ffn[l])
    return x
```

```cpp
#include <hip/hip_runtime.h>
#include <cstdio>
#include <cstdint>

#ifndef PROBE_DUP_SITES
#define PROBE_DUP_SITES 0
#endif
#ifndef WIN_I8_MASK
#define WIN_I8_MASK 2
#endif
__host__ __device__ constexpr bool win8(int l) { return ((WIN_I8_MASK >> l) & 1) != 0; }
#ifndef MK_SINGLE_LAUNCH
#define MK_SINGLE_LAUNCH 1
#endif

#define LAS __attribute__((address_space(3)))
#define GAS __attribute__((address_space(1)))
typedef unsigned short bf16_t;
typedef short bf16x8 __attribute__((ext_vector_type(8)));
typedef float f32x4 __attribute__((ext_vector_type(4)));
typedef float f32x2 __attribute__((ext_vector_type(2)));
typedef unsigned u32x4 __attribute__((ext_vector_type(4)));
typedef unsigned u32x2 __attribute__((ext_vector_type(2)));

constexpr int D = 1024, NB = 16, SEQ = 2048, CTX = 256, DEPTH = 2, DFF = 2816;
constexpr int NIN_SRC = 2352, NIN = 2560;
constexpr int RL = NB * SEQ, RC = NB * CTX, R = RL + RC;
constexpr int TL = RL / 256, TC = RC / 256, TR = R / 256;
constexpr float EPS = 1e-6f;
constexpr float LOG2E = 1.4426950408889634f;
constexpr float QS_M = 0.10206207261596575f * LOG2E;
constexpr float QS_G = 0.125f * LOG2E;
constexpr int NTHR = 512;

constexpr size_t MiB = 1u << 20;
constexpr size_t WS_CTL = 0, CTL_BYTES = 2 * MiB;
constexpr size_t WS_MOD = 2 * MiB;
constexpr size_t WS_TAB = 3 * MiB;
constexpr size_t WS_HS = WS_TAB + 128 * 1024, WS_H2S = WS_TAB + 320 * 1024;
constexpr size_t WS_WSCG = WS_TAB + 512 * 1024, WS_WSCU = WS_TAB + 576 * 1024, WS_WSCW = WS_TAB + 640 * 1024;
constexpr size_t WS_XC = 4 * MiB;
constexpr size_t WS_W = 20 * MiB, W_LAYER = 35 * MiB;
constexpr size_t W_IN = 0, W_UQ = 5632 * 1024, W_UKV = W_UQ + 256 * 1024, W_G = 6 * MiB, W_B = 14 * MiB, W_OUT = 16 * MiB, W_UP = 18 * MiB, W_DOWN = 29 * MiB;
constexpr size_t WS_CS = 94 * MiB;
constexpr size_t WS_H8A = WS_W + W_LAYER;
constexpr size_t WS_H8B = WS_W;
constexpr size_t WS_FTMP = 98 * MiB;
constexpr size_t WS_CSC = 106 * MiB;
constexpr size_t WS_H = 107 * MiB;
constexpr size_t WS_H2 = WS_H;
constexpr size_t WS_Y = 179 * MiB;
constexpr size_t WS_SCR = 251 * MiB;
static_assert(WS_H8A + (size_t)R * 1024 <= WS_CS && WS_H8B + (size_t)RL * 1024 <= WS_W + W_LAYER && WS_CS + 4 * MiB <= WS_FTMP && WS_FTMP + 2 * MiB <= WS_CSC && WS_H + (size_t)R * 2048 <= WS_Y, "map");
constexpr size_t WS_CQ = WS_Y, WS_CKV = WS_Y + 18 * MiB, WS_FAB = WS_Y + 36 * MiB;
constexpr size_t WS_SSP = WS_SCR, WS_MQK = WS_SCR + 2 * MiB, WS_MV = WS_SCR + 38 * MiB, WS_MO = WS_SCR + 56 * MiB, WS_MG = WS_SCR + 74 * MiB,
                 WS_GQ = WS_SCR + 77 * MiB, WS_GK = WS_SCR + 95 * MiB, WS_GV = WS_SCR + 104 * MiB, WS_FABT = WS_SCR + 113 * MiB,
                 WS_Q96 = WS_SCR + 149 * MiB, WS_K96 = WS_SCR + 176 * MiB, WS_V = WS_SCR + 203 * MiB, WS_HF = WS_SCR + 221 * MiB,
                 WS_KVL = WS_SCR + 221 * MiB  , WS_CT = WS_SCR + 239 * MiB  ,
                 WS_EDQ = WS_CTL + 768 * 1024  ,
                 WS_NL = WS_SCR + 257 * MiB  , WS_NS = WS_NL + MiB  , WS_SCL = WS_NS + MiB  , WS_MS = WS_SCL + 64 * 1024  ;
constexpr size_t WS_BV = WS_SCR, WS_ACC = WS_SCR + 128 * MiB, WS_YO = WS_SCR;
constexpr size_t WS_G = WS_Y, WS_EDGE = WS_SCR + 128 * MiB  , WS_F = WS_SCR + 140 * MiB;
constexpr size_t WS_END = WS_SCR + 260 * MiB;
static_assert(WS_G + (size_t)R * DFF * 2 <= WS_EDGE, "G vs EDGE");
static_assert(WS_EDGE + (size_t)TR * 22 * 6 * 128 * 4 <= WS_F && WS_F + (size_t)R * 1024 * 2 <= WS_END, "EDGE / F");
static_assert(WS_MS + 128 * 18 * 4 <= WS_END && WS_EDQ + (size_t)TR * 2 * 4 * 256 * 4 <= WS_CTL + CTL_BYTES && (size_t)(1024 + 40 * 3456) * 4 <= WS_EDQ, "mlstm scan buffers / EDQ (barrier words: u32 index 1024 + 3456 per launch region)");

constexpr int CW_BAR = 1024;

constexpr int LDS_BYTES = 160 * 1024;
constexpr int RING_BYTES = 131072;
constexpr int MISC_OFF = LDS_BYTES - 256;

__device__ __forceinline__ float bf2f(bf16_t v) { return __uint_as_float((unsigned)v << 16); }
__device__ __forceinline__ unsigned f2bf(float f) { unsigned u = __float_as_uint(f); return (u + 0x7fffu + ((u >> 16) & 1u)) >> 16; }
__device__ __forceinline__ unsigned pk2(float lo, float hi) { return f2bf(lo) | (f2bf(hi) << 16); }
__device__ __forceinline__ float lo_bf(unsigned w) { return __uint_as_float(w << 16); }
__device__ __forceinline__ float hi_bf(unsigned w) { return __uint_as_float(w & 0xffff0000u); }
__device__ __forceinline__ float fexp2(float x) { return __builtin_amdgcn_exp2f(x); }
__device__ __forceinline__ float fexp(float x) { return __builtin_amdgcn_exp2f(x * LOG2E); }
__device__ __forceinline__ float frcp(float x) { return __builtin_amdgcn_rcpf(x); }
__device__ __forceinline__ float sigmoidf_(float x) { return frcp(1.0f + fexp(-x)); }
__device__ __forceinline__ float siluf_(float x) { return x * frcp(1.0f + fexp(-x)); }
__device__ __forceinline__ unsigned cvt_pk_bf16(float lo, float hi) { unsigned r; asm("v_cvt_pk_bf16_f32 %0, %1, %2" : "=v"(r) : "v"(lo), "v"(hi)); return r; }
__device__ __forceinline__ float wave_sum(float v) {
#pragma unroll
    for (int o = 1; o < 64; o <<= 1) v += __shfl_xor(v, o);
    return v;
}
__device__ __forceinline__ unsigned pack4_i8(float a, float b, float c, float d) {
    const int ia = (int)rintf(a), ib = (int)rintf(b), ic = (int)rintf(c), id = (int)rintf(d);
    return (unsigned)(ia & 0xff) | ((unsigned)(ib & 0xff) << 8) | ((unsigned)(ic & 0xff) << 16) | ((unsigned)(id & 0xff) << 24);
}
__device__ __forceinline__ unsigned pack4_fp8(float a, float b, float c, float d) { int w = 0; w = __builtin_amdgcn_cvt_pk_fp8_f32(a, b, w, false); w = __builtin_amdgcn_cvt_pk_fp8_f32(c, d, w, true); return (unsigned)w; }
__device__ __forceinline__ void store8bf(bf16_t* p, f32x4 a, f32x4 b) { u32x4 w; w.x = cvt_pk_bf16(a[0], a[1]); w.y = cvt_pk_bf16(a[2], a[3]); w.z = cvt_pk_bf16(b[0], b[1]); w.w = cvt_pk_bf16(b[2], b[3]); *(u32x4*)p = w; }
__device__ __forceinline__ void store4bf(bf16_t* p, f32x4 v) { u32x2 w; w.x = cvt_pk_bf16(v[0], v[1]); w.y = cvt_pk_bf16(v[2], v[3]); *(u32x2*)p = w; }

#define XB_TMO      128
#define XB_XCNT(j)  (256  + 64 * (j))
#define XB_XSUB(j)  (1280 + 64 * (j))
#define XB_XGEN(j)  (2304 + 64 * (j))
#define XB_TOP      3328
#define XB_TOPGEN   3392
#define XCD_BAR_WORDS 3456
#define XB_SPIN_CAP (1u << 21)

__device__ __forceinline__ unsigned xb_ld(unsigned* p)              { return __hip_atomic_load(p, __ATOMIC_RELAXED, __HIP_MEMORY_SCOPE_AGENT); }
__device__ __forceinline__ unsigned xb_add(unsigned* p, unsigned v) { return __hip_atomic_fetch_add(p, v, __ATOMIC_RELAXED, __HIP_MEMORY_SCOPE_AGENT); }
__device__ __forceinline__ unsigned xb_xcc_id() { return (unsigned)__builtin_amdgcn_s_getreg((3 << 11) | 20) & 0xFu; }
#define XB_SPIN(cond, bar) do { unsigned _sp = 0; while (cond) { __builtin_amdgcn_s_sleep(1); \
    if ((++_sp & 255u) == 0u) { if (xb_ld(&(bar)[XB_TMO])) break; if (_sp > XB_SPIN_CAP) { atomicAdd(&(bar)[XB_TMO], 1u); break; } } } } while (0)

struct XcdBarrier { unsigned* bar; unsigned x; volatile LAS unsigned* st; };

__device__ __forceinline__ XcdBarrier xcd_barrier_post(unsigned* bar, volatile LAS unsigned* st) {
    XcdBarrier b; b.bar = bar; b.x = xb_xcc_id(); b.st = st;
    if (threadIdx.x == 0) (void)xb_add(&bar[XB_XCNT(b.x)], 1u);
    return b;
}
__device__ __forceinline__ void xcd_barrier_complete(unsigned* bar, unsigned x, unsigned& nloc, unsigned& nx) {
    const unsigned G = gridDim.x * gridDim.y * gridDim.z;
    unsigned sum, cnt, mine, sp = 0u;
    for (;;) {
        sum = 0u; cnt = 0u; mine = 0u;
#pragma unroll
        for (unsigned j = 0; j < 16; ++j) { const unsigned c = xb_ld(&bar[XB_XCNT(j)]); sum += c; cnt += (c > 0u) ? 1u : 0u; mine = (j == x) ? c : mine; }
        if (sum == G) break;
        __builtin_amdgcn_s_sleep(1);
        if ((++sp & 255u) == 0u) { if (xb_ld(&bar[XB_TMO])) break; if (sp > XB_SPIN_CAP) { atomicAdd(&bar[XB_TMO], 1u); break; } }
    }
    nloc = mine > 0u ? mine : 1u; nx = cnt > 0u ? cnt : 1u;
}
__device__ __forceinline__ void xcd_barrier(const XcdBarrier& b) {
    asm volatile("s_waitcnt vmcnt(0)" ::: "memory");
    __syncthreads();
    if (threadIdx.x == 0) {
        unsigned* bar = b.bar;
        __builtin_amdgcn_s_waitcnt(0);
        unsigned nloc = b.st[0], nx = b.st[1];
        if (nloc == 0u) { xcd_barrier_complete(bar, b.x, nloc, nx); b.st[0] = nloc; b.st[1] = nx; }
        const unsigned old = xb_add(&bar[XB_XSUB(b.x)], 1u);
        const unsigned gen = old / nloc;
        if (old + 1u == (gen + 1u) * nloc) {
            __builtin_amdgcn_fence(__ATOMIC_RELEASE, "agent");
            asm volatile("s_waitcnt vmcnt(0)" ::: "memory");
            const unsigned og = xb_add(&bar[XB_TOP], 1u);
            const unsigned tg = og / nx;
            if (og + 1u == (tg + 1u) * nx) xb_add(&bar[XB_TOPGEN], 1u);
            else XB_SPIN(xb_ld(&bar[XB_TOPGEN]) == tg, bar);
            __builtin_amdgcn_fence(__ATOMIC_ACQUIRE, "agent");
            xb_add(&bar[XB_XGEN(b.x)], 1u);
            asm volatile("s_waitcnt vmcnt(0)" ::: "memory");
        } else {
            XB_SPIN(xb_ld(&bar[XB_XGEN(b.x)]) == gen, bar);
            __builtin_amdgcn_fence(__ATOMIC_ACQUIRE, "agent");
            asm volatile("s_waitcnt vmcnt(0)" ::: "memory");
        }
    }
    __syncthreads();
}

namespace pg8 {
constexpr int BM = 256, BK = 64, HALF = 128, HTB = HALF * BK * 2, STAGE_BYTES = 8 * HTB;
__host__ __device__ __forceinline__ int lds_byte(int r, int c) { const int st = (r >> 4) * 2 + (c >> 5), rr = r & 15, cc = c & 31, ob = rr * 64 + cc * 2; return st * 1024 + (ob ^ (((ob >> 9) & 1) << 5)); }
__host__ __device__ __forceinline__ void stage_rc(int b, int& Rr, int& C) { const int st = b / 1024, sb = b % 1024, swz = sb ^ (((sb >> 9) & 1) << 5); Rr = (st >> 1) * 16 + swz / 64; C = (st & 1) * 32 + (swz % 64) / 2; }

struct Unit { int pm, pn; const char* a; const char* b; int srow, scol; };

typedef int v4i32 __attribute__((ext_vector_type(4)));
template <class E> constexpr auto self_scale_of(int) -> decltype(E::SELF_SCALE) { return E::SELF_SCALE; }
template <class E> constexpr bool self_scale_of(long) { return false; }
template <class Epi, class Sched, int MODE = 0>
__device__ __forceinline__ void gemm_phase(LAS unsigned char* lds, const int K, const int lda, const int ldb, const Sched& S, const Epi& E, const float* rowscale = nullptr, const float* colscale = nullptr) {
    int tid = threadIdx.x; asm volatile("" : "+v"(tid));
    const int wid = __builtin_amdgcn_readfirstlane(tid >> 6), lane = tid & 63, wr = wid >> 2, wc = wid & 3, fr = lane & 15, fq = lane >> 4;
    int nt = K / BK; asm volatile("" : "+s"(nt));
    unsigned voffA[2], voffB[2];
#pragma unroll
    for (int i = 0; i < 2; ++i) { int Rr, C; stage_rc(tid * 16 + i * 8192, Rr, C); voffA[i] = (unsigned)(Rr * lda + C) * 2u; voffB[i] = (unsigned)(Rr * ldb + C) * 2u; }
    const size_t kstep = (size_t)(BK * 2);
    const size_t hstepA = (size_t)HALF * lda * 2, hstepB = (size_t)HALF * ldb * 2;
    const unsigned ldsw = (unsigned)wid * 1024u;
    const int aoff = lds_byte(wr * 64 + fr, fq * 8), boff = lds_byte(wc * 32 + fr, fq * 8);
#define PG8_SA(b, h) (((b) * 2 + (h)) * HTB)
#define PG8_SB(b, h) ((4 + (b) * 2 + (h)) * HTB)
#define PG8_STAGE(bufoff, gbase, voff) do { _Pragma("unroll") for (int _i = 0; _i < 2; ++_i) \
        __builtin_amdgcn_global_load_lds((const unsigned*)((const char*)(gbase) + (voff)[_i]), (LAS unsigned*)(lds + (bufoff) + ldsw + _i * 8192), 16, 0, 0); } while (0)
#define PG8_LDA(dst, b, h) do { _Pragma("unroll") for (int m = 0; m < 4; ++m) _Pragma("unroll") for (int k = 0; k < 2; ++k) dst[m][k] = *(const LAS bf16x8*)(lds + PG8_SA(b, h) + aoff + m * 2048 + k * 1024); } while (0)
#define PG8_LDB(dst, b, h) do { _Pragma("unroll") for (int n = 0; n < 2; ++n) _Pragma("unroll") for (int k = 0; k < 2; ++k) dst[n][k] = *(const LAS bf16x8*)(lds + PG8_SB(b, h) + boff + n * 2048 + k * 1024); } while (0)
#define PG8_MMA(ai, bj, At, Bt) do { __builtin_amdgcn_s_setprio(1); _Pragma("unroll") for (int m = 0; m < 4; ++m) _Pragma("unroll") for (int n = 0; n < 2; ++n) _Pragma("unroll") for (int k = 0; k < 2; ++k) { \
        if constexpr (MODE == 1) acc[ai][bj][m][n] = __builtin_bit_cast(f32x4, __builtin_amdgcn_mfma_i32_16x16x64_i8(__builtin_bit_cast(v4i32, Bt[n][k]), __builtin_bit_cast(v4i32, At[m][k]), __builtin_bit_cast(v4i32, acc[ai][bj][m][n]), 0, 0, 0)); \
        else acc[ai][bj][m][n] = __builtin_amdgcn_mfma_f32_16x16x32_bf16(Bt[n][k], At[m][k], acc[ai][bj][m][n], 0, 0, 0); } \
        __builtin_amdgcn_s_setprio(0); } while (0)
#define PG8_WAIT_V(n) asm volatile("s_waitcnt vmcnt(" #n ")" ::: "memory")
#define PG8_WAIT_L(n) asm volatile("s_waitcnt lgkmcnt(" #n ")" ::: "memory")
#define PG8_BAR __builtin_amdgcn_s_barrier()
#define PG8_SCHED __builtin_amdgcn_sched_barrier(0)
    Unit cur, nxt; int ui = 0;
    if (!S.next(0, cur)) return;
    f32x4 acc[2][2][4][2];
#pragma unroll
    for (int a = 0; a < 2; ++a)
#pragma unroll
        for (int b = 0; b < 2; ++b)
#pragma unroll
            for (int m = 0; m < 4; ++m)
#pragma unroll
                for (int n = 0; n < 2; ++n) acc[a][b][m][n] = (f32x4){0.f, 0.f, 0.f, 0.f};
    bf16x8 At[4][2], B0[2][2], B1[2][2];
    const char* cA = cur.a; const char* cB = cur.b;
    PG8_STAGE(PG8_SB(0, 0), cB, voffB); PG8_STAGE(PG8_SB(0, 1), cB + hstepB, voffB); PG8_STAGE(PG8_SA(0, 0), cA, voffA); PG8_STAGE(PG8_SA(0, 1), cA + hstepA, voffA);
    if (wr == 1) PG8_BAR;
    PG8_WAIT_V(2); PG8_BAR;
    PG8_STAGE(PG8_SB(1, 0), cB + kstep, voffB); PG8_STAGE(PG8_SA(1, 0), cA + kstep, voffA); PG8_STAGE(PG8_SB(1, 1), cB + hstepB + kstep, voffB);
    PG8_WAIT_V(6); PG8_BAR;
    for (;;) {
        const bool has_next = S.next(ui + 1, nxt);
        const char* nA = has_next ? nxt.a : cA; const char* nB = has_next ? nxt.b : cB;
        for (int t = 0; t < nt; t += 2) {
            const bool last = (t == nt - 2);
            const char* a1 = cA + (size_t)(t + 1) * kstep;
            const char* a2 = last ? nA : cA + (size_t)(t + 2) * kstep; const char* b2 = last ? nB : cB + (size_t)(t + 2) * kstep;
            const char* a3 = a2 + kstep; const char* b3 = b2 + kstep;
            PG8_LDB(B0, 0, 0); PG8_LDB(B1, 0, 1); PG8_SCHED; PG8_LDA(At, 0, 0); PG8_STAGE(PG8_SA(1, 1), a1 + hstepA, voffA);
            PG8_WAIT_V(8); PG8_WAIT_L(0); PG8_BAR; PG8_MMA(0, 0, At, B0); PG8_MMA(0, 1, At, B1); PG8_BAR; PG8_SCHED;
            PG8_LDA(At, 0, 1); PG8_STAGE(PG8_SB(0, 0), b2, voffB); PG8_STAGE(PG8_SB(0, 1), b2 + hstepB, voffB); PG8_STAGE(PG8_SA(0, 0), a2, voffA);
            PG8_WAIT_V(8); PG8_WAIT_L(0); PG8_BAR; PG8_MMA(1, 0, At, B0); PG8_MMA(1, 1, At, B1); PG8_BAR; PG8_SCHED;
            PG8_LDB(B0, 1, 0); PG8_LDB(B1, 1, 1); PG8_SCHED; PG8_LDA(At, 1, 0); PG8_STAGE(PG8_SA(0, 1), a2 + hstepA, voffA);
            PG8_WAIT_V(8); PG8_WAIT_L(0); PG8_BAR; PG8_MMA(0, 0, At, B0); PG8_MMA(0, 1, At, B1); PG8_BAR; PG8_SCHED;
            PG8_LDA(At, 1, 1); PG8_STAGE(PG8_SB(1, 0), b3, voffB); PG8_STAGE(PG8_SB(1, 1), b3 + hstepB, voffB); PG8_STAGE(PG8_SA(1, 0), a3, voffA);
            PG8_WAIT_V(8); PG8_WAIT_L(0); PG8_BAR; PG8_MMA(1, 0, At, B0); PG8_MMA(1, 1, At, B1); PG8_BAR; PG8_SCHED;
        }
        if (wr == 0) PG8_BAR;
        { int fr_ = fr, fq_ = fq; asm volatile("" : "+v"(fr_), "+v"(fq_));
          if constexpr (MODE == 1 && !self_scale_of<Epi>(0)) {
              f32x4 cs[2][2];
#pragma unroll
              for (int bj = 0; bj < 2; ++bj)
#pragma unroll
                  for (int n = 0; n < 2; ++n) cs[bj][n] = *(const f32x4*)(colscale + cur.scol + 128 * bj + 32 * wc + 16 * n + 4 * fq_);
#pragma unroll
              for (int ai = 0; ai < 2; ++ai)
#pragma unroll
                  for (int m = 0; m < 4; ++m) { const float rs = rowscale[cur.srow + 128 * ai + 64 * wr + 16 * m + fr_];
#pragma unroll
                      for (int bj = 0; bj < 2; ++bj)
#pragma unroll
                          for (int n = 0; n < 2; ++n) { const v4i32 iv = __builtin_bit_cast(v4i32, acc[ai][bj][m][n]);
                              acc[ai][bj][m][n] = (f32x4){(float)iv[0], (float)iv[1], (float)iv[2], (float)iv[3]} * cs[bj][n] * rs; } }
          }
          E(acc, cur, wr, wc, fr_, fq_, lds); }
        if (!has_next) break;
#pragma unroll
        for (int a = 0; a < 2; ++a)
#pragma unroll
            for (int b = 0; b < 2; ++b)
#pragma unroll
                for (int m = 0; m < 4; ++m)
#pragma unroll
                    for (int n = 0; n < 2; ++n) acc[a][b][m][n] = (f32x4){0.f, 0.f, 0.f, 0.f};
        cur = nxt; cA = nA; cB = nB; ++ui;
        if (wr == 1) PG8_BAR;
    }
    PG8_WAIT_V(0);
    PG8_BAR;
#undef PG8_SA
#undef PG8_SB
#undef PG8_STAGE
#undef PG8_LDA
#undef PG8_LDB
#undef PG8_MMA
#undef PG8_WAIT_V
#undef PG8_WAIT_L
#undef PG8_BAR
#undef PG8_SCHED
}
}
using pg8::Unit;

struct Frame {
    LAS unsigned char* lds;
    int tid, lane, wave, vcu, G;
    float* xl;
    unsigned char* ws;
};
typedef const char __attribute__((address_space(4)))* kaptr_t;
__device__ __forceinline__ const float* inp(int i) {
    kaptr_t ka = (kaptr_t)__builtin_amdgcn_kernarg_segment_ptr();
    asm volatile("" : "+s"(i));
    return *(const float* const __attribute__((address_space(4)))*)(ka + 8 * i);
}
#define WSP(T, off) ((T*)(F.ws + (off)))
__device__ __forceinline__ int rotc(const Frame& F, int rot) { return (F.vcu + rot) % F.G; }

__device__ __forceinline__ const float* xrow_ptr(const Frame& F, int r) { return r < RL ? F.xl + (size_t)r * D : WSP(float, WS_XC) + (size_t)(r - RL) * D; }
__device__ __forceinline__ int modrow_of(int r) { return r < RL ? (r >> 11) : 16; }

struct SchedMN {
    int m_lo, nM, nN, G, c; const char* A; const char* B; size_t a_tile, b_tile; int a_row0;
    __device__ __forceinline__ bool next(int i, Unit& u) const {
        const long L = (long)i * G + c; if (L >= (long)nM * nN) return false;
        const int band = (int)(L / (4 * nN)), rem = (int)(L % (4 * nN)); const int pm = band * 4 + (rem & 3), pn = rem >> 2;
        u.pm = m_lo + pm; u.pn = pn; u.a = A + (size_t)(m_lo + pm - a_row0) * a_tile; u.b = B + (size_t)pn * b_tile; u.srow = (m_lo + pm) * 256; u.scol = pn * 256; return true;
    }
};
struct SchedWin {
    int nfull, nrest, nsel, G, c; const char* A; const char* B; size_t rowb;
    __device__ __forceinline__ bool next(int i, Unit& u) const {
        const long L = (long)i * G + c; const long n0 = (long)nfull * 10; if (L >= n0 + (long)nrest * nsel) return false;
        int pm, pn;
        if (L < n0) { const int band = (int)(L / 40), rem = (int)(L % 40); pm = band * 4 + (rem & 3); pn = rem >> 2; }
        else { const int q = (int)(L - n0); pm = nfull + (q & 15); const int k = q >> 4; pn = k == 0 ? 1 : (k == 1 ? 3 : (k == 2 ? 4 : (k == 3 ? 7 : 9))); }
        u.pm = pm; u.pn = pn; u.a = A + (size_t)pm * 256 * rowb; u.b = B + (size_t)pn * 256 * rowb; u.srow = pm * 256; u.scol = pn * 256; return true;
    }
};
struct SchedBranch {
    int m_lo, nM, G, c; const char* Y; const char* Wb;
    __device__ __forceinline__ bool next(int i, Unit& u) const {
        const long L = (long)i * G + c; if (L >= (long)nM * 16) return false;
        const int pm = (int)(L / 16), q = (int)(L % 16), s = q >> 2, pn = q & 3;
        u.pm = m_lo + pm; u.pn = q; u.a = Y + ((size_t)(m_lo + pm) * 256 * 1024 + 256 * s) * 2; u.b = Wb + ((size_t)(s * 1024 + pn * 256) * 256) * 2; return true;
    }
};
struct SchedDft {
    int nb, nMb, G, c; const char* CS; const char* FT; size_t cs_tile, ft_b;
    __device__ __forceinline__ bool next(int i, Unit& u) const {
        const long L = (long)i * G + c; if (L >= (long)nb * nMb) return false;
        const int b = (int)(L / nMb), pm = (int)(L % nMb);
        u.pm = pm; u.pn = b; u.a = CS + (size_t)pm * cs_tile; u.b = FT + (size_t)b * ft_b; return true;
    }
};

typedef f32x4 Acc[2][2][4][2];
#define EPI_LOOP_AM for (int ai = 0; ai < 2; ++ai) _Pragma("unroll") for (int m = 0; m < 4; ++m)
#define EPI_LOOP_BN for (int bj = 0; bj < 2; ++bj) _Pragma("unroll") for (int n = 0; n < 2; ++n)

__device__ __forceinline__ float dpp_from_prev(float x) { return __int_as_float(__builtin_amdgcn_update_dpp(0, __float_as_int(x), 0x121, 0xF, 0xF, true)); }
__device__ __forceinline__ float dpp_from_next(float x) { return __int_as_float(__builtin_amdgcn_update_dpp(0, __float_as_int(x), 0x12F, 0xF, 0xF, true)); }
#define EW(T, off) ((T*)(ws + (off)))
struct EpiWin {
    unsigned char* ws; int layer;
    __device__ __forceinline__ void operator()(const Acc& acc, const Unit& u, int wr, int wc, int fr, int fq, LAS unsigned char* lds) const {
        bf16_t* const CQ = EW(bf16_t, WS_CQ); bf16_t* const CKV = EW(bf16_t, WS_CKV); bf16_t* const MQK = EW(bf16_t, WS_MQK); bf16_t* const MV = EW(bf16_t, WS_MV); bf16_t* const MO = EW(bf16_t, WS_MO);
        bf16_t* const GQ = EW(bf16_t, WS_GQ); bf16_t* const GK = EW(bf16_t, WS_GK); bf16_t* const GV = EW(bf16_t, WS_GV); bf16_t* const FAB = EW(bf16_t, WS_FAB); bf16_t* const K96 = EW(bf16_t, WS_K96);
        float* const SSP = EW(float, WS_SSP); float* const MG = EW(float, WS_MG); const float* const ropeG = EW(float, WS_TAB); const float* const ropeM = EW(float, WS_TAB + 8192);
        asm volatile("" : "+v"(fq), "+v"(fr));
        const int t = u.pn, rb = u.pm * 256 + wr * 64 + fr; const bool lat = u.pm < TL;
        const int cw = 32 * wc + 4 * fq;
        if (t <= 1) {
            bf16_t* dst = t == 0 ? CQ : CKV; float* ss = SSP + (size_t)t * R * 4;
#pragma unroll
            EPI_LOOP_AM { const int r = rb + ai * 128 + m * 16; float sq = 0.f;
#pragma unroll
                for (int bj = 0; bj < 2; ++bj) { const f32x4 v = acc[ai][bj][m][0], v2 = acc[ai][bj][m][1]; sq += ((v[0] * v[0] + v[1] * v[1]) + (v[2] * v[2] + v[3] * v[3])) + ((v2[0] * v2[0] + v2[1] * v2[1]) + (v2[2] * v2[2] + v2[3] * v2[3]));
                    store8bf(dst + (size_t)r * 256 + 128 * bj + 32 * wc + 8 * fq, v, v2); }
                sq += __shfl_xor(sq, 16); sq += __shfl_xor(sq, 32);
                if (fq == 0) ss[(size_t)r * 4 + wc] = sq; }
        } else if (t <= 3) {
            asm volatile("" : "+v"(fq), "+v"(fr));
            LAS float* XF = (LAS float*)(lds + RING_BYTES);
            LAS float* XL = XF + 1024;
            const float scl = t == 3 ? 0.125f : 1.f; const int c0 = 32 * wc + 8 * fq; const int rb = u.pm * 256 + wr * 64 + fr;
            float* const EDQ = EW(float, WS_EDQ) + (size_t)(u.pm * 2 + (t - 2)) * 4 * 256;
#pragma unroll
            for (int ai = 0; ai < 2; ++ai) { const int k = 2 * ai + wr;
#pragma unroll
                EPI_LOOP_BN {
                    if (fr == 0) *(LAS f32x4*)(XF + ((k * 4 + wc) * 2 + bj) * 32 + 16 * n + 4 * fq) = acc[ai][bj][0][n];
                    if (fr == 15) *(LAS f32x4*)(XL + ((k * 4 + wc) * 2 + bj) * 32 + 16 * n + 4 * fq) = acc[ai][bj][3][n]; } }
            if (wr == 0 && fr < 2) {
#pragma unroll
                EPI_LOOP_BN { *(f32x4*)(EDQ + (size_t)fr * 256 + 128 * bj + c0 + 4 * n) = acc[0][bj][0][n]; } }
            if (wr == 1 && fr >= 14) {
#pragma unroll
                EPI_LOOP_BN { *(f32x4*)(EDQ + (size_t)(fr - 12) * 256 + 128 * bj + c0 + 4 * n) = acc[1][bj][3][n]; } }
            asm volatile("s_waitcnt lgkmcnt(0)" ::: "memory"); __builtin_amdgcn_s_barrier(); asm volatile("" ::: "memory");
            const float* const wcv = inp(15) + (size_t)layer * 3 * 512 + (t - 2) * 256;
#pragma unroll
            for (int bj = 0; bj < 2; ++bj) {
#pragma unroll
                for (int n = 0; n < 2; ++n) { const int ch = 128 * bj + c0 + 4 * n;
                    const f32x4 w0 = *(const f32x4*)(wcv + ch), w1 = *(const f32x4*)(wcv + 512 + ch), w2 = *(const f32x4*)(wcv + 1024 + ch);
                    const f32x4 zz = (f32x4){0.f, 0.f, 0.f, 0.f}; const f32x4 w0a = fr > 0 ? w0 : zz, w0b = fr > 0 ? zz : w0, w2a = fr < 15 ? w2 : zz, w2b = fr < 15 ? zz : w2;
#pragma unroll
                    for (int ai = 0; ai < 2; ++ai) { const int k = 2 * ai + wr;
                        f32x4 hp = (f32x4){0.f, 0.f, 0.f, 0.f}, hn = hp;
                        if (k > 0) hp = *(const LAS f32x4*)(XL + (((k - 1) * 4 + wc) * 2 + bj) * 32 + 16 * n + 4 * fq);
                        if (k < 3) hn = *(const LAS f32x4*)(XF + (((k + 1) * 4 + wc) * 2 + bj) * 32 + 16 * n + 4 * fq);
                        f32x4 pprev = hp, ncur;
#pragma unroll
                        for (int j = 0; j < 4; ++j) ncur[j] = dpp_from_next(acc[ai][bj][0][n][j]);
#pragma unroll
                        for (int m = 0; m < 4; ++m) { f32x4 o, pcur, nnext = hn;
#pragma unroll
                            for (int j = 0; j < 4; ++j) { pcur[j] = dpp_from_prev(acc[ai][bj][m][n][j]); if (m < 3) nnext[j] = dpp_from_next(acc[ai][bj][m < 3 ? m + 1 : 3][n][j]); }
#pragma unroll
                            for (int j = 0; j < 4; ++j) o[j] = siluf_(w1[j] * acc[ai][bj][m][n][j] + w0a[j] * pcur[j] + w0b[j] * pprev[j] + w2a[j] * ncur[j] + w2b[j] * nnext[j]) * scl;
                            store4bf(MQK + (size_t)(rb + ai * 128 + m * 16) * 512 + (t - 2) * 256 + 128 * bj + c0 + 4 * n, o);
                            pprev = pcur; ncur = nnext; }
                        __builtin_amdgcn_sched_barrier(0); } } }
            asm volatile("s_waitcnt lgkmcnt(0)" ::: "memory"); __builtin_amdgcn_s_barrier(); asm volatile("" ::: "memory");
        } else if (t <= 5) {
            bf16_t* dst = t == 4 ? MV : MO; const int ld = 256;
#pragma unroll
            EPI_LOOP_AM { const int r = rb + ai * 128 + m * 16;
#pragma unroll
                for (int bj = 0; bj < 2; ++bj) { f32x4 v = acc[ai][bj][m][0], v2 = acc[ai][bj][m][1];
                    if (t == 5) { v[0] = sigmoidf_(v[0]); v[1] = sigmoidf_(v[1]); v[2] = sigmoidf_(v[2]); v[3] = sigmoidf_(v[3]); v2[0] = sigmoidf_(v2[0]); v2[1] = sigmoidf_(v2[1]); v2[2] = sigmoidf_(v2[2]); v2[3] = sigmoidf_(v2[3]); }
                    store8bf(dst + (size_t)r * ld + 128 * bj + 32 * wc + 8 * fq, v, v2); } }
        } else if (t == 6 || t == 7) {
#pragma unroll
            EPI_LOOP_AM { const int r = rb + ai * 128 + m * 16; const int tok = r & 2047; const int pos = (wc & 1) ? (tok & 63) : (tok >> 6);
                f32x4 cs0 = (f32x4){1.f, 0.f, 1.f, 0.f}, cs1 = cs0;
                if (lat) { const f32x4* tp = (const f32x4*)(ropeG + (size_t)(pos * 16 + 4 * fq) * 2); cs0 = tp[0]; cs1 = tp[1]; }
#pragma unroll
                for (int bj = 0; bj < 2; ++bj) {
                    f32x4 x1 = acc[ai][bj][m][0], x2 = acc[ai][bj][m][1];
                    if (t == 6 || bj == 0) {
                        f32x4 o1, o2;
                        o1[0] = x1[0] * cs0[0] - x2[0] * cs0[1]; o2[0] = x1[0] * cs0[1] + x2[0] * cs0[0];
                        o1[1] = x1[1] * cs0[2] - x2[1] * cs0[3]; o2[1] = x1[1] * cs0[3] + x2[1] * cs0[2];
                        o1[2] = x1[2] * cs1[0] - x2[2] * cs1[1]; o2[2] = x1[2] * cs1[1] + x2[2] * cs1[0];
                        o1[3] = x1[3] * cs1[2] - x2[3] * cs1[3]; o2[3] = x1[3] * cs1[3] + x2[3] * cs1[2];
                        x1 = o1; x2 = o2;
                    }
                    if (t == 6) { x1 = x1 * QS_G; x2 = x2 * QS_G; store4bf(GQ + (size_t)r * 256 + 128 * bj + cw, x1); store4bf(GQ + (size_t)r * 256 + 128 * bj + cw + 16, x2); }
                    else if (bj == 0) { store4bf(GK + (size_t)r * 128 + cw, x1); store4bf(GK + (size_t)r * 128 + cw + 16, x2); }
                    else { const int bb = r < RL ? (r >> 11) : ((r - RL) >> 8), key = r < RL ? 256 + (r & 2047) : ((r - RL) & 255);
                        bf16_t* dst = GV + ((size_t)((bb * 2 + (wc >> 1)) * 64 + 32 * (wc & 1) + 4 * fq)) * 2304 + key;
#pragma unroll
                        for (int j = 0; j < 4; ++j) { dst[(size_t)j * 2304] = (bf16_t)f2bf(x1[j]); dst[(size_t)(16 + j) * 2304] = (bf16_t)f2bf(x2[j]); } }
                } }
        } else if (t == 8) {
#pragma unroll
            EPI_LOOP_AM { const int r = rb + ai * 128 + m * 16;
#pragma unroll
                for (int bj = 0; bj < 2; ++bj) store8bf(FAB + (size_t)r * 256 + 128 * bj + 32 * wc + 8 * fq, acc[ai][bj][m][0], acc[ai][bj][m][1]); }
        } else {
            if (wc == 0) {
#pragma unroll
                EPI_LOOP_AM { const int r = rb + ai * 128 + m * 16; const int tok = r & 2047; const int pos = (fq >= 2) ? (tok & 63) : (tok >> 6);
                    f32x4 cs0 = (f32x4){1.f, 0.f, 1.f, 0.f}, cs1 = cs0;
                    if (lat) { const f32x4* tp = (const f32x4*)(ropeM + (size_t)(pos * 8 + 4 * (fq & 1)) * 2); cs0 = tp[0]; cs1 = tp[1]; }
                    const f32x4 x1 = acc[ai][0][m][0], x2 = acc[ai][0][m][1]; f32x4 o1, o2;
                    o1[0] = x1[0] * cs0[0] - x2[0] * cs0[1]; o2[0] = x1[0] * cs0[1] + x2[0] * cs0[0];
                    o1[1] = x1[1] * cs0[2] - x2[1] * cs0[3]; o2[1] = x1[1] * cs0[3] + x2[1] * cs0[2];
                    o1[2] = x1[2] * cs1[0] - x2[2] * cs1[1]; o2[2] = x1[2] * cs1[1] + x2[2] * cs1[0];
                    o1[3] = x1[3] * cs1[2] - x2[3] * cs1[3]; o2[3] = x1[3] * cs1[3] + x2[3] * cs1[2];
#pragma unroll
                    for (int h = 0; h < 4; ++h) { store4bf(K96 + (size_t)r * 384 + h * 96 + 64 + 4 * fq, o1); store4bf(K96 + (size_t)r * 384 + h * 96 + 80 + 4 * fq, o2); } }
            } else if (wc == 1) {
#pragma unroll
                EPI_LOOP_AM { const int r = rb + ai * 128 + m * 16; *(f32x4*)(MG + (size_t)r * 16 + 4 * fq) = acc[ai][0][m][0]; }
            }
        }
    }
};

struct EpiUq {
    unsigned char* ws;
    __device__ __forceinline__ void operator()(const Acc& acc, const Unit& u, int wr, int wc, int fr, int fq, LAS unsigned char* lds) const {
        if (wc == 3) return;
        bf16_t* const Q96 = EW(bf16_t, WS_Q96); const float* const SSP = EW(float, WS_SSP); const float* const ropeM = EW(float, WS_TAB + 8192);
        const int rb = u.pm * 256 + wr * 64 + fr; const bool lat = u.pm < TL;
#pragma unroll
        EPI_LOOP_AM { const int r = rb + ai * 128 + m * 16; const f32x4 s4 = *(const f32x4*)(SSP + (size_t)r * 4);
            const float sc = rsqrtf(((s4[0] + s4[1]) + (s4[2] + s4[3])) * (1.f / 256.f) + EPS) * QS_M;
            const int tok = r & 2047; const int pos = (fq >= 2) ? (tok & 63) : (tok >> 6);
            f32x4 cs0 = (f32x4){1.f, 0.f, 1.f, 0.f}, cs1 = cs0;
            if (lat && wc == 2) { const f32x4* tp = (const f32x4*)(ropeM + (size_t)(pos * 8 + 4 * (fq & 1)) * 2); cs0 = tp[0]; cs1 = tp[1]; }
#pragma unroll
            for (int bj = 0; bj < 2; ++bj) { const int hh = 2 * u.pn + bj; bf16_t* dst = Q96 + (size_t)r * 384 + hh * 96 + 32 * wc + 4 * fq;
                f32x4 x1 = acc[ai][bj][m][0] * sc, x2 = acc[ai][bj][m][1] * sc;
                if (wc == 2) { f32x4 o1, o2;
                    o1[0] = x1[0] * cs0[0] - x2[0] * cs0[1]; o2[0] = x1[0] * cs0[1] + x2[0] * cs0[0];
                    o1[1] = x1[1] * cs0[2] - x2[1] * cs0[3]; o2[1] = x1[1] * cs0[3] + x2[1] * cs0[2];
                    o1[2] = x1[2] * cs1[0] - x2[2] * cs1[1]; o2[2] = x1[2] * cs1[1] + x2[2] * cs1[0];
                    o1[3] = x1[3] * cs1[2] - x2[3] * cs1[3]; o2[3] = x1[3] * cs1[3] + x2[3] * cs1[2];
                    x1 = o1; x2 = o2; }
                store4bf(dst, x1); store4bf(dst + 16, x2); } }
    }
};
struct EpiUkv {
    unsigned char* ws;
    __device__ __forceinline__ void operator()(const Acc& acc, const Unit& u, int wr, int wc, int fr, int fq, LAS unsigned char* lds) const {
        bf16_t* const K96 = EW(bf16_t, WS_K96); bf16_t* const V = EW(bf16_t, WS_V); const float* const SSP = EW(float, WS_SSP) + (size_t)R * 4;
        const int rb = u.pm * 256 + wr * 64 + fr;
#pragma unroll
        EPI_LOOP_AM { const int r = rb + ai * 128 + m * 16; const f32x4 s4 = *(const f32x4*)(SSP + (size_t)r * 4);
            const float sc = rsqrtf(((s4[0] + s4[1]) + (s4[2] + s4[3])) * (1.f / 256.f) + EPS);
            const int bb = r < RL ? (r >> 11) : ((r - RL) >> 8), key = r < RL ? 256 + (r & 2047) : ((r - RL) & 255);
#pragma unroll
            for (int bj = 0; bj < 2; ++bj) { const int hh = 2 * u.pn + bj;
                if (wc < 2) { bf16_t* dst = K96 + (size_t)r * 384 + hh * 96 + 32 * wc + 4 * fq; store4bf(dst, acc[ai][bj][m][0] * sc); store4bf(dst + 16, acc[ai][bj][m][1] * sc); }
                else { bf16_t* dst = V + ((size_t)((bb * 4 + hh) * 64 + 32 * (wc - 2) + 4 * fq)) * 2304 + key;
#pragma unroll
                    for (int n = 0; n < 2; ++n)
#pragma unroll
                        for (int j = 0; j < 4; ++j) dst[(size_t)(16 * n + j) * 2304] = (bf16_t)f2bf(acc[ai][bj][m][n][j] * sc); } } }
    }
};
struct EpiDft {
    unsigned char* ws; int row0, nseq; float scale;
    __device__ __forceinline__ void operator()(const Acc& acc, const Unit& u, int wr, int wc, int fr, int fq, LAS unsigned char* lds) const {
        bf16_t* const Y = EW(bf16_t, WS_Y);
        const int rb = row0 + u.pn * nseq + u.pm * 256 + wr * 64 + fr;
#pragma unroll
        EPI_LOOP_AM { const int r = rb + ai * 128 + m * 16;
#pragma unroll
            EPI_LOOP_BN { store4bf(Y + (size_t)r * 1024 + 768 + 128 * bj + 32 * wc + 16 * n + 4 * fq, acc[ai][bj][m][n] * scale); } }
    }
};
struct EpiBranch {
    unsigned char* ws; int r0, crows;
    __device__ __forceinline__ void operator()(const Acc& acc, const Unit& u, int wr, int wc, int fr, int fq, LAS unsigned char* lds) const {
        const int s = u.pn >> 2, pn = u.pn & 3; const int rb = u.pm * 256 + wr * 64 + fr - r0;
        bf16_t* const base = EW(bf16_t, WS_BV) + ((size_t)s * crows + rb) * 1024 + 256 * pn + 32 * wc + 8 * fq;
#pragma unroll
        EPI_LOOP_AM {
#pragma unroll
            for (int bj = 0; bj < 2; ++bj) store8bf(base + (size_t)(ai * 128 + m * 16) * 1024 + 128 * bj, acc[ai][bj][m][0], acc[ai][bj][m][1]); }
    }
};
struct EpiGate {
    static constexpr bool SELF_SCALE = true;
    unsigned char* ws; const float* bg; int r0, crows; const float* rowscale; const float* colscale;
    __device__ __forceinline__ void operator()(const Acc& acc, const Unit& u, int wr, int wc, int fr, int fq, LAS unsigned char* lds) const {
        asm volatile("" : "+v"(fq), "+v"(fr));
        bf16_t* const ACCo = EW(bf16_t, WS_ACC);
        const int d0 = 64 * u.pn + 16 * wc + 4 * fq; const int rb = u.pm * 256 + wr * 64 + fr;
        const bf16_t* const bvp = EW(bf16_t, WS_BV) + (size_t)(rb - r0) * 1024 + d0; const size_t plane = (size_t)crows * 1024;
        const float* const rsp = rowscale + rb;
        u32x2 w[3][4]; float rs[3];
#pragma unroll
        for (int p = 0; p < 2; ++p) { const int ro = (p >> 2) * 128 + (p & 3) * 16; rs[p] = rsp[ro];
#pragma unroll
            for (int s = 0; s < 4; ++s) w[p][s] = *(const u32x2*)(bvp + (size_t)ro * 1024 + s * plane); }
        f32x4 kc[4], bz[4];
#pragma unroll
        for (int s = 0; s < 4; ++s) { kc[s] = *(const f32x4*)(colscale + u.scol + 128 * (s >> 1) + 32 * wc + 16 * (s & 1) + 4 * fq) * (-LOG2E); bz[s] = *(const f32x4*)(bg + s * 1024 + d0) * (-LOG2E); }
#pragma unroll
        for (int p = 0; p < 8; ++p) { const int ai = p >> 2, m = p & 3;
            if (p + 2 < 8) { const int q = p + 2, ro = (q >> 2) * 128 + (q & 3) * 16; rs[q % 3] = rsp[ro];
#pragma unroll
                for (int s = 0; s < 4; ++s) w[q % 3][s] = *(const u32x2*)(bvp + (size_t)ro * 1024 + s * plane); }
            f32x4 o;
#pragma unroll
            for (int s = 0; s < 4; ++s) { const pg8::v4i32 iv = __builtin_bit_cast(pg8::v4i32, acc[ai][s >> 1][m][s & 1]);
                const u32x2 ww = w[p % 3][s]; const f32x4 bv = (f32x4){lo_bf(ww.x), hi_bf(ww.x), lo_bf(ww.y), hi_bf(ww.y)};
#pragma unroll
                for (int j = 0; j < 4; ++j) { const float sg = frcp(1.0f + fexp2(fmaf((float)iv[j] * rs[p % 3], kc[s][j], bz[s][j]))); o[j] = s == 0 ? sg * bv[j] : fmaf(sg, bv[j], o[j]); } }
            store4bf(ACCo + (size_t)(rb + ai * 128 + m * 16) * 1024 + d0, o); }
    }
};
struct EpiPlain {
    bf16_t* O; int ldc; int r0;
    __device__ __forceinline__ void operator()(const Acc& acc, const Unit& u, int wr, int wc, int fr, int fq, LAS unsigned char* lds) const {
        const int rb = u.pm * 256 + wr * 64 + fr - r0;
#pragma unroll
        EPI_LOOP_AM { const int r = rb + ai * 128 + m * 16;
#pragma unroll
            for (int bj = 0; bj < 2; ++bj) store8bf(O + (size_t)r * ldc + 256 * u.pn + 128 * bj + 32 * wc + 8 * fq, acc[ai][bj][m][0], acc[ai][bj][m][1]); }
    }
};

struct EpiUpConv {
    unsigned char* ws; const float* wconv; const float* bconv;
    __device__ __forceinline__ void operator()(const Acc& acc, const Unit& u, int wr, int wc, int fr, int fq, LAS unsigned char* lds) const {
        LAS float* XF = (LAS float*)(lds + RING_BYTES);
        LAS float* XL = XF + 512;
        const int c0 = 32 * wc + 8 * fq;
        const int f0 = 128 * u.pn + c0;
        bf16_t* const G = EW(bf16_t, WS_G); float* const EDGE = EW(float, WS_EDGE) + (size_t)(u.pm * 22 + u.pn) * 6 * 128;
#pragma unroll
        for (int ai = 0; ai < 2; ++ai) { const int k = 2 * ai + wr;
#pragma unroll
            for (int n = 0; n < 2; ++n) {
                if (fr == 0) *(LAS f32x4*)(XF + (k * 4 + wc) * 32 + 16 * n + 4 * fq) = acc[ai][0][0][n];
                if (fr == 15) *(LAS f32x4*)(XL + (k * 4 + wc) * 32 + 16 * n + 4 * fq) = acc[ai][0][3][n]; } }
        if (wr == 0 && fr < 2) {
#pragma unroll
            for (int n = 0; n < 2; ++n) { *(f32x4*)(EDGE + (size_t)fr * 128 + c0 + 4 * n) = acc[0][0][0][n]; if (fr == 0) *(f32x4*)(EDGE + 4 * 128 + c0 + 4 * n) = acc[0][1][0][n]; } }
        if (wr == 1 && fr >= 14) {
#pragma unroll
            for (int n = 0; n < 2; ++n) { *(f32x4*)(EDGE + (size_t)(fr - 12) * 128 + c0 + 4 * n) = acc[1][0][3][n]; if (fr == 15) *(f32x4*)(EDGE + 5 * 128 + c0 + 4 * n) = acc[1][1][3][n]; } }
        asm volatile("s_waitcnt lgkmcnt(0)" ::: "memory"); __builtin_amdgcn_s_barrier(); asm volatile("" ::: "memory");
        u32x2 stash[2][4];
#pragma unroll
        for (int n = 0; n < 2; ++n) {
            const f32x4 w0 = *(const f32x4*)(wconv + f0 + 4 * n), w1 = *(const f32x4*)(wconv + DFF + f0 + 4 * n), w2 = *(const f32x4*)(wconv + 2 * DFF + f0 + 4 * n), bb = *(const f32x4*)(bconv + f0 + 4 * n);
            const f32x4 zz = (f32x4){0.f, 0.f, 0.f, 0.f}; const f32x4 w0a = fr > 0 ? w0 : zz, w0b = fr > 0 ? zz : w0, w2a = fr < 15 ? w2 : zz, w2b = fr < 15 ? zz : w2;
#pragma unroll
            for (int ai = 0; ai < 2; ++ai) { const int k = 2 * ai + wr;
                f32x4 hp = (f32x4){0.f, 0.f, 0.f, 0.f}, hn = hp;
                if (k > 0) hp = *(const LAS f32x4*)(XL + ((k - 1) * 4 + wc) * 32 + 16 * n + 4 * fq);
                if (k < 3) hn = *(const LAS f32x4*)(XF + ((k + 1) * 4 + wc) * 32 + 16 * n + 4 * fq);
                f32x4 P[4], N[4];
#pragma unroll
                for (int m = 0; m < 4; ++m)
#pragma unroll
                    for (int j = 0; j < 4; ++j) { P[m][j] = dpp_from_prev(acc[ai][0][m][n][j]); N[m][j] = dpp_from_next(acc[ai][0][m][n][j]); }
#pragma unroll
                for (int m = 0; m < 4; ++m) { f32x4 o;
#pragma unroll
                    for (int j = 0; j < 4; ++j) {
                        const float c = bb[j] + w1[j] * acc[ai][0][m][n][j] + w0a[j] * P[m][j] + w0b[j] * (m > 0 ? P[m - 1][j] : hp[j]) + w2a[j] * N[m][j] + w2b[j] * (m < 3 ? N[m + 1][j] : hn[j]);
                        o[j] = siluf_(c) * acc[ai][1][m][n][j]; }
                    u32x2 w; w.x = cvt_pk_bf16(o[0], o[1]); w.y = cvt_pk_bf16(o[2], o[3]);
                    if (n == 0) stash[ai][m] = w;
                    else { const u32x4 ww = (u32x4){stash[ai][m].x, stash[ai][m].y, w.x, w.y}; *(u32x4*)(G + (size_t)(u.pm * 256 + 128 * ai + 64 * wr + 16 * m + fr) * DFF + f0) = ww; } } } }
        asm volatile("s_waitcnt lgkmcnt(0)" ::: "memory"); __builtin_amdgcn_s_barrier(); asm volatile("" ::: "memory");
    }
};
__device__ __forceinline__ void phase_conv_fixup(const Frame& F, int l, int t_lo, int ntile) {
    const float* EDGE = WSP(float, WS_EDGE); bf16_t* Gb = WSP(bf16_t, WS_G); const float* wc = inp(23) + (size_t)l * 3 * DFF; const float* bc = inp(24) + (size_t)l * DFF;
    const long total = (long)ntile * 2 * (DFF / 4); const long gt = (long)F.vcu * NTHR + F.tid, gs = (long)F.G * NTHR;
    for (long it = gt; it < total; it += gs) {
        const int f4 = (int)(it % (DFF / 4)); const int q = (int)(it / (DFF / 4)); const int which = q & 1, pm = t_lo + (q >> 1); const int f = 4 * f4, pn = f >> 7, c = f & 127;
        const bool seq_first = pm >= TL || (pm & 7) == 0, seq_last = pm >= TL || (pm & 7) == 7;
        const float* e = EDGE + (size_t)(pm * 22 + pn) * 768 + c;
        f32x4 ap = (f32x4){0.f, 0.f, 0.f, 0.f}, an = ap, ac, vv;
        if (which == 0) { if (!seq_first) ap = *(const f32x4*)(e - 22 * 768 + 3 * 128); ac = *(const f32x4*)e; an = *(const f32x4*)(e + 128); vv = *(const f32x4*)(e + 4 * 128); }
        else { ap = *(const f32x4*)(e + 2 * 128); ac = *(const f32x4*)(e + 3 * 128); if (!seq_last) an = *(const f32x4*)(e + 22 * 768); vv = *(const f32x4*)(e + 5 * 128); }
        const f32x4 w0 = *(const f32x4*)(wc + f), w1 = *(const f32x4*)(wc + DFF + f), w2 = *(const f32x4*)(wc + 2 * DFF + f), bb = *(const f32x4*)(bc + f);
        f32x4 o;
#pragma unroll
        for (int j = 0; j < 4; ++j) o[j] = siluf_(w0[j] * ap[j] + w1[j] * ac[j] + w2[j] * an[j] + bb[j]) * vv[j];
        store4bf(Gb + (size_t)(pm * 256 + (which ? 255 : 0)) * DFF + f, o);
    }
}

__device__ __forceinline__ int perm32(int rho) { const int n = rho >> 4, i = rho & 15; return 8 * (i >> 2) + 4 * n + (i & 3); }
__device__ __forceinline__ int permcol(int n) { return (n & ~31) + perm32(n & 31); }
struct MapIdent { __device__ int operator()(int n) const { return n; } };
struct MapIdentP { __device__ int operator()(int n) const { return permcol(n); } };
struct MapWin { __device__ int operator()(int n) const { const int t = n >> 8; const int i = t <= 5 ? permcol(n & 255) : (n & 255);
    switch (t) { case 0: return i; case 1: return 256 + i; case 2: return 544 + i; case 3: return 800 + i; case 4: return 1056 + i; case 5: return 1312 + i; case 6: return 1584 + i; case 7: return 1840 + i;
        case 9: { if (i < 32) { const int nn = i >> 4, ii = i & 15; return 512 + ((ii < 8 ? ii : 8 + ii) + 8 * nn); } if (i < 48) return 1568 + (i - 32); return -1; }
        default: return -1; } } };
struct MapUq { __device__ int operator()(int n) const { const int hh = n >> 7, w = n & 127; if (w < 64) return 96 * hh + w; if (w < 96) { const int c = w - 64, nn = c >> 4, ii = c & 15; return 96 * hh + 64 + ((ii < 8 ? ii : 8 + ii) + 8 * nn); } return -1; } };
struct MapGate { __device__ int operator()(int n) const { const int pn = n >> 8, rem = n & 255, bj = rem >> 7, wc = (rem & 127) >> 5, nn = (rem & 31) >> 4, q4 = rem & 15; const int s = 2 * bj + nn, d = 64 * pn + 16 * wc + q4; return s * 1048576 + d; } };
struct MapBranch { __device__ int operator()(int n) const { const int s = n >> 10, d = permcol(n & 1023); return s * 262144 + d; } };
struct MapUp { __device__ int operator()(int n) const { const int pn = n >> 8, i = permcol(n & 255); return i < 128 ? 128 * pn + i : 2816 + 128 * pn + (i - 128); } };

template <class Map>
__device__ __forceinline__ void conv_weight(const Frame& F, const float* W, int ldw, int K, bf16_t* Wt, int nrows, const float* ks, Map map, int skip_lo, int skip_hi, int vc, int nvc) {
    LAS float* scr = (LAS float*)(F.lds + F.wave * 8448);
    const int nblk = nrows / 32, kblk = K / 64; const int gw = vc * 8 + F.wave, ngw = nvc * 8; const int lane = F.lane;
    for (int it = gw; it < nblk * kblk; it += ngw) {
        const int nb = it % nblk, kb = it / nblk; const int n0 = 32 * nb, k0 = 64 * kb;
        if (n0 >= skip_lo && n0 < skip_hi) continue;
        const int col = map(n0 + (lane & 31));
        float v[32];
        const float* wp = W + (size_t)(k0 + (lane >> 5)) * ldw + (col >= 0 ? col : 0);
#pragma unroll
        for (int i = 0; i < 32; ++i) v[i] = wp[(size_t)(2 * i) * ldw];
        if (ks) {
#pragma unroll
            for (int i = 0; i < 32; ++i) v[i] *= ks[k0 + 2 * i + (lane >> 5)]; }
#pragma unroll
        for (int i = 0; i < 32; ++i) scr[(2 * i + (lane >> 5)) * 33 + (lane & 31)] = col >= 0 ? v[i] : 0.f;
        asm volatile("s_waitcnt lgkmcnt(0)" ::: "memory");
        const int c = lane & 7;
#pragma unroll
        for (int j = 0; j < 4; ++j) { const int n = (lane >> 3) + 8 * j; const LAS float* sp = scr + (8 * c) * 33 + n;
            u32x4 o; o.x = cvt_pk_bf16(sp[0 * 33], sp[1 * 33]); o.y = cvt_pk_bf16(sp[2 * 33], sp[3 * 33]); o.z = cvt_pk_bf16(sp[4 * 33], sp[5 * 33]); o.w = cvt_pk_bf16(sp[6 * 33], sp[7 * 33]);
            *(u32x4*)(Wt + (size_t)(n0 + n) * K + k0 + 8 * c) = o; }
        asm volatile("s_waitcnt lgkmcnt(0)" ::: "memory");
    }
}
template <class Map>
__device__ __forceinline__ void conv_weight_i8(const Frame& F, const float* W, int ldw, unsigned char* Wt, int nrows, Map map, float* colscale, int vc, int nvc, int skip_lo = 0, int skip_hi = 0) {
    LAS float* scr = (LAS float*)(F.lds + F.wave * 8448);
    LAS float* cmx = (LAS float*)(F.lds + 68 * 1024);
    const int lane = F.lane;
    for (int it = vc; it < nrows / 32; it += nvc) {
        const int n0 = 32 * it; if (n0 >= skip_lo && n0 < skip_hi) continue;
        const int col = map(n0 + (lane & 31));
        float v[2][32]; float mx = 0.f;
#pragma unroll
        for (int t = 0; t < 2; ++t) { const int k0 = 64 * (2 * F.wave + t); const float* wp = W + (size_t)(k0 + (lane >> 5)) * ldw + (col >= 0 ? col : 0);
#pragma unroll
            for (int i = 0; i < 32; ++i) { v[t][i] = col >= 0 ? wp[(size_t)(2 * i) * ldw] : 0.f; } }
#pragma unroll
        for (int t = 0; t < 2; ++t)
#pragma unroll
            for (int i = 0; i < 32; ++i) mx = fmaxf(mx, fabsf(v[t][i]));
        mx = fmaxf(mx, __shfl_xor(mx, 32));
        __syncthreads();
        if (lane < 32) cmx[F.wave * 32 + lane] = mx;
        __syncthreads();
        float cm = 0.f;
#pragma unroll
        for (int w = 0; w < 8; ++w) cm = fmaxf(cm, cmx[w * 32 + (lane & 31)]);
        const float inv = cm > 0.f ? 127.f / cm : 0.f;
        if (F.wave == 0 && lane < 32) colscale[n0 + lane] = cm * (1.f / 127.f);
#pragma unroll
        for (int t = 0; t < 2; ++t) { const int k0 = 64 * (2 * F.wave + t);
#pragma unroll
            for (int i = 0; i < 32; ++i) scr[(2 * i + (lane >> 5)) * 33 + (lane & 31)] = v[t][i] * inv;
            asm volatile("s_waitcnt lgkmcnt(0)" ::: "memory");
            const int c = lane & 7;
#pragma unroll
            for (int j = 0; j < 4; ++j) { const int n = (lane >> 3) + 8 * j; const LAS float* sp = scr + (8 * c) * 33 + n;
                u32x2 o; o.x = pack4_i8(sp[0 * 33], sp[1 * 33], sp[2 * 33], sp[3 * 33]); o.y = pack4_i8(sp[4 * 33], sp[5 * 33], sp[6 * 33], sp[7 * 33]);
                *(u32x2*)(Wt + (size_t)(n0 + n) * 1024 + k0 + 8 * c) = o; }
            asm volatile("s_waitcnt lgkmcnt(0)" ::: "memory"); }
    }
}
__device__ __forceinline__ void quant_rows_i8(const Frame& F, const float* src, unsigned char* dst, float* rscale, int nrows, int vc, int nvc) {
    LAS float* cmx = (LAS float*)(F.lds + 68 * 1024);
    for (int it = vc; it < nrows / 32; it += nvc) {
        const int row = 32 * it + (F.tid & 31), kq = F.tid >> 5;
        f32x4 v[16]; float mx = 0.f;
#pragma unroll
        for (int i = 0; i < 16; ++i) { v[i] = *(const f32x4*)(src + (size_t)row * 1024 + 64 * kq + 4 * i); mx = fmaxf(fmaxf(mx, fmaxf(fabsf(v[i][0]), fabsf(v[i][1]))), fmaxf(fabsf(v[i][2]), fabsf(v[i][3]))); }
        __syncthreads();
        cmx[kq * 32 + (F.tid & 31)] = mx;
        __syncthreads();
        float cm = 0.f;
#pragma unroll
        for (int w = 0; w < 16; ++w) cm = fmaxf(cm, cmx[w * 32 + (F.tid & 31)]);
        const float inv = cm > 0.f ? 127.f / cm : 0.f;
        if (kq == 0) rscale[row] = cm * (1.f / 127.f);
#pragma unroll
        for (int i = 0; i < 16; i += 4) { u32x4 o; o.x = pack4_i8(v[i][0] * inv, v[i][1] * inv, v[i][2] * inv, v[i][3] * inv); o.y = pack4_i8(v[i + 1][0] * inv, v[i + 1][1] * inv, v[i + 1][2] * inv, v[i + 1][3] * inv);
            o.z = pack4_i8(v[i + 2][0] * inv, v[i + 2][1] * inv, v[i + 2][2] * inv, v[i + 2][3] * inv); o.w = pack4_i8(v[i + 3][0] * inv, v[i + 3][1] * inv, v[i + 3][2] * inv, v[i + 3][3] * inv);
            *(u32x4*)(dst + (size_t)row * 1024 + 64 * kq + 4 * i) = o; }
    }
}
__device__ __forceinline__ void conv_fourier_rows(const Frame& F, const float* W, float* Ft  , bool i8, int vc, int nvc) {
    LAS float* Wl = (LAS float*)(F.lds + 68 * 1024);
    LAS float* Tc = Wl + 64 * 65;
    for (int item = vc; item < 64; item += nvc) {
        const int g = item & 3, kb = item >> 2; const int k0 = 64 * kb;
        __syncthreads();
        for (int i = F.tid; i < 4096; i += NTHR) { const int kk = i >> 6, c = i & 63; Wl[kk * 65 + c] = W[(size_t)(k0 + kk) * NIN_SRC + 2096 + g * 64 + c]; }
        if (F.tid < 64) Tc[F.tid] = cospif((float)F.tid * (1.f / 32.f));
        __syncthreads();
        const int q = F.tid & 63, kq = F.tid >> 6; const bool issin = q >= 33; const int j = issin ? q - 32 : q;
        float acc[8];
#pragma unroll
        for (int i = 0; i < 8; ++i) acc[i] = 0.f;
        for (int c = 0; c < 64; ++c) { const int mm = (j * c) & 63; const float tw = issin ? -Tc[(mm + 48) & 63] : Tc[mm];
#pragma unroll
            for (int i = 0; i < 8; ++i) acc[i] += Wl[(8 * kq + i) * 65 + c] * tw; }
        const int fc = g * 64 + q; const int qq = fc & 31; const int fq = qq >> 3, nn = (qq >> 2) & 1, jj = qq & 3; const int rho = 16 * nn + 4 * fq + jj;
        if (i8) { float* dst = Ft + (size_t)((fc & ~31) + rho) * 1024 + k0 + 8 * kq;
            *(f32x4*)dst = (f32x4){acc[0], acc[1], acc[2], acc[3]}; *(f32x4*)(dst + 4) = (f32x4){acc[4], acc[5], acc[6], acc[7]}; }
        else { bf16_t* dst = (bf16_t*)Ft + (size_t)(2048 + (fc & ~31) + rho) * 1024 + k0 + 8 * kq;
            u32x4 o0; o0.x = cvt_pk_bf16(acc[0], acc[1]); o0.y = cvt_pk_bf16(acc[2], acc[3]); o0.z = cvt_pk_bf16(acc[4], acc[5]); o0.w = cvt_pk_bf16(acc[6], acc[7]);
            *(u32x4*)dst = o0; }
    }
}
__device__ __forceinline__ void build_cs(const Frame& F, bf16_t* CS, int N) {
    const long total = (long)N * (2 * N / 8); const long gt = (long)F.vcu * NTHR + F.tid, gs = (long)F.G * NTHR; const float inv = 2.0f / (float)N;
    for (long it = gt; it < total; it += gs) {
        const int cc = (int)(it % (2 * N / 8)), k = (int)(it / (2 * N / 8)); float v[8];
#pragma unroll
        for (int i = 0; i < 8; ++i) { const int col = cc * 8 + i; const int part = col >= N, n = col - part * N; const int mm = (int)(((long)k * n) % N); const float a = (float)mm * inv; v[i] = part ? sinpif(a) : cospif(a); }
        u32x4 o; o.x = pk2(v[0], v[1]); o.y = pk2(v[2], v[3]); o.z = pk2(v[4], v[5]); o.w = pk2(v[6], v[7]);
        *(u32x4*)(CS + (size_t)k * 2 * N + cc * 8) = o;
    }
}
__device__ __forceinline__ void build_cs2(const Frame& F, bf16_t* CS) {
    const long total = 1024L * 256; const long gt = (long)F.vcu * NTHR + F.tid, gs = (long)F.G * NTHR;
    for (long it = gt; it < total; it += gs) {
        const int cc = (int)(it & 255), k = (int)(it >> 8); float v[8];
#pragma unroll
        for (int i = 0; i < 8; ++i) { const int col = cc * 8 + i; const int part = col >> 10, n = col & 1023; const int mm = (k * n) & 2047; const float a = (float)mm * (1.f / 1024.f); v[i] = part ? sinpif(a) : cospif(a); }
        u32x4 o; o.x = pk2(v[0], v[1]); o.y = pk2(v[2], v[3]); o.z = pk2(v[4], v[5]); o.w = pk2(v[6], v[7]);
        *(u32x4*)(CS + (size_t)k * 2048 + cc * 8) = o;
    }
}
__device__ __forceinline__ void mod_gemv(const Frame& F) {
    LAS float* sc = (LAS float*)F.lds;
    LAS float* red = (LAS float*)(F.lds + 17 * 1024 * 4);
    const float* c = inp(1); const float* cctx = inp(3); const float* wm = inp(4); const float* bm = inp(5); float* mod = WSP(float, WS_MOD);
    bool loaded = false;
    for (int item = F.vcu; item < DEPTH * 128; item += F.G) {
        if (!loaded) { for (int i = F.tid; i < 17 * 1024; i += NTHR) { const float x = i < 16 * 1024 ? c[i] : cctx[i - 16 * 1024]; sc[i] = siluf_(x); } __syncthreads(); loaded = true; }
        const int l = item >> 7, cb = item & 127; const int cl = F.tid % 48, kp = F.tid / 48;
        if (kp < 8) {
            float a[17];
#pragma unroll
            for (int j = 0; j < 17; ++j) a[j] = 0.f;
            const float* wp = wm + (size_t)l * 1024 * 6144 + cb * 48 + cl;
#pragma unroll 2
            for (int k = kp * 128; k < kp * 128 + 128; k += 4) { const float w0 = wp[(size_t)k * 6144], w1 = wp[(size_t)(k + 1) * 6144], w2 = wp[(size_t)(k + 2) * 6144], w3 = wp[(size_t)(k + 3) * 6144];
#pragma unroll
                for (int j = 0; j < 17; ++j) { const f32x4 s4 = *(const LAS f32x4*)(sc + j * 1024 + k); a[j] += (s4[0] * w0 + s4[1] * w1) + (s4[2] * w2 + s4[3] * w3); } }
#pragma unroll
            for (int j = 0; j < 17; ++j) red[(kp * 48 + cl) * 17 + j] = a[j];
        }
        __syncthreads();
        for (int o = F.tid; o < 48 * 17; o += NTHR) { const int cc = o / 17, j = o % 17; float sacc = 0.f;
#pragma unroll
            for (int q = 0; q < 8; ++q) sacc += red[(q * 48 + cc) * 17 + j];
            mod[((size_t)l * 17 + j) * 6144 + cb * 48 + cc] = sacc + bm[(size_t)l * 6144 + cb * 48 + cc]; }
        __syncthreads();
    }
}
__device__ __forceinline__ void build_tables(const Frame& F) {
    float* rg = WSP(float, WS_TAB); float* rm = WSP(float, WS_TAB + 8192);
    const int gt = F.vcu * NTHR + F.tid;
    if (gt < 64 * 16) { const int pos = gt >> 4, i = gt & 15; const float inv = exp2f(-(float)i * (1.f / 16.f) * 13.287712379549449f); const float a = (float)pos * inv; rg[gt * 2] = cosf(a); rg[gt * 2 + 1] = sinf(a); }
    else if (gt < 64 * 16 + 64 * 8) { const int q = gt - 64 * 16; const int pos = q >> 3, i = q & 7; const float inv = exp2f(-(float)i * (1.f / 8.f) * 13.287712379549449f); const float a = (float)pos * inv; rm[q * 2] = cosf(a); rm[q * 2 + 1] = sinf(a); }
}
__device__ __forceinline__ void copy_f32(const Frame& F, const float* src, float* dst, size_t n4) {
    const size_t gt = (size_t)F.vcu * NTHR + F.tid, gs = (size_t)F.G * NTHR;
    for (size_t i = gt; i < n4; i += gs) ((f32x4*)dst)[i] = ((const f32x4*)src)[i];
}

__device__ __forceinline__ void convert_layer_weights(const Frame& F, int l, int vc, int nvc, int parts) {
    unsigned char* wl = F.ws + WS_W + (size_t)l * W_LAYER;
  if (parts & 1) {
    if (win8(l)) {
        conv_weight_i8(F, inp(10) + (size_t)l * 1024 * NIN_SRC, NIN_SRC, wl + W_IN, NIN, MapWin(), WSP(float, WS_WSCW) + l * 2560, vc, nvc, 2048, 2304);
        conv_fourier_rows(F, inp(10) + (size_t)l * 1024 * NIN_SRC, WSP(float, WS_FTMP) + (size_t)l * 256 * 1024, true, vc, nvc);
    } else {
        conv_weight(F, inp(10) + (size_t)l * 1024 * NIN_SRC, NIN_SRC, 1024, (bf16_t*)(wl + W_IN), NIN, nullptr, MapWin(), 2048, 2304, vc, nvc);
        conv_fourier_rows(F, inp(10) + (size_t)l * 1024 * NIN_SRC, (float*)(wl + W_IN), false, vc, nvc);
    }
    conv_weight(F, inp(12) + (size_t)l * 256 * 384, 384, 256, (bf16_t*)(wl + W_UQ), 512, inp(11) + l * 256, MapUq(), 0, 0, vc, nvc);
    conv_weight(F, inp(14) + (size_t)l * 256 * 512, 512, 256, (bf16_t*)(wl + W_UKV), 512, inp(13) + l * 256, MapIdent(), 0, 0, vc, nvc);
  }
  if (parts & 2) {
    conv_weight_i8(F, inp(18) + (size_t)l * 4 * 1024 * 1024, 1024, wl + W_G, 4096, MapGate(), WSP(float, WS_WSCG) + l * 4096, vc, nvc);
    conv_weight(F, inp(20) + (size_t)l * 4 * 256 * 1024, 1024, 256, (bf16_t*)(wl + W_B), 4096, nullptr, MapBranch(), 0, 0, vc, nvc);
    conv_weight(F, inp(21) + (size_t)l * 1024 * 1024, 1024, 1024, (bf16_t*)(wl + W_OUT), 1024, nullptr, MapIdentP(), 0, 0, vc, nvc);
  }
  if (parts & 4)
    conv_weight_i8(F, inp(22) + (size_t)l * 1024 * 5632, 5632, wl + W_UP, 5632, MapUp(), WSP(float, WS_WSCU) + l * 5632, vc, nvc);
  if (parts & 8)
    conv_weight(F, inp(25) + (size_t)l * 2816 * 1024, 1024, 2816, (bf16_t*)(wl + W_DOWN), 1024, nullptr, MapIdentP(), 0, 0, vc, nvc);
}

__device__ __forceinline__ void quant_row_store(const Frame& F, const f32x4 (&o)[4], unsigned char* o8row, float* scale_out) {
    float mx = 0.f;
#pragma unroll
    for (int j = 0; j < 4; ++j) mx = fmaxf(fmaxf(mx, fmaxf(fabsf(o[j][0]), fabsf(o[j][1]))), fmaxf(fabsf(o[j][2]), fabsf(o[j][3])));
#pragma unroll
    for (int d = 1; d < 64; d <<= 1) mx = fmaxf(mx, __shfl_xor(mx, d));
    const float inv = mx > 0.f ? 127.f / mx : 0.f;
#pragma unroll
    for (int j = 0; j < 4; ++j) *(unsigned*)(o8row + 4 * (F.lane + 64 * j)) = pack4_i8(o[j][0] * inv, o[j][1] * inv, o[j][2] * inv, o[j][3] * inv);
    if (F.lane == 0) *scale_out = mx * (1.f / 127.f);
}
__device__ __forceinline__ void norm_mod_row(const Frame& F, f32x4 (&v)[4], const float* xnext, const float* gain, const float* sh, const float* sc, bf16_t* orow  , unsigned char* o8row, float* scale_out) {
    f32x4 g[4], a[4], b[4], vn[4];
#pragma unroll
    for (int j = 0; j < 4; ++j) { const int c4 = F.lane + 64 * j; g[j] = ((const f32x4*)gain)[c4]; a[j] = ((const f32x4*)sc)[c4]; b[j] = ((const f32x4*)sh)[c4]; }
    if (xnext) {
#pragma unroll
        for (int j = 0; j < 4; ++j) vn[j] = ((const f32x4*)xnext)[F.lane + 64 * j]; }
    float s = 0.f;
#pragma unroll
    for (int j = 0; j < 4; ++j) s += (v[j][0] * v[j][0] + v[j][1] * v[j][1]) + (v[j][2] * v[j][2] + v[j][3] * v[j][3]);
    const float rstd = rsqrtf(wave_sum(s) * (1.f / D) + EPS);
    f32x4 o[4];
#pragma unroll
    for (int j = 0; j < 4; ++j) { const int c4 = F.lane + 64 * j;
#pragma unroll
        for (int e = 0; e < 4; ++e) o[j][e] = v[j][e] * rstd * g[j][e] * (1.f + a[j][e]) + b[j][e];
        if (orow) store4bf(orow + 4 * c4, o[j]);
    }
    quant_row_store(F, o, o8row, scale_out);
    if (xnext) {
#pragma unroll
        for (int j = 0; j < 4; ++j) v[j] = vn[j]; }
}
__device__ __forceinline__ void phase_norm1_in(const Frame& F) {
    const float* mod = WSP(float, WS_MOD); const float* gain = inp(6); const float* xin = inp(0); const float* cin = inp(2);
    const int gw = F.vcu * 8 + F.wave, ngw = F.G * 8;
    f32x4 v[4];
    if (gw < R) { const float* xr = gw < RL ? xin + (size_t)gw * D : cin + (size_t)(gw - RL) * D;
#pragma unroll
        for (int j = 0; j < 4; ++j) v[j] = ((const f32x4*)xr)[F.lane + 64 * j]; }
    for (int r = gw; r < R; r += ngw) { const float* mr = mod + (size_t)modrow_of(r) * 6144; const int rn = r + ngw;
        const float* xnext = rn < R ? (rn < RL ? xin + (size_t)rn * D : cin + (size_t)(rn - RL) * D) : nullptr;
        if (win8(0)) norm_mod_row(F, v, xnext, gain, mr, mr + 1024, nullptr, WSP(unsigned char, WS_H) + (size_t)r * D, WSP(float, WS_HS) + r);
        else norm_mod_row(F, v, xnext, gain, mr, mr + 1024, WSP(bf16_t, WS_H) + (size_t)r * D, WSP(unsigned char, WS_H8A) + (size_t)r * D, WSP(float, WS_HS) + r);
    }
}
__device__ __forceinline__ void phase_post(const Frame& F, int l, const bf16_t* Yin, int nrows, bool second, bool from_input) {
    const float* mod = WSP(float, WS_MOD) + (size_t)l * 17 * 6144;
    const float* gpost = inp(second ? 9 : 7) + (size_t)l * D;
    const bool donorm = !second || l + 1 < DEPTH; const int ln = second ? l + 1 : l;
    const float* gpre = inp(second ? 6 : 8) + (size_t)ln * D; const float* modn = WSP(float, WS_MOD) + (size_t)ln * 17 * 6144;
    const float* xin0 = inp(0); const float* cin0 = inp(2);
    const int gw = F.vcu * 8 + F.wave, ngw = F.G * 8;
    for (int r = gw; r < nrows; r += ngw) {
        const int mrow = modrow_of(r); const float* mr = mod + (size_t)mrow * 6144; const float* gate = mr + (second ? 5 * 1024 : 2 * 1024);
        float* xo = (float*)xrow_ptr(F, r); const float* xi = from_input ? (r < RL ? xin0 + (size_t)r * D : cin0 + (size_t)(r - RL) * D) : xo; const bf16_t* yr = Yin + (size_t)r * D;
        f32x4 y[4]; float s = 0.f;
#pragma unroll
        for (int j = 0; j < 4; ++j) { const u32x2 w = ((const u32x2*)yr)[F.lane + 64 * j]; y[j] = (f32x4){lo_bf(w.x), hi_bf(w.x), lo_bf(w.y), hi_bf(w.y)}; s += (y[j][0] * y[j][0] + y[j][1] * y[j][1]) + (y[j][2] * y[j][2] + y[j][3] * y[j][3]); }
        const float rstd = rsqrtf(wave_sum(s) * (1.f / D) + EPS);
        f32x4 xn[4]; float s2 = 0.f;
#pragma unroll
        for (int j = 0; j < 4; ++j) { const int c4 = F.lane + 64 * j; const f32x4 g = ((const f32x4*)gpost)[c4], ga = ((const f32x4*)gate)[c4], xv = ((const f32x4*)xi)[c4];
#pragma unroll
            for (int e = 0; e < 4; ++e) xn[j][e] = xv[e] + ga[e] * (y[j][e] * rstd * g[e]);
            ((f32x4*)xo)[c4] = xn[j]; s2 += (xn[j][0] * xn[j][0] + xn[j][1] * xn[j][1]) + (xn[j][2] * xn[j][2] + xn[j][3] * xn[j][3]); }
        if (donorm) {
            const float rstd2 = rsqrtf(wave_sum(s2) * (1.f / D) + EPS); const float* mn = modn + (size_t)mrow * 6144; const float* shn = mn + (second ? 0 : 3 * 1024); const float* scn = mn + (second ? 1024 : 4 * 1024);
            f32x4 o[4];
#pragma unroll
            for (int j = 0; j < 4; ++j) { const int c4 = F.lane + 64 * j; const f32x4 g = ((const f32x4*)gpre)[c4], a = ((const f32x4*)scn)[c4], bsh = ((const f32x4*)shn)[c4];
#pragma unroll
                for (int e = 0; e < 4; ++e) o[j][e] = xn[j][e] * rstd2 * g[e] * (1.f + a[e]) + bsh[e];
                if (second && !win8(ln)) store4bf(WSP(bf16_t, WS_H) + (size_t)r * D + 4 * c4, o[j]);
            }
            if (!second) quant_row_store(F, o, WSP(unsigned char, WS_H2) + (size_t)r * D, WSP(float, WS_H2S) + r);
            else if (win8(ln)) quant_row_store(F, o, WSP(unsigned char, WS_H) + (size_t)r * D, WSP(float, WS_HS) + r);
            else if (r < RL) quant_row_store(F, o, WSP(unsigned char, WS_H8B) + (size_t)r * D, WSP(float, WS_HS) + r);
        }
    }
}
__device__ __forceinline__ void phase_fab_transpose(const Frame& F, int row0, int N, int nb, bf16_t* FT) {
    const bf16_t* FAB = WSP(bf16_t, WS_FAB);
    const long total = (long)nb * 2 * (N / 8) * 256; const long gt = (long)F.vcu * NTHR + F.tid, gs = (long)F.G * NTHR;
    for (long it = gt; it < total; it += gs) {
        const int col = (int)(it & 255); long q = it >> 8; const int nc = (int)(q % (N / 8)); q /= (N / 8); const int part = (int)(q & 1), b = (int)(q >> 1);
        const int g = col >> 6, j = col & 63; const int jj = j <= 32 ? j : 64 - j;
        const bool zer = part == 1 && (j == 0 || j == 32); const unsigned short flip = (part == 1 && j > 32) ? 0x8000u : 0u;
        const int slot = part == 0 ? jj : 32 + jj;
        unsigned short v[8];
#pragma unroll
        for (int i = 0; i < 8; ++i) v[i] = zer ? (unsigned short)0 : (unsigned short)(FAB[(size_t)(row0 + b * N + nc * 8 + i) * 256 + g * 64 + slot] ^ flip);
        u32x4 o; o.x = v[0] | ((unsigned)v[1] << 16); o.y = v[2] | ((unsigned)v[3] << 16); o.z = v[4] | ((unsigned)v[5] << 16); o.w = v[6] | ((unsigned)v[7] << 16);
        *(u32x4*)(FT + ((size_t)(b * 256 + col) * 2 * N + part * N + nc * 8)) = o;
    }
}
__device__ __forceinline__ void fold_unit(const Frame& F, int b, int g, int blk) {
    const bf16_t* FAB = WSP(bf16_t, WS_FAB); bf16_t* FT = WSP(bf16_t, WS_FABT); float* ALT = WSP(float, WS_TAB + 65536); float* A1024 = WSP(float, WS_TAB + 81920);
    LAS bf16_t* T = (LAS bf16_t*)F.lds;
    LAS float* red = (LAS float*)(F.lds + 131072);
    __syncthreads();
#pragma unroll 4
    for (int it = 0; it < 16; ++it) { const int n = it * 128 + (F.tid >> 2), ch = F.tid & 3;
        *(LAS u32x4*)(T + n * 32 + ch * 8) = *(const u32x4*)(FAB + (size_t)(b * SEQ + n) * 256 + g * 64 + blk * 32 + ch * 8); }
    __syncthreads();
    const int c = F.tid & 31; const bool cosrc = blk == 0 || c == 0;
    const int j1 = blk == 0 ? c : (c == 0 ? 32 : c); const int j2 = (c == 0) ? -1 : 64 - c;
    bf16_t* const d1 = FT + ((size_t)(b * 512 + g * 64 + j1)) * 2048 + (cosrc ? 0 : 1024);
    bf16_t* const d2 = FT + ((size_t)(b * 512 + g * 64 + (j2 < 0 ? 0 : j2))) * 2048 + (cosrc ? 0 : 1024);
#pragma unroll 2
    for (int it = 0; it < 8; ++it) { const int n0 = (it * 16 + (F.tid >> 5)) * 8; float v[8];
#pragma unroll
        for (int i = 0; i < 8; ++i) { const int n = n0 + i; const float x = bf2f(T[n * 32 + c]); const float y = n > 0 ? bf2f(T[(2048 - n) * 32 + c]) : 0.f; v[i] = cosrc ? x + y : (n > 0 ? x - y : 0.f); }
        u32x4 o; o.x = cvt_pk_bf16(v[0], v[1]); o.y = cvt_pk_bf16(v[2], v[3]); o.z = cvt_pk_bf16(v[4], v[5]); o.w = cvt_pk_bf16(v[6], v[7]);
        u32x4 on = o; on.x ^= 0x80008000u; on.y ^= 0x80008000u; on.z ^= 0x80008000u; on.w ^= 0x80008000u;
        if (cosrc) { *(u32x4*)(d1 + n0) = o; *(u32x4*)(d1 + (size_t)256 * 2048 + n0) = o; if (j2 >= 0) { *(u32x4*)(d2 + n0) = o; *(u32x4*)(d2 + (size_t)256 * 2048 + n0) = o; } }
        else { *(u32x4*)(d1 + n0) = o; *(u32x4*)(d1 + (size_t)256 * 2048 + n0) = on; *(u32x4*)(d2 + n0) = on; *(u32x4*)(d2 + (size_t)256 * 2048 + n0) = o; }
        if (blk == 1 && c == 0) {
            const u32x4 z = (u32x4){0u, 0u, 0u, 0u}; bf16_t* z0 = FT + ((size_t)(b * 512 + g * 64)) * 2048 + 1024 + n0; bf16_t* z1 = z0 + (size_t)32 * 2048;
            *(u32x4*)z0 = z; *(u32x4*)(z0 + (size_t)256 * 2048) = z; *(u32x4*)z1 = z; *(u32x4*)(z1 + (size_t)256 * 2048) = z; } }
    { const int q = F.tid >> 5; float sacc = 0.f;
      for (int n = q * 128; n < q * 128 + 128; n += 2) sacc += bf2f(T[n * 32 + c]) - bf2f(T[(n + 1) * 32 + c]);
      red[q * 32 + c] = sacc; __syncthreads();
      if (F.tid < 32 && (blk == 0 || F.tid == 0)) { float t = 0.f;
#pragma unroll
          for (int qq = 0; qq < 16; ++qq) t += red[qq * 32 + F.tid];
          const float a1024 = bf2f(T[1024 * 32 + F.tid]);
          ALT[b * 256 + g * 64 + j1] = t; A1024[b * 256 + g * 64 + j1] = a1024;
          if (j2 >= 0) { ALT[b * 256 + g * 64 + j2] = t; A1024[b * 256 + g * 64 + j2] = a1024; } } }
}
struct SchedDft2 {
    int G, c; const char* CS; const char* FT;
    __device__ __forceinline__ bool next(int i, Unit& u) const {
        const long L = (long)i * G + c; if (L >= 128) return false;
        const int b = (int)(L >> 3), pm = (int)((L >> 1) & 3), v = (int)(L & 1);
        u.pm = pm; u.pn = b * 2 + v; u.a = CS + (size_t)pm * 256 * 2048 * 2; u.b = FT + (size_t)(b * 512 + v * 256) * 2048 * 2; return true;
    }
};
struct EpiDft2 {
    unsigned char* ws;
    __device__ __forceinline__ void operator()(const Acc& acc, const Unit& u, int wr, int wc, int fr, int fq, LAS unsigned char* lds) const {
        bf16_t* const Y = EW(bf16_t, WS_Y); const float* const ALT = EW(float, WS_TAB + 65536); const float* const A1024 = EW(float, WS_TAB + 81920);
        const int b = u.pn >> 1, v = u.pn & 1; const float scale = 0.0027621358640099515f; const float sg = (fr & 1) ? -1.f : 1.f;
#pragma unroll
        EPI_LOOP_BN { const int col = 128 * bj + 32 * wc + 16 * n + 4 * fq; const f32x4 a4 = *(const f32x4*)(A1024 + b * 256 + col) * sg;
#pragma unroll
            EPI_LOOP_AM { const int k = 256 * u.pm + 128 * ai + 64 * wr + 16 * m + fr;
                f32x4 o = (acc[ai][bj][m][n] + a4) * scale; int row = v ? 2048 - k : k;
                if (v && k == 0) { row = 1024; o = *(const f32x4*)(ALT + b * 256 + col) * scale; }
                store4bf(Y + (size_t)(b * SEQ + row) * 1024 + 768 + col, o); } }
    }
};

template <int DQK, bool WIN>
__device__ __forceinline__ void attn_unit(LAS unsigned char* lds, const int tid,
        const bf16_t* qptr, const int ldq, const bf16_t* Kc, const bf16_t* Kl, const int ldk, const bf16_t* VT,
        const int nctx, const int lt0, const int lt1, const int qpos, const float m_init, const float l_init, bf16_t* optr) {
    constexpr int NS = DQK / 32, KB = 64 * DQK * 2, VB = 64 * 144, BUFB = KB + VB, KCH = DQK / 8;
    const int lane = tid & 63, quad = lane >> 4, l15 = lane & 15;
    const int nt = nctx + (lt1 - lt0);
    bf16x8 Qf[2][NS];
#pragma unroll
    for (int qt = 0; qt < 2; ++qt)
#pragma unroll
        for (int sx = 0; sx < NS; ++sx) Qf[qt][sx] = *(const bf16x8*)(qptr + (size_t)qt * 16 * ldq + 32 * sx);
    f32x4 O[4][2];
#pragma unroll
    for (int a = 0; a < 4; ++a) { O[a][0] = (f32x4){0.f, 0.f, 0.f, 0.f}; O[a][1] = (f32x4){0.f, 0.f, 0.f, 0.f}; }
    float mrun[2] = {m_init, m_init}, lrun[2] = {l_init, l_init};
    const int kkey0 = tid / KCH, kcc0 = tid % KCH, kkey1 = (tid + 512) / KCH, kcc1 = (tid + 512) % KCH;
    const bool k1on = (tid + 512) < 64 * KCH;
    int ko0, ko1;
    { int ob = (kkey0 & 15) * 64 + (kcc0 & 3) * 16; ob ^= ((ob >> 9) & 1) << 5; ko0 = ((kkey0 >> 4) * NS + (kcc0 >> 2)) * 1024 + ob; }
    { int ob = (kkey1 & 15) * 64 + (kcc1 & 3) * 16; ob ^= ((ob >> 9) & 1) << 5; ko1 = ((kkey1 >> 4) * NS + (kcc1 >> 2)) * 1024 + ob; }
    const int vdv = tid >> 3, vkc = tid & 7;
    int kfo; { int ob = l15 * 64 + quad * 16; ob ^= ((ob >> 9) & 1) << 5; kfo = ob; }
    const int vfo = l15 * 144 + quad * 8;
    u32x4 kr0, kr1, vr0, nk0, nk1, nv0;
    kr1 = (u32x4){0u, 0u, 0u, 0u}; nk1 = kr1;
#define ATT_LOAD(ti_, K0, K1, V0) do { const int ti__ = (ti_); const bool isc = ti__ < nctx; const int lt = lt0 + ti__ - nctx; \
        const bf16_t* kb = isc ? Kc + (size_t)ti__ * 64 * ldk : Kl + (size_t)lt * 64 * ldk; const int vcol = isc ? 64 * ti__ : 256 + 64 * lt; \
        K0 = *(const u32x4*)(kb + (size_t)kkey0 * ldk + 8 * kcc0); if (k1on) K1 = *(const u32x4*)(kb + (size_t)kkey1 * ldk + 8 * kcc1); \
        V0 = *(const u32x4*)(VT + (size_t)vdv * 2304 + vcol + 8 * vkc); } while (0)
#define ATT_WRITE(buf_, K0, K1, V0) do { LAS unsigned char* bp_ = lds + (buf_) * BUFB; *(LAS u32x4*)(bp_ + ko0) = K0; if (k1on) *(LAS u32x4*)(bp_ + ko1) = K1; *(LAS u32x4*)(bp_ + KB + vdv * 144 + vkc * 16) = V0; } while (0)
#define ATT_BAR() do { asm volatile("s_waitcnt lgkmcnt(0)" ::: "memory"); __builtin_amdgcn_s_barrier(); asm volatile("" ::: "memory"); } while (0)
    __syncthreads();
    ATT_LOAD(0, kr0, kr1, vr0); ATT_WRITE(0, kr0, kr1, vr0);
    if (nt > 1) ATT_LOAD(1, kr0, kr1, vr0);
    ATT_BAR();
#pragma unroll 1
    for (int ti = 0; ti < nt; ++ti) {
        if (ti + 2 < nt) ATT_LOAD(ti + 2, nk0, nk1, nv0);
        const LAS unsigned char* bp = lds + (ti & 1) * BUFB;
        f32x4 S[4][2];
        bf16x8 kfr[4][NS];
#pragma unroll
        for (int kt = 0; kt < 4; ++kt)
#pragma unroll
            for (int sx = 0; sx < NS; ++sx) kfr[kt][sx] = *(const LAS bf16x8*)(bp + (kt * NS + sx) * 1024 + kfo);
        __builtin_amdgcn_sched_barrier(0);
        __builtin_amdgcn_s_setprio(1);
#pragma unroll
        for (int kt = 0; kt < 4; ++kt) { S[kt][0] = (f32x4){-mrun[0], -mrun[0], -mrun[0], -mrun[0]}; S[kt][1] = (f32x4){-mrun[1], -mrun[1], -mrun[1], -mrun[1]}; }
#pragma unroll
        for (int sx = 0; sx < NS; ++sx)
#pragma unroll
            for (int kt = 0; kt < 4; ++kt) {
                S[kt][0] = __builtin_amdgcn_mfma_f32_16x16x32_bf16(kfr[kt][sx], Qf[0][sx], S[kt][0], 0, 0, 0);
                S[kt][1] = __builtin_amdgcn_mfma_f32_16x16x32_bf16(kfr[kt][sx], Qf[1][sx], S[kt][1], 0, 0, 0); }
        __builtin_amdgcn_s_setprio(0);
        u32x2 vfr[2][4][2];
#pragma unroll
        for (int ks = 0; ks < 2; ++ks)
#pragma unroll
            for (int a = 0; a < 4; ++a) { vfr[ks][a][0] = *(const LAS u32x2*)(bp + KB + a * 16 * 144 + ks * 64 + vfo); vfr[ks][a][1] = *(const LAS u32x2*)(bp + KB + a * 16 * 144 + ks * 64 + 32 + vfo); }
        __builtin_amdgcn_sched_barrier(0);
        if (WIN && ti >= nctx) { const int kp0 = 64 * (lt0 + ti - nctx) + 4 * quad;
#pragma unroll
            for (int qt = 0; qt < 2; ++qt) { const int qp = qpos + 16 * qt;
#pragma unroll
                for (int kt = 0; kt < 4; ++kt)
#pragma unroll
                    for (int j = 0; j < 4; ++j) { const int dl = kp0 + 16 * kt + j - qp; if (dl > 128 || dl < -128) S[kt][qt][j] = -1e30f; } } }
        unsigned Pw[2][2][4];
        float ps[2];
#define ATT_EXP() do { _Pragma("unroll") for (int qt = 0; qt < 2; ++qt) { float acc_ = 0.f; \
            _Pragma("unroll") for (int kt = 0; kt < 4; ++kt) { const float p0 = fexp2(S[kt][qt][0]), p1 = fexp2(S[kt][qt][1]), p2 = fexp2(S[kt][qt][2]), p3 = fexp2(S[kt][qt][3]); \
                acc_ += (p0 + p1) + (p2 + p3); Pw[qt][kt >> 1][(kt & 1) * 2] = cvt_pk_bf16(p0, p1); Pw[qt][kt >> 1][(kt & 1) * 2 + 1] = cvt_pk_bf16(p2, p3); } ps[qt] = acc_; } } while (0)
        ATT_EXP();
        if (ti == 0 || __any(!(ps[0] < 1.0e18f) || !(ps[1] < 1.0e18f))) {
#pragma unroll
            for (int qt = 0; qt < 2; ++qt) {
                float mx = fmaxf(fmaxf(S[0][qt][0], S[0][qt][1]), fmaxf(S[0][qt][2], S[0][qt][3]));
#pragma unroll
                for (int kt = 1; kt < 4; ++kt) mx = fmaxf(mx, fmaxf(fmaxf(S[kt][qt][0], S[kt][qt][1]), fmaxf(S[kt][qt][2], S[kt][qt][3])));
                mx = fmaxf(mx, __shfl_xor(mx, 16)); mx = fmaxf(mx, __shfl_xor(mx, 32));
                const float d = (ti == 0 && !WIN) ? mx : fmaxf(mx, 0.f);
                const float al = (ti == 0 && !WIN) ? 0.f : fexp2(-d); mrun[qt] += d; lrun[qt] *= al;
#pragma unroll
                for (int a = 0; a < 4; ++a) O[a][qt] = O[a][qt] * al;
#pragma unroll
                for (int kt = 0; kt < 4; ++kt) S[kt][qt] = S[kt][qt] - d; }
            ATT_EXP();
        }
#undef ATT_EXP
        lrun[0] += ps[0]; lrun[1] += ps[1];
        __builtin_amdgcn_s_setprio(1);
#pragma unroll
        for (int ks = 0; ks < 2; ++ks) {
            bf16x8 pf0, pf1;
            { u32x4 t0 = (u32x4){Pw[0][ks][0], Pw[0][ks][1], Pw[0][ks][2], Pw[0][ks][3]}, t1 = (u32x4){Pw[1][ks][0], Pw[1][ks][1], Pw[1][ks][2], Pw[1][ks][3]};
              pf0 = __builtin_bit_cast(bf16x8, t0); pf1 = __builtin_bit_cast(bf16x8, t1); }
#pragma unroll
            for (int a = 0; a < 4; ++a) {
                const u32x4 vv = (u32x4){vfr[ks][a][0].x, vfr[ks][a][0].y, vfr[ks][a][1].x, vfr[ks][a][1].y}; const bf16x8 vf = __builtin_bit_cast(bf16x8, vv);
                O[a][0] = __builtin_amdgcn_mfma_f32_16x16x32_bf16(vf, pf0, O[a][0], 0, 0, 0);
                O[a][1] = __builtin_amdgcn_mfma_f32_16x16x32_bf16(vf, pf1, O[a][1], 0, 0, 0); }
        }
        __builtin_amdgcn_s_setprio(0);
        if (ti + 1 < nt) ATT_WRITE((ti + 1) & 1, kr0, kr1, vr0);
        ATT_BAR();
        kr0 = nk0; kr1 = nk1; vr0 = nv0;
    }
#undef ATT_LOAD
#undef ATT_WRITE
#pragma unroll
    for (int qt = 0; qt < 2; ++qt) { float l = lrun[qt]; l += __shfl_xor(l, 16); l += __shfl_xor(l, 32); const float inv = frcp(l);
#pragma unroll
        for (int a = 0; a < 4; ++a) { const f32x4 o = O[a][qt] * inv; u32x2 w; w.x = cvt_pk_bf16(o[0], o[1]); w.y = cvt_pk_bf16(o[2], o[3]); *(u32x2*)(optr + (size_t)qt * 16 * 1024 + 16 * a) = w; } }
}
__device__ __forceinline__ void mla_unit(const Frame& F, int b, int h, int q0, bool ctxq) {
    const bf16_t* Q96 = WSP(bf16_t, WS_Q96); const bf16_t* K96 = WSP(bf16_t, WS_K96); const bf16_t* VT = WSP(bf16_t, WS_V); bf16_t* Y = WSP(bf16_t, WS_Y);
    const int quad = F.lane >> 4, l15 = F.lane & 15; const int qrow = (ctxq ? RL + b * CTX : b * SEQ + q0) + 32 * F.wave + l15;
    attn_unit<96, false>(F.lds, F.tid, Q96 + (size_t)qrow * 384 + h * 96 + 8 * quad, 384, K96 + (size_t)(RL + b * CTX) * 384 + h * 96, K96 + (size_t)(b * SEQ) * 384 + h * 96, 384,
                         VT + (size_t)((b * 4 + h) * 64) * 2304, 4, 0, ctxq ? 0 : 32, 0, 0.f, 0.f, Y + (size_t)qrow * 1024 + h * 64 + 4 * quad);
}
__device__ __forceinline__ void gqa_unit(const Frame& F, int l, int b, int kvh, int p0, bool ctxq) {
    const bf16_t* GQ = WSP(bf16_t, WS_GQ); const bf16_t* GK = WSP(bf16_t, WS_GK); const bf16_t* GVT = WSP(bf16_t, WS_GV); bf16_t* Y = WSP(bf16_t, WS_Y);
    const int quad = F.lane >> 4, l15 = F.lane & 15; const int hq = 2 * kvh + (F.wave >> 2); const int pos = p0 + 32 * (F.wave & 3) + l15;
    const int qrow = (ctxq ? RL + b * CTX : b * SEQ) + pos; const float sink = inp(17)[l * 4 + hq] * LOG2E;
    const int lt0 = ctxq ? 0 : max(0, p0 - 128) / 64, lt1 = ctxq ? 0 : min(SEQ, p0 + 256) / 64;
    attn_unit<64, true>(F.lds, F.tid, GQ + (size_t)qrow * 256 + hq * 64 + 8 * quad, 256, GK + (size_t)(RL + b * CTX) * 128 + kvh * 64, GK + (size_t)(b * SEQ) * 128 + kvh * 64, 128,
                        GVT + (size_t)((b * 2 + kvh) * 64) * 2304, 4, lt0, lt1, pos, sink, quad == 0 ? 1.f : 0.f, Y + (size_t)qrow * 1024 + 512 + hq * 64 + 4 * quad);
}
__device__ __forceinline__ float logsigmoidf_(float x) { return fminf(x, 0.f) - log1pf(__expf(-fabsf(x))); }
__device__ __forceinline__ void mlstm_naive_unit(const Frame& F, int l, int b, int h, bool ctx_out) {
    const bf16_t* MQK = WSP(bf16_t, WS_MQK); const bf16_t* MV = WSP(bf16_t, WS_MV); const bf16_t* MO = WSP(bf16_t, WS_MO); const float* MG = WSP(float, WS_MG);
    float* HF = WSP(float, WS_HF); bf16_t* Y = WSP(bf16_t, WS_Y);
    const float* wcv = inp(15) + (size_t)l * 3 * 512; const float* bgate = inp(16) + (size_t)l * 16;
    LAS float* qs = (LAS float*)F.lds; LAS float* ks = qs + 8192; LAS float* vs = ks + 8192; LAS float* Cs = vs + 8192; LAS float* ns = Cs + 4096;
    LAS float* gs = ns + 64; LAS float* Ms = gs + 128; LAS float* cums = Ms + 128; LAS float* lis = cums + 128; LAS float* lfs = lis + 128; LAS float* mst = lfs + 128;
    const int tid = F.tid;
    for (int dir = 0; dir < 2; ++dir) {
        __syncthreads();
        for (int i = tid; i < 4096; i += NTHR) Cs[i] = 0.f;
        if (tid < 64) ns[tid] = 0.f;
        if (tid == 0) mst[0] = 0.f;
        __syncthreads();
        for (int j = 0; j < 18; ++j) {
            const bool isctx = j < 2; const int nseq = isctx ? CTX : SEQ; const int cj = isctx ? j : j - 2; const int base = isctx ? RL + b * CTX : b * SEQ;
            for (int i = tid; i < 128 * 64; i += NTHR) { const int p = i >> 6, d = i & 63; const int sp = cj * 128 + p; const int t = dir ? nseq - 1 - sp : sp; const size_t r = (size_t)(base + t);
                const int cq = h * 64 + d, ck = 256 + h * 64 + d;
                float aq = wcv[512 + cq] * bf2f(MQK[r * 512 + cq]), ak = wcv[512 + ck] * bf2f(MQK[r * 512 + ck]);
                if (t > 0) { aq += wcv[cq] * bf2f(MQK[(r - 1) * 512 + cq]); ak += wcv[ck] * bf2f(MQK[(r - 1) * 512 + ck]); }
                if (t < nseq - 1) { aq += wcv[1024 + cq] * bf2f(MQK[(r + 1) * 512 + cq]); ak += wcv[1024 + ck] * bf2f(MQK[(r + 1) * 512 + ck]); }
                qs[i] = siluf_(aq); ks[i] = siluf_(ak) * 0.125f; vs[i] = bf2f(MV[r * 256 + h * 64 + d]); }
            if (tid < 128) { const int sp = cj * 128 + tid; const int t = dir ? nseq - 1 - sp : sp; const size_t r = (size_t)(base + t);
                lis[tid] = MG[r * 16 + 8 * dir + h] + bgate[8 * dir + h]; lfs[tid] = logsigmoidf_(MG[r * 16 + 8 * dir + 4 + h] + bgate[8 * dir + 4 + h]); }
            __syncthreads();
            if (tid == 0) { float cum = 0.f, pm = -INFINITY; const float m0 = mst[0];
                for (int p = 0; p < 128; ++p) { cum += lfs[p]; const float g = lis[p] - cum; pm = fmaxf(pm, g); cums[p] = cum; gs[p] = g; Ms[p] = fmaxf(m0, pm); } }
            __syncthreads();
            const float m0 = mst[0];
            { const int p = tid >> 2, eg = tid & 3; float q[16], num[16]; float den = 0.f; const float Mp = Ms[p];
#pragma unroll
              for (int d = 0; d < 16; d += 4) { const f32x4 t4 = *(const LAS f32x4*)(qs + p * 64 + 16 * eg + d); q[d] = t4[0]; q[d + 1] = t4[1]; q[d + 2] = t4[2]; q[d + 3] = t4[3]; }
#pragma unroll
              for (int e = 0; e < 16; ++e) num[e] = 0.f;
              const int pmax = (p | 15);
              for (int s = 0; s <= pmax; ++s) { float dot = 0.f;
#pragma unroll
                  for (int d = 0; d < 16; d += 4) { const f32x4 kv = *(const LAS f32x4*)(ks + s * 64 + 16 * eg + d); dot += q[d] * kv[0] + q[d + 1] * kv[1] + q[d + 2] * kv[2] + q[d + 3] * kv[3]; }
                  dot += __shfl_xor(dot, 1); dot += __shfl_xor(dot, 2);
                  const float S = s <= p ? dot * __expf(gs[s] - Mp) : 0.f; den += S;
#pragma unroll
                  for (int e = 0; e < 16; e += 4) { const f32x4 vv = *(const LAS f32x4*)(vs + s * 64 + 16 * eg + e); num[e] += S * vv[0]; num[e + 1] += S * vv[1]; num[e + 2] += S * vv[2]; num[e + 3] += S * vv[3]; } }
              const float wint = __expf(m0 - Mp); float qn = 0.f;
              for (int d = 0; d < 64; ++d) { const float qd = qs[p * 64 + d]; qn += qd * ns[d]; const float wq = wint * qd;
#pragma unroll
                  for (int e = 0; e < 16; e += 4) { const f32x4 cv = *(const LAS f32x4*)(Cs + d * 64 + 16 * eg + e); num[e] += wq * cv[0]; num[e + 1] += wq * cv[1]; num[e + 2] += wq * cv[2]; num[e + 3] += wq * cv[3]; } }
              den += wint * qn; const float dn = fmaxf(fabsf(den), __expf(-(cums[p] + Mp))); const float inv = 1.f / dn;
              const int sp = cj * 128 + p; const int t = dir ? nseq - 1 - sp : sp; const size_t r = (size_t)(base + t);
              if (!isctx || ctx_out) {
                  if (dir == 0) {
#pragma unroll
                      for (int e = 0; e < 16; e += 4) *(f32x4*)(HF + r * 256 + h * 64 + 16 * eg + e) = (f32x4){num[e] * inv, num[e + 1] * inv, num[e + 2] * inv, num[e + 3] * inv};
                  } else {
#pragma unroll
                      for (int e = 0; e < 16; e += 4) { const f32x4 hf = *(const f32x4*)(HF + r * 256 + h * 64 + 16 * eg + e); const u32x2 ow = *(const u32x2*)(MO + r * 256 + h * 64 + 16 * eg + e);
                          f32x4 o; o[0] = lo_bf(ow.x) * (hf[0] + num[e] * inv); o[1] = hi_bf(ow.x) * (hf[1] + num[e + 1] * inv); o[2] = lo_bf(ow.y) * (hf[2] + num[e + 2] * inv); o[3] = hi_bf(ow.y) * (hf[3] + num[e + 3] * inv);
                          store4bf(Y + r * 1024 + 256 + h * 64 + 16 * eg + e, o); }
                  }
              }
            }
            __syncthreads();
            { const int d = tid >> 3, e0 = (tid & 7) * 8; const float M127 = Ms[127]; const float decay = __expf(m0 - M127);
              float a[8]; float an = 0.f;
#pragma unroll
              for (int e = 0; e < 8; ++e) a[e] = 0.f;
              for (int s = 0; s < 128; ++s) { const float wk = __expf(gs[s] - M127) * ks[s * 64 + d]; an += wk;
                  const f32x4 v0 = *(const LAS f32x4*)(vs + s * 64 + e0), v1 = *(const LAS f32x4*)(vs + s * 64 + e0 + 4);
                  a[0] += wk * v0[0]; a[1] += wk * v0[1]; a[2] += wk * v0[2]; a[3] += wk * v0[3]; a[4] += wk * v1[0]; a[5] += wk * v1[1]; a[6] += wk * v1[2]; a[7] += wk * v1[3]; }
#pragma unroll
              for (int e = 0; e < 8; ++e) Cs[d * 64 + e0 + e] = decay * Cs[d * 64 + e0 + e] + a[e];
              if ((tid & 7) == 0) ns[d] = decay * ns[d] + an;
              __syncthreads();
              if (tid == 0) mst[0] = cums[127] + M127;
            }
            __syncthreads();
        }
    }
}
__device__ __forceinline__ int swz16(int row16, int byte_in_row) { const int ob = row16 * 64 + byte_in_row; return ob ^ (((ob >> 9) & 1) << 5); }
__device__ __forceinline__ void conv_silu8(const bf16_t* MQK, const float* EDQ, const float* wcv, size_t r, int t, int nseq, int col0, float scale, float (&o)[8]) {
    const int rr = (int)(r & 255);
    if (rr != 0 && rr != 255) {
        const u32x4 x = *(const u32x4*)(MQK + r * 512 + col0);
        o[0] = lo_bf(x.x); o[1] = hi_bf(x.x); o[2] = lo_bf(x.y); o[3] = hi_bf(x.y); o[4] = lo_bf(x.z); o[5] = hi_bf(x.z); o[6] = lo_bf(x.w); o[7] = hi_bf(x.w);
    } else {
        const int pm = (int)(r >> 8), tq = col0 >> 8, cc = col0 & 255; const float* e = EDQ + (size_t)(pm * 2 + tq) * 1024 + cc;
        f32x4 p0 = (f32x4){0.f, 0.f, 0.f, 0.f}, p1 = p0, n0 = p0, n1 = p0, c0v, c1v;
        if (rr == 0) { if (t > 0) { p0 = *(const f32x4*)(e - 2048 + 768); p1 = *(const f32x4*)(e - 2048 + 768 + 4); } c0v = *(const f32x4*)e; c1v = *(const f32x4*)(e + 4); n0 = *(const f32x4*)(e + 256); n1 = *(const f32x4*)(e + 256 + 4); }
        else { p0 = *(const f32x4*)(e + 512); p1 = *(const f32x4*)(e + 512 + 4); c0v = *(const f32x4*)(e + 768); c1v = *(const f32x4*)(e + 768 + 4); if (t < nseq - 1) { n0 = *(const f32x4*)(e + 2048); n1 = *(const f32x4*)(e + 2048 + 4); } }
        const f32x4 wa0 = *(const f32x4*)(wcv + col0), wa1 = *(const f32x4*)(wcv + col0 + 4), wb0 = *(const f32x4*)(wcv + 512 + col0), wb1 = *(const f32x4*)(wcv + 512 + col0 + 4), wc0 = *(const f32x4*)(wcv + 1024 + col0), wc1 = *(const f32x4*)(wcv + 1024 + col0 + 4);
#pragma unroll
        for (int i = 0; i < 4; ++i) { o[i] = siluf_(wa0[i] * p0[i] + wb0[i] * c0v[i] + wc0[i] * n0[i]) * scale; o[4 + i] = siluf_(wa1[i] * p1[i] + wb1[i] * c1v[i] + wc1[i] * n1[i]) * scale; }
    }
}
__device__ __forceinline__ void mlstm_gate_load(int tid, const float* MG, size_t r0, int h, float (&gv)[4]) {
    gv[0] = gv[1] = gv[2] = gv[3] = 0.f;
    if (tid < 128) { const int dir = tid >> 6, l = tid & 63; const int t0 = dir ? 127 - 2 * l : 2 * l, t1 = dir ? 126 - 2 * l : 2 * l + 1;
        gv[0] = MG[(r0 + t0) * 16 + 8 * dir + h]; gv[1] = MG[(r0 + t1) * 16 + 8 * dir + h]; gv[2] = MG[(r0 + t0) * 16 + 8 * dir + 4 + h]; gv[3] = MG[(r0 + t1) * 16 + 8 * dir + 4 + h]; }
}
__device__ __forceinline__ void mlstm_gate_scan(int tid, const float (&gv)[4], const float* bgate, int h, LAS float* gF, LAS float* gB, LAS float* cF, LAS float* cB, LAS float* pF, LAS float* pB) {
    if (tid < 128) {
        const int dir = tid >> 6, l = tid & 63; const int t0 = dir ? 127 - 2 * l : 2 * l, t1 = dir ? 126 - 2 * l : 2 * l + 1;
        const float bi = bgate[8 * dir + h], bfg = bgate[8 * dir + 4 + h];
        const float li0 = gv[0] + bi, li1 = gv[1] + bi; const float lf0 = logsigmoidf_(gv[2] + bfg), lf1 = logsigmoidf_(gv[3] + bfg);
        float sc = lf0 + lf1;
#pragma unroll
        for (int d = 1; d < 64; d <<= 1) { const float t = __shfl_up(sc, d); if (l >= d) sc += t; }
        const float c1 = sc, c0 = sc - lf1; const float g0 = li0 - c0, g1 = li1 - c1;
        float mx = fmaxf(g0, g1);
#pragma unroll
        for (int d = 1; d < 64; d <<= 1) { const float t = __shfl_up(mx, d); if (l >= d) mx = fmaxf(mx, t); }
        float mprev = __shfl_up(mx, 1); if (l == 0) mprev = -INFINITY;
        const float p0 = fmaxf(mprev, g0), p1 = mx;
        LAS float* g = dir ? gB : gF; LAS float* c = dir ? cB : cF; LAS float* p = dir ? pB : pF;
        g[t0] = g0; g[t1] = g1; c[t0] = c0; c[t1] = c1; p[t0] = p0; p[t1] = p1;
    }
    __syncthreads();
}
__device__ __forceinline__ void mlstm_passA_unit(const Frame& F, int l, int b, int h, int jj) {
    const bf16_t* MQK = WSP(bf16_t, WS_MQK); const bf16_t* MV = WSP(bf16_t, WS_MV); const float* MG = WSP(float, WS_MG);
    const float* wcv = inp(15) + (size_t)l * 3 * 512; const float* bgate = inp(16) + (size_t)l * 16;
    const bool isctx = jj < 2; const int nseq = isctx ? CTX : SEQ; const int c = isctx ? jj : jj - 2; const size_t r0 = (size_t)(isctx ? RL + b * CTX : b * SEQ) + 128 * c;
    LAS unsigned char* Vt = F.lds;
    LAS unsigned char* Kw = F.lds + 16384;
    LAS float* gF = (LAS float*)(F.lds + 49152); LAS float* gB = gF + 128; LAS float* cF = gB + 128; LAS float* cB = cF + 128; LAS float* pF = cB + 128; LAS float* pB = pF + 128;
    const int tid = F.tid;
    float gv[4]; mlstm_gate_load(tid, MG, r0, h, gv);
    const int sx = tid >> 2, part = tid & 3; const size_t r = r0 + sx; const int t = 128 * c + sx;
    float kv[2][8]; u32x4 vv2[2];
#pragma unroll
    for (int hh = 0; hh < 2; ++hh) { const int d0 = 16 * part + 8 * hh; conv_silu8(MQK, WSP(float, WS_EDQ), wcv, r, t, nseq, 256 + h * 64 + d0, 0.125f, kv[hh]); vv2[hh] = *(const u32x4*)(MV + r * 256 + h * 64 + d0); }
    __syncthreads();
    mlstm_gate_scan(tid, gv, bgate, h, gF, gB, cF, cB, pF, pB);
    const float pmF = pF[127], pmB = pB[0];
    { const float wF = fexp(gF[sx] - pmF), wB = fexp(gB[sx] - pmB);
#pragma unroll
      for (int hh = 0; hh < 2; ++hh) { const int d0 = 16 * part + 8 * hh;
#pragma unroll
          for (int i = 0; i < 8; ++i) { const int d = d0 + i; const int off = ((d >> 4) * 4 + (sx >> 5)) * 1024 + swz16(d & 15, (sx & 31) * 2);
              *(LAS bf16_t*)(Kw + off) = (bf16_t)f2bf(kv[hh][i] * wF); *(LAS bf16_t*)(Kw + 16384 + off) = (bf16_t)f2bf(kv[hh][i] * wB); }
          const unsigned vw[4] = {vv2[hh].x, vv2[hh].y, vv2[hh].z, vv2[hh].w};
#pragma unroll
          for (int i = 0; i < 8; ++i) { const int e = d0 + i; const int off = ((e >> 4) * 4 + (sx >> 5)) * 1024 + swz16(e & 15, (sx & 31) * 2);
              *(LAS bf16_t*)(Vt + off) = (bf16_t)((i & 1) ? (vw[i >> 1] >> 16) : (vw[i >> 1] & 0xffffu)); } } }
    __syncthreads();
    const int dir = F.wave >> 2, et = F.wave & 3, quad = F.lane >> 4, l15 = F.lane & 15; const int kfo = swz16(l15, quad * 16);
    const int chain = (b * 4 + h) * 2 + dir; const int j = dir == 0 ? jj : (isctx ? 1 - c : 17 - c);
    f32x4 acc[4];
#pragma unroll
    for (int dt = 0; dt < 4; ++dt) acc[dt] = (f32x4){0.f, 0.f, 0.f, 0.f};
#pragma unroll
    for (int ks = 0; ks < 4; ++ks) { const bf16x8 af = *(const LAS bf16x8*)(Vt + (et * 4 + ks) * 1024 + kfo);
#pragma unroll
        for (int dt = 0; dt < 4; ++dt) { const bf16x8 bf = *(const LAS bf16x8*)(Kw + dir * 16384 + (dt * 4 + ks) * 1024 + kfo); acc[dt] = __builtin_amdgcn_mfma_f32_16x16x32_bf16(af, bf, acc[dt], 0, 0, 0); } }
    bf16_t* KVL = WSP(bf16_t, WS_KVL) + ((size_t)chain * 18 + j) * 4096;
#pragma unroll
    for (int dt = 0; dt < 4; ++dt)
#pragma unroll
        for (int i = 0; i < 4; ++i) KVL[(16 * et + 4 * quad + i) * 64 + 16 * dt + l15] = (bf16_t)f2bf(acc[dt][i]);
    if (tid < 128) { const int dr = tid >> 6, d = tid & 63; float sacc = 0.f;
        for (int sx = 0; sx < 128; ++sx) sacc += bf2f(*(const LAS bf16_t*)(Kw + dr * 16384 + ((d >> 4) * 4 + (sx >> 5)) * 1024 + swz16(d & 15, (sx & 31) * 2)));
        const int ch2 = (b * 4 + h) * 2 + dr; const int j2 = dr == 0 ? jj : (isctx ? 1 - c : 17 - c);
        WSP(float, WS_NL)[((size_t)ch2 * 18 + j2) * 64 + d] = sacc;
        if (d == 0) { float* scl = WSP(float, WS_SCL) + ((size_t)ch2 * 18 + j2) * 2; scl[0] = dr == 0 ? cF[127] : cB[0]; scl[1] = dr == 0 ? pmF : pmB; } }
}
__device__ __forceinline__ void mlstm_passB_unit(const Frame& F, int chain, int half) {
    const bf16_t* KVL = WSP(bf16_t, WS_KVL) + (size_t)chain * 18 * 4096; bf16_t* CT = WSP(bf16_t, WS_CT) + (size_t)chain * 18 * 4096;
    const float* NL = WSP(float, WS_NL) + (size_t)chain * 18 * 64; float* NS = WSP(float, WS_NS) + (size_t)chain * 18 * 64; const float* SCL = WSP(float, WS_SCL) + (size_t)chain * 18 * 2; float* MS = WSP(float, WS_MS) + (size_t)chain * 18;
    const int idx = half * 2048 + F.tid * 4; const bool nthr = half == 0 && F.tid < 64;
    f32x4 C = (f32x4){0.f, 0.f, 0.f, 0.f}; float nst = 0.f, mst = 0.f;
    u32x2 kv[18]; float nl[18]; f32x2 sc[18];
#pragma unroll
    for (int j = 0; j < 18; ++j) { kv[j] = *(const u32x2*)(KVL + (size_t)j * 4096 + idx); nl[j] = nthr ? NL[j * 64 + F.tid] : 0.f; sc[j] = *(const f32x2*)(SCL + j * 2); }
#pragma unroll
    for (int j = 0; j < 18; ++j) {
        u32x2 cw; cw.x = cvt_pk_bf16(C[0], C[1]); cw.y = cvt_pk_bf16(C[2], C[3]); *(u32x2*)(CT + (size_t)j * 4096 + idx) = cw;
        if (nthr) NS[j * 64 + F.tid] = nst;
        if (half == 0 && F.tid == 0) MS[j] = mst;
        const float Mx = fmaxf(mst, sc[j][1]), decay = fexp(mst - Mx), sl = fexp(sc[j][1] - Mx);
        C[0] = decay * C[0] + sl * lo_bf(kv[j].x); C[1] = decay * C[1] + sl * hi_bf(kv[j].x); C[2] = decay * C[2] + sl * lo_bf(kv[j].y); C[3] = decay * C[3] + sl * hi_bf(kv[j].y);
        nst = decay * nst + sl * nl[j]; mst = sc[j][0] + Mx;
    }
}
__device__ __forceinline__ void mlstm_passC_unit(const Frame& F, int l, int b, int h, int jj) {
    const bf16_t* MQK = WSP(bf16_t, WS_MQK); const bf16_t* MV = WSP(bf16_t, WS_MV); const bf16_t* MO = WSP(bf16_t, WS_MO); const float* MG = WSP(float, WS_MG); bf16_t* Y = WSP(bf16_t, WS_Y);
    const float* wcv = inp(15) + (size_t)l * 3 * 512; const float* bgate = inp(16) + (size_t)l * 16;
    const bool isctx = jj < 2; const int nseq = isctx ? CTX : SEQ; const int c = isctx ? jj : jj - 2; const size_t r0 = (size_t)(isctx ? RL + b * CTX : b * SEQ) + 128 * c;
    const int chF = (b * 4 + h) * 2, chB = chF + 1; const int jF = jj, jB = isctx ? 1 - c : 17 - c;
    LAS unsigned char* Qs = F.lds;
    LAS unsigned char* Ks = F.lds + 16384;
    LAS unsigned char* Vt = F.lds + 32768;
    LAS unsigned char* CF = F.lds + 50176;
    LAS unsigned char* CB = F.lds + 58368;
    LAS float* gF = (LAS float*)(F.lds + 66560); LAS float* gB = gF + 128; LAS float* cF = gB + 128; LAS float* cB = cF + 128; LAS float* pF = cB + 128; LAS float* pB = pF + 128; LAS float* nF = pB + 128; LAS float* nB = nF + 64;
    const int tid = F.tid;
    float gv[4]; mlstm_gate_load(tid, MG, r0, h, gv);
    __syncthreads();
    { const int sx = tid >> 2, cg = tid & 3; const size_t r = r0 + sx; const int t = 128 * c + sx;
      const bool isk = cg >= 2; const int dbase = 32 * (cg & 1); LAS unsigned char* dst = isk ? Ks : Qs;
#pragma unroll
      for (int q4 = 0; q4 < 4; ++q4) { const int d0 = dbase + 8 * q4; float o[8]; conv_silu8(MQK, WSP(float, WS_EDQ), wcv, r, t, nseq, (isk ? 256 : 0) + h * 64 + d0, isk ? 0.125f : 1.f, o);
          u32x4 w; w.x = cvt_pk_bf16(o[0], o[1]); w.y = cvt_pk_bf16(o[2], o[3]); w.z = cvt_pk_bf16(o[4], o[5]); w.w = cvt_pk_bf16(o[6], o[7]);
          *(LAS u32x4*)(dst + ((sx >> 4) * 2 + (d0 >> 5)) * 1024 + swz16(sx & 15, (d0 & 31) * 2)) = w; }
#pragma unroll
      for (int hh = 0; hh < 2; ++hh) { const int e0 = 16 * cg + 8 * hh; const u32x4 vv = *(const u32x4*)(MV + r * 256 + h * 64 + e0); const unsigned vw[4] = {vv.x, vv.y, vv.z, vv.w};
#pragma unroll
          for (int i = 0; i < 8; ++i) *(LAS bf16_t*)(Vt + (e0 + i) * 272 + sx * 2) = (bf16_t)((i & 1) ? (vw[i >> 1] >> 16) : (vw[i >> 1] & 0xffffu)); }
      { const int e = tid >> 3, dc = tid & 7; const int off = ((e >> 4) * 2 + (dc >> 2)) * 1024 + swz16(e & 15, (dc & 3) * 16);
        *(LAS u32x4*)(CF + off) = *(const u32x4*)(WSP(bf16_t, WS_CT) + ((size_t)chF * 18 + jF) * 4096 + e * 64 + dc * 8);
        *(LAS u32x4*)(CB + off) = *(const u32x4*)(WSP(bf16_t, WS_CT) + ((size_t)chB * 18 + jB) * 4096 + e * 64 + dc * 8); }
      if (tid < 64) nF[tid] = WSP(float, WS_NS)[((size_t)chF * 18 + jF) * 64 + tid]; else if (tid < 128) nB[tid - 64] = WSP(float, WS_NS)[((size_t)chB * 18 + jB) * 64 + tid - 64];
    }
    const float mF = WSP(float, WS_MS)[chF * 18 + jF], mB = WSP(float, WS_MS)[chB * 18 + jB];
    mlstm_gate_scan(tid, gv, bgate, h, gF, gB, cF, cB, pF, pB);
    const int w = F.wave, quad = F.lane >> 4, l15 = F.lane & 15; const int kfo = swz16(l15, quad * 16); const int p = 16 * w + l15;
    u32x2 mo[4];
#pragma unroll
    for (int et = 0; et < 4; ++et) mo[et] = *(const u32x2*)(MO + (r0 + p) * 256 + h * 64 + 16 * et + 4 * quad);
    bf16x8 Qf[2];
#pragma unroll
    for (int sx = 0; sx < 2; ++sx) Qf[sx] = *(const LAS bf16x8*)(Qs + (w * 2 + sx) * 1024 + kfo);
    f32x4 S[8];
#pragma unroll
    for (int st = 0; st < 8; ++st) { S[st] = (f32x4){0.f, 0.f, 0.f, 0.f};
#pragma unroll
        for (int sx = 0; sx < 2; ++sx) { const bf16x8 kf = *(const LAS bf16x8*)(Ks + (st * 2 + sx) * 1024 + kfo); S[st] = __builtin_amdgcn_mfma_f32_16x16x32_bf16(kf, Qf[sx], S[st], 0, 0, 0); } }
    const float MFp = fmaxf(mF, pF[p]), MBp = fmaxf(mB, pB[p]);
    __builtin_amdgcn_sched_barrier(0);
    float sF = 0.f, sB = 0.f;
#pragma unroll
    for (int st = 0; st < 8; ++st) { const f32x4 g4 = *(const LAS f32x4*)(gF + 16 * st + 4 * quad), h4 = *(const LAS f32x4*)(gB + 16 * st + 4 * quad);
#pragma unroll
        for (int i = 0; i < 4; ++i) { const int sx = 16 * st + 4 * quad + i;
            float eF = fexp(g4[i] - MFp), eB = fexp(h4[i] - MBp); eF = sx <= p ? eF : 0.f; eB = sx >= p ? eB : 0.f;
            sF += S[st][i] * eF; sB += S[st][i] * eB; } }
    __builtin_amdgcn_sched_barrier(0);
    sF += __shfl_xor(sF, 16); sF += __shfl_xor(sF, 32); sB += __shfl_xor(sB, 16); sB += __shfl_xor(sB, 32);
    float qnF = 0.f, qnB = 0.f; float qv[2][8];
#pragma unroll
    for (int sx = 0; sx < 2; ++sx) { const u32x4 qw = __builtin_bit_cast(u32x4, Qf[sx]); const unsigned qq[4] = {qw.x, qw.y, qw.z, qw.w};
        const f32x4 nf0 = *(const LAS f32x4*)(nF + 32 * sx + 8 * quad), nf1 = *(const LAS f32x4*)(nF + 32 * sx + 8 * quad + 4), nb0 = *(const LAS f32x4*)(nB + 32 * sx + 8 * quad), nb1 = *(const LAS f32x4*)(nB + 32 * sx + 8 * quad + 4);
#pragma unroll
        for (int i = 0; i < 8; ++i) { const float qf = (i & 1) ? hi_bf(qq[i >> 1]) : lo_bf(qq[i >> 1]); qv[sx][i] = qf; qnF += qf * (i < 4 ? nf0[i & 3] : nf1[i & 3]); qnB += qf * (i < 4 ? nb0[i & 3] : nb1[i & 3]); } }
    qnF += __shfl_xor(qnF, 16); qnF += __shfl_xor(qnF, 32); qnB += __shfl_xor(qnB, 16); qnB += __shfl_xor(qnB, 32);
    const float wiF = fexp(mF - MFp), wiB = fexp(mB - MBp);
    const float rF = frcp(fmaxf(fabsf(sF + wiF * qnF), fexp(-(cF[p] + MFp)))), rB = frcp(fmaxf(fabsf(sB + wiB * qnB), fexp(-(cB[p] + MBp))));
    const float qsF = wiF * rF, qsB = wiB * rB;
    __builtin_amdgcn_sched_barrier(0);
    f32x4 O[4];
#pragma unroll
    for (int et = 0; et < 4; ++et) O[et] = (f32x4){0.f, 0.f, 0.f, 0.f};
#pragma unroll
    for (int sx = 0; sx < 2; ++sx) { u32x4 a, bq;
        a.x = cvt_pk_bf16(qv[sx][0] * qsF, qv[sx][1] * qsF); a.y = cvt_pk_bf16(qv[sx][2] * qsF, qv[sx][3] * qsF); a.z = cvt_pk_bf16(qv[sx][4] * qsF, qv[sx][5] * qsF); a.w = cvt_pk_bf16(qv[sx][6] * qsF, qv[sx][7] * qsF);
        bq.x = cvt_pk_bf16(qv[sx][0] * qsB, qv[sx][1] * qsB); bq.y = cvt_pk_bf16(qv[sx][2] * qsB, qv[sx][3] * qsB); bq.z = cvt_pk_bf16(qv[sx][4] * qsB, qv[sx][5] * qsB); bq.w = cvt_pk_bf16(qv[sx][6] * qsB, qv[sx][7] * qsB);
        const bf16x8 qF8 = __builtin_bit_cast(bf16x8, a), qB8 = __builtin_bit_cast(bf16x8, bq);
#pragma unroll
        for (int et = 0; et < 4; ++et) { const bf16x8 cf = *(const LAS bf16x8*)(CF + (et * 2 + sx) * 1024 + kfo), cb = *(const LAS bf16x8*)(CB + (et * 2 + sx) * 1024 + kfo);
            O[et] = __builtin_amdgcn_mfma_f32_16x16x32_bf16(cf, qF8, O[et], 0, 0, 0); O[et] = __builtin_amdgcn_mfma_f32_16x16x32_bf16(cb, qB8, O[et], 0, 0, 0); } }
    __builtin_amdgcn_sched_barrier(0);
#pragma unroll
    for (int ks = 0; ks < 4; ++ks) { __builtin_amdgcn_sched_barrier(0); u32x4 pw; float pv[8];
#pragma unroll
        for (int hh = 0; hh < 2; ++hh) { const int st = 2 * ks + hh; const f32x4 g4 = *(const LAS f32x4*)(gF + 16 * st + 4 * quad), h4 = *(const LAS f32x4*)(gB + 16 * st + 4 * quad);
#pragma unroll
            for (int i = 0; i < 4; ++i) { const int sx = 16 * st + 4 * quad + i;
                float eF = fexp(g4[i] - MFp) * rF, eB = fexp(h4[i] - MBp) * rB; eF = sx <= p ? eF : 0.f; eB = sx >= p ? eB : 0.f; pv[4 * hh + i] = S[st][i] * (eF + eB); } }
        pw.x = cvt_pk_bf16(pv[0], pv[1]); pw.y = cvt_pk_bf16(pv[2], pv[3]); pw.z = cvt_pk_bf16(pv[4], pv[5]); pw.w = cvt_pk_bf16(pv[6], pv[7]);
        const bf16x8 pf = __builtin_bit_cast(bf16x8, pw);
#pragma unroll
        for (int et = 0; et < 4; ++et) { const LAS unsigned char* vp = Vt + (16 * et + l15) * 272 + ks * 64 + quad * 8; const u32x2 v0 = *(const LAS u32x2*)vp, v1 = *(const LAS u32x2*)(vp + 32);
            const u32x4 vv = (u32x4){v0.x, v0.y, v1.x, v1.y}; O[et] = __builtin_amdgcn_mfma_f32_16x16x32_bf16(__builtin_bit_cast(bf16x8, vv), pf, O[et], 0, 0, 0); } }
    { const size_t r = r0 + p;
#pragma unroll
      for (int et = 0; et < 4; ++et) { const int e = 16 * et + 4 * quad; const u32x2 ow = mo[et];
          f32x4 o; o[0] = lo_bf(ow.x) * O[et][0]; o[1] = hi_bf(ow.x) * O[et][1]; o[2] = lo_bf(ow.y) * O[et][2]; o[3] = hi_bf(ow.y) * O[et][3];
          store4bf(Y + r * 1024 + 256 + h * 64 + e, o); } }
}
__device__ __forceinline__ void phase_mlstm_A(const Frame& F, int l, int rot) { for (int u = rotc(F, rot); u < 64 * 18; u += F.G) mlstm_passA_unit(F, l, u / 72, (u / 18) & 3, u % 18); }
__device__ __forceinline__ void phase_mlstm_B(const Frame& F, int rot) { for (int u = rotc(F, rot); u < 256; u += F.G) mlstm_passB_unit(F, u >> 1, u & 1); }
__device__ __forceinline__ void phase_mlstm_C(const Frame& F, int l, bool ctx_out, int rot) {
    const int per = ctx_out ? 18 : 16, j0 = ctx_out ? 0 : 2;
    for (int u = rotc(F, rot); u < 64 * per; u += F.G) mlstm_passC_unit(F, l, u / (4 * per), (u / per) & 3, j0 + u % per);
}
__device__ __forceinline__ void phase_fold(const Frame& F, int rot) { for (int u = rotc(F, rot); u < 128; u += F.G) fold_unit(F, u >> 3, (u >> 1) & 3, u & 1); }
__device__ __forceinline__ void phase_mla(const Frame& F, bool ctx_out) {
    const int nm = 512 + (ctx_out ? 64 : 0);
    for (int q = F.vcu; q < nm; q += F.G) { const bool cq = q >= 512; const int qq = q - 512;
        mla_unit(F, cq ? qq >> 2 : q >> 5, cq ? qq & 3 : (q >> 3) & 3, cq ? 0 : (q & 7) * 256, cq); }
}
__device__ __forceinline__ void phase_gqa(const Frame& F, int l, bool ctx_out) {
    const int nm = 512 + (ctx_out ? 64 : 0);
    if (F.G == 256) {
        const int v = F.vcu; int q0, qs, nq;
        if (v < 128) { q0 = v; qs = 128; nq = 3; } else { q0 = 384 + (v - 128); qs = 128; nq = (q0 + 128 < nm) ? 2 : 1; }
        for (int i = 0; i < nq; ++i) { const int q = q0 + i * qs; const bool cq = q >= 512; const int qq = q - 512;
            gqa_unit(F, l, cq ? qq >> 2 : q >> 5, cq ? (qq >> 1) & 1 : (q >> 4) & 1, cq ? (qq & 1) * 128 : (q & 15) * 128, cq); }
    } else {
        for (int q = F.vcu; q < nm; q += F.G) { const bool cq = q >= 512; const int qq = q - 512;
            gqa_unit(F, l, cq ? qq >> 2 : q >> 5, cq ? (qq >> 1) & 1 : (q >> 4) & 1, cq ? (qq & 1) * 128 : (q & 15) * 128, cq); }
    }
}

struct Params { const float* in[26]; float* out; unsigned char* ws; int ph_lo, ph_hi, li, pad; };

__global__ void __launch_bounds__(NTHR, 2) mk_fwd(Params P) {
    extern __shared__ __attribute__((aligned(16))) unsigned char lds_raw[];
    volatile LAS unsigned* MISC = (volatile LAS unsigned*)((LAS unsigned char*)lds_raw + MISC_OFF);
    if (threadIdx.x < 64) MISC[threadIdx.x] = 0u;
    __syncthreads();
    XcdBarrier bar = xcd_barrier_post((unsigned*)(P.ws + WS_CTL) + CW_BAR + P.li * XCD_BAR_WORDS, MISC + 8);
    const int lo = P.ph_lo, hi = P.ph_hi; int ph = 0;
#define MAKE_FRAME Frame F; { int t_ = threadIdx.x, b_ = blockIdx.x; asm volatile("" : "+v"(t_)); asm volatile("" : "+s"(b_)); F.lds = (LAS unsigned char*)lds_raw; F.tid = t_; F.lane = t_ & 63; \
        F.wave = __builtin_amdgcn_readfirstlane(t_ >> 6); F.G = gridDim.x; F.vcu = (F.G % 8 == 0) ? (b_ % 8) * (F.G / 8) + b_ / 8 : b_; F.xl = P.out; F.ws = P.ws; }
#ifndef SITE_MASK
#define SITE_MASK 0x1FFFFFF
#endif
#ifndef REP_MASK
#define REP_MASK 0
#endif
#define SITE(k) if (SITE_MASK & (1 << (k))) for (int rep_ = 0; rep_ <= ((REP_MASK >> (k)) & 1); ++rep_)
#define PHASE_BEGIN if (ph >= lo && ph < hi) {
#define PHASE_END   if (ph + 1 < hi) xcd_barrier(bar); } ++ph;

    PHASE_BEGIN SITE(0) { MAKE_FRAME
        mod_gemv(F);
        __syncthreads();
        convert_layer_weights(F, 0, F.vcu, F.G, F.G == 256 ? 1 : 15);
        build_cs2(F, WSP(bf16_t, WS_CS));
        build_cs(F, WSP(bf16_t, WS_CSC), CTX);
        build_tables(F);
    } PHASE_END
    PHASE_BEGIN SITE(1) { MAKE_FRAME
        phase_norm1_in(F);
        if (win8(0)) { __syncthreads();
        quant_rows_i8(F, WSP(float, WS_FTMP), F.ws + WS_W + W_IN + (size_t)2048 * 1024, WSP(float, WS_WSCW) + 2048, 256, F.vcu, F.G); }
    } PHASE_END

    for (int l = 0; l < DEPTH; ++l) {
        const bool ctx_out = l < DEPTH - 1;
        const unsigned char* wl = P.ws + WS_W + (size_t)l * W_LAYER;
        const int mrows = ctx_out ? R : RL;
        const int mtiles = ctx_out ? TR : TL;

        PHASE_BEGIN SITE(2) { MAKE_FRAME
            if (!win8(l)) {
                SchedWin S{ctx_out ? TR : TL, ctx_out ? 0 : TC, 5, F.G, F.vcu, (const char*)WSP(unsigned char, WS_H), (const char*)(wl + W_IN), 2048};
                EpiWin E{F.ws, l};
                pg8::gemm_phase(F.lds, 1024, 1024, 1024, S, E); }
        }
        SITE(24) { MAKE_FRAME
            if (win8(l)) {
                SchedWin S{ctx_out ? TR : TL, ctx_out ? 0 : TC, 5, F.G, F.vcu, (const char*)WSP(unsigned char, WS_H), (const char*)(wl + W_IN), 1024};
                EpiWin E{F.ws, l};
                pg8::gemm_phase<EpiWin, SchedWin, 1>(F.lds, 512, 512, 512, S, E, WSP(float, WS_HS), WSP(float, WS_WSCW) + l * 2560); }
        }
        SITE(21) { MAKE_FRAME
            if (l == 0 && F.G == 256 && F.vcu >= 160) { __syncthreads(); convert_layer_weights(F, 0, F.vcu - 160, 96, 2); }
        } PHASE_END

        PHASE_BEGIN
          SITE(3) { MAKE_FRAME
            { SchedMN S{0, ctx_out ? TR : TL, 2, F.G, rotc(F, 192)  , (const char*)WSP(bf16_t, WS_CQ), (const char*)(wl + W_UQ), (size_t)256 * 256 * 2, (size_t)256 * 256 * 2, 0};
              EpiUq E{F.ws};
              pg8::gemm_phase(F.lds, 256, 256, 256, S, E); }
            { SchedMN S{0, TR, 2, F.G, rotc(F, 160)  , (const char*)WSP(bf16_t, WS_CKV), (const char*)(wl + W_UKV), (size_t)256 * 256 * 2, (size_t)256 * 256 * 2, 0};
              EpiUkv E{F.ws};
              pg8::gemm_phase(F.lds, 256, 256, 256, S, E); }
            if (ctx_out) phase_fab_transpose(F, RL, CTX, NB, WSP(bf16_t, WS_FABT + 32 * MiB));
          }
          SITE(19) { MAKE_FRAME
            phase_fold(F, 64);
          }
          SITE(4) { MAKE_FRAME
            phase_mlstm_A(F, l, 128);
          }
        PHASE_END

        PHASE_BEGIN
          SITE(17) { MAKE_FRAME
            phase_mlstm_B(F, 0);
          }
          SITE(14) { MAKE_FRAME
            __syncthreads();
            SchedDft2 S{F.G, rotc(F, 128), (const char*)WSP(bf16_t, WS_CS), (const char*)WSP(bf16_t, WS_FABT)};
            EpiDft2 E{F.ws};
            pg8::gemm_phase(F.lds, 2048, 2048, 2048, S, E);
          }
          SITE(13) { MAKE_FRAME
            if (ctx_out) { __syncthreads(); SchedDft S{NB, 1, F.G, rotc(F, 192), (const char*)WSP(bf16_t, WS_CSC), (const char*)WSP(bf16_t, WS_FABT + 32 * MiB), (size_t)256 * 512 * 2, (size_t)256 * 512 * 2};
              EpiDft E{F.ws, RL, CTX, 0.0078125f};
              pg8::gemm_phase(F.lds, 512, 512, 512, S, E); }
          }
          SITE(16) { MAKE_FRAME
            __syncthreads();
            phase_gqa(F, l, ctx_out);
          }
        PHASE_END

        PHASE_BEGIN
          SITE(18) { MAKE_FRAME
            phase_mlstm_C(F, l, ctx_out, 128);
          }
          SITE(15) { MAKE_FRAME
            __syncthreads();
            phase_mla(F, ctx_out);
          }
        PHASE_END

        { const int nch = ctx_out ? 3 : 2, cht = ctx_out ? 48 : 64;
          for (int ch = 0; ch < nch; ++ch) {
            PHASE_BEGIN SITE(5) { MAKE_FRAME
                SchedBranch S{ch * cht, cht, F.G, F.vcu, (const char*)WSP(bf16_t, WS_Y), (const char*)(wl + W_B)};
                EpiBranch E{F.ws, ch * cht * 256, cht * 256};
                pg8::gemm_phase(F.lds, 256, 1024, 256, S, E);
            } PHASE_END
            PHASE_BEGIN SITE(6) { MAKE_FRAME
                SchedMN S{ch * cht, cht, 16, F.G, F.vcu, (const char*)(F.ws + (win8(l) ? WS_H : (l == 0 ? WS_H8A : WS_H8B))), (const char*)(wl + W_G), (size_t)256 * 1024, (size_t)256 * 1024, 0};
                EpiGate E{F.ws, inp(19) + (size_t)l * 4 * 1024, ch * cht * 256, cht * 256, WSP(float, WS_HS), WSP(float, WS_WSCG) + l * 4096};
                pg8::gemm_phase<EpiGate, SchedMN, 1>(F.lds, 512, 512, 512, S, E, WSP(float, WS_HS), WSP(float, WS_WSCG) + l * 4096);
            } PHASE_END
          } }

        PHASE_BEGIN SITE(7) { MAKE_FRAME
            SchedMN S{0, mtiles, 4, F.G, F.vcu, (const char*)WSP(bf16_t, WS_ACC), (const char*)(wl + W_OUT), (size_t)256 * 1024 * 2, (size_t)256 * 1024 * 2, 0};
            EpiPlain E{WSP(bf16_t, WS_YO), 1024, 0};
            pg8::gemm_phase(F.lds, 1024, 1024, 1024, S, E);
        }
        SITE(22) { MAKE_FRAME
            if (l == 0 && F.G == 256 && F.vcu >= 64) { __syncthreads(); convert_layer_weights(F, 0, F.vcu - 64, 192, 12); }
        } PHASE_END

        PHASE_BEGIN SITE(8) { MAKE_FRAME
            phase_post(F, l, WSP(bf16_t, WS_YO), mrows, false, l == 0);
        } PHASE_END

        PHASE_BEGIN SITE(9) { MAKE_FRAME
            SchedMN S{0, mtiles, 22, F.G, F.vcu, (const char*)WSP(unsigned char, WS_H2), (const char*)(wl + W_UP), (size_t)256 * 1024, (size_t)256 * 1024, 0};
            EpiUpConv E{F.ws, inp(23) + (size_t)l * 3 * DFF, inp(24) + (size_t)l * DFF};
            pg8::gemm_phase<EpiUpConv, SchedMN, 1>(F.lds, 512, 512, 512, S, E, WSP(float, WS_H2S), WSP(float, WS_WSCU) + l * 5632);
        } PHASE_END
        PHASE_BEGIN SITE(10) { MAKE_FRAME
            phase_conv_fixup(F, l, 0, mtiles);
        } PHASE_END

        PHASE_BEGIN SITE(11) { MAKE_FRAME
            SchedMN S{0, mtiles, 4, F.G, F.vcu, (const char*)WSP(bf16_t, WS_G), (const char*)(wl + W_DOWN), (size_t)256 * 2816 * 2, (size_t)256 * 2816 * 2, 0};
            EpiPlain E{WSP(bf16_t, WS_F), 1024, 0};
            pg8::gemm_phase(F.lds, 2816, 2816, 2816, S, E);
        }
        SITE(20) { MAKE_FRAME
            if (l + 1 < DEPTH && F.G == 256 && F.vcu >= 64) { __syncthreads(); convert_layer_weights(F, l + 1, F.vcu - 64, F.G - 64, 15); }
            else if (l + 1 < DEPTH && F.G != 256) { __syncthreads(); convert_layer_weights(F, l + 1, F.vcu, F.G, 15); }
        } PHASE_END

        PHASE_BEGIN SITE(12) { MAKE_FRAME
            phase_post(F, l, WSP(bf16_t, WS_F), mrows, true, false);
            if (l + 1 < DEPTH && win8(l + 1)) { __syncthreads(); quant_rows_i8(F, WSP(float, WS_FTMP) + (size_t)(l + 1) * 256 * 1024, F.ws + WS_W + (size_t)(l + 1) * W_LAYER + W_IN + (size_t)2048 * 1024, WSP(float, WS_WSCW) + (l + 1) * 2560 + 2048, 256, F.vcu, F.G); }
        } PHASE_END
    }
#undef PHASE_BEGIN
#undef PHASE_END
}

constexpr int N_PHASES = 32;

extern "C" void kernel_launch(void* const* d_in, const int* in_sizes, int n_in, void* d_out, int out_size, void* d_ws, size_t ws_size, hipStream_t stream) {
    static int grid = 0;
    if (grid == 0) {
        if (n_in != 26 || out_size != RL * D || ws_size < WS_END) { fprintf(stderr, "kernel_launch: unexpected problem (n_in %d out %d ws %zu need %zu)\n", n_in, out_size, ws_size, (size_t)WS_END); grid = -1; return; }
        int dev = 0, cus = 0;
        if (hipGetDevice(&dev) != hipSuccess || hipDeviceGetAttribute(&cus, hipDeviceAttributeMultiprocessorCount, dev) != hipSuccess) { grid = -1; return; }
        if (hipFuncSetAttribute((const void*)mk_fwd, hipFuncAttributeMaxDynamicSharedMemorySize, LDS_BYTES) != hipSuccess) { fprintf(stderr, "kernel_launch: hipFuncSetAttribute failed\n"); grid = -1; return; }
        int per_cu = 0;
        if (hipOccupancyMaxActiveBlocksPerMultiprocessor(&per_cu, (const void*)mk_fwd, NTHR, LDS_BYTES) != hipSuccess || per_cu < 1) { fprintf(stderr, "kernel_launch: occupancy query says %d\n", per_cu); (void)hipGetLastError(); grid = -1; return; }
        grid = cus;
    }
    if (grid < 0) return;
    (void)hipMemsetAsync((char*)d_ws + WS_CTL, 0, CTL_BYTES, stream);
    Params p{};
    for (int i = 0; i < 26; ++i) p.in[i] = (const float*)d_in[i];
    p.out = (float*)d_out; p.ws = (unsigned char*)d_ws; p.pad = 0;
#if MK_SINGLE_LAUNCH
    p.ph_lo = 0; p.ph_hi = N_PHASES; p.li = 0;
    hipLaunchKernelGGL(mk_fwd, dim3(grid), dim3(NTHR), LDS_BYTES, stream, p);
#else
    {
        int sites[N_PHASES]; int n = 0; sites[n++] = 0; sites[n++] = 1;
        for (int l = 0; l < DEPTH; ++l) { const bool co = l < DEPTH - 1; const int seq1[4] = {2, 3, 17, 18};
            for (int i = 0; i < 4; ++i) sites[n++] = seq1[i];
            for (int ch = 0; ch < (co ? 3 : 2); ++ch) { sites[n++] = 5; sites[n++] = 6; }
            sites[n++] = 7; sites[n++] = 8; sites[n++] = 9; sites[n++] = 10; sites[n++] = 11; sites[n++] = 12; }
        for (int i = 0; i < N_PHASES; ++i) { p.ph_lo = i; p.ph_hi = i + 1; p.li = i;
            const int reps = ((PROBE_DUP_SITES >> sites[i]) & 1) ? 2 : 1;
            for (int r = 0; r < reps; ++r) hipLaunchKernelGGL(mk_fwd, dim3(grid), dim3(NTHR), LDS_BYTES, stream, p); }
    }
#endif
}
```

```cpp
#include <hip/hip_runtime.h>
#include <cstdio>
#include <cstdint>

#ifndef PROBE_DUP_SITES
#define PROBE_DUP_SITES 0
#endif
#ifndef WIN_I8_MASK
#define WIN_I8_MASK 2
#endif
__host__ __device__ constexpr bool win8(int l) { return ((WIN_I8_MASK >> l) & 1) != 0; }
#ifndef MK_SINGLE_LAUNCH
#define MK_SINGLE_LAUNCH 1
#endif

#define LAS __attribute__((address_space(3)))
#define GAS __attribute__((address_space(1)))
typedef unsigned short bf16_t;
typedef short bf16x8 __attribute__((ext_vector_type(8)));
typedef float f32x4 __attribute__((ext_vector_type(4)));
typedef float f32x2 __attribute__((ext_vector_type(2)));
typedef unsigned u32x4 __attribute__((ext_vector_type(4)));
typedef unsigned u32x2 __attribute__((ext_vector_type(2)));

constexpr int D = 1024, NB = 16, SEQ = 2048, CTX = 256, DEPTH = 2, DFF = 2816;
constexpr int NIN_SRC = 2352, NIN = 2560;
constexpr int RL = NB * SEQ, RC = NB * CTX, R = RL + RC;
constexpr int TL = RL / 256, TC = RC / 256, TR = R / 256;
constexpr float EPS = 1e-6f;
constexpr float LOG2E = 1.4426950408889634f;
constexpr float QS_M = 0.10206207261596575f * LOG2E;
constexpr float QS_G = 0.125f * LOG2E;
constexpr int NTHR = 512;

constexpr size_t MiB = 1u << 20;
constexpr size_t WS_CTL = 0, CTL_BYTES = 2 * MiB;
constexpr size_t WS_MOD = 2 * MiB;
constexpr size_t WS_TAB = 3 * MiB;
constexpr size_t WS_HS = WS_TAB + 128 * 1024, WS_H2S = WS_TAB + 320 * 1024;
constexpr size_t WS_WSCG = WS_TAB + 512 * 1024, WS_WSCU = WS_TAB + 576 * 1024, WS_WSCW = WS_TAB + 640 * 1024;
constexpr size_t WS_XC = 4 * MiB;
constexpr size_t WS_W = 20 * MiB, W_LAYER = 35 * MiB;
constexpr size_t W_IN = 0, W_UQ = 5632 * 1024, W_UKV = W_UQ + 256 * 1024, W_G = 6 * MiB, W_B = 14 * MiB, W_OUT = 16 * MiB, W_UP = 18 * MiB, W_DOWN = 29 * MiB;
constexpr size_t WS_CS = 94 * MiB;
constexpr size_t WS_H8A = WS_W + W_LAYER;
constexpr size_t WS_H8B = WS_W;
constexpr size_t WS_FTMP = 98 * MiB;
constexpr size_t WS_CSC = 106 * MiB;
constexpr size_t WS_H = 107 * MiB;
constexpr size_t WS_H2 = WS_H;
constexpr size_t WS_Y = 179 * MiB;
constexpr size_t WS_SCR = 251 * MiB;
static_assert(WS_H8A + (size_t)R * 1024 <= WS_CS && WS_H8B + (size_t)RL * 1024 <= WS_W + W_LAYER && WS_CS + 4 * MiB <= WS_FTMP && WS_FTMP + 2 * MiB <= WS_CSC && WS_H + (size_t)R * 2048 <= WS_Y, "map");
constexpr size_t WS_CQ = WS_Y, WS_CKV = WS_Y + 18 * MiB, WS_FAB = WS_Y + 36 * MiB;
constexpr size_t WS_SSP = WS_SCR, WS_MQK = WS_SCR + 2 * MiB, WS_MV = WS_SCR + 38 * MiB, WS_MO = WS_SCR + 56 * MiB, WS_MG = WS_SCR + 74 * MiB,
                 WS_GQ = WS_SCR + 77 * MiB, WS_GK = WS_SCR + 95 * MiB, WS_GV = WS_SCR + 104 * MiB, WS_FABT = WS_SCR + 113 * MiB,
                 WS_Q96 = WS_SCR + 149 * MiB, WS_K96 = WS_SCR + 176 * MiB, WS_V = WS_SCR + 203 * MiB, WS_HF = WS_SCR + 221 * MiB,
                 WS_KVL = WS_SCR + 221 * MiB  , WS_CT = WS_SCR + 239 * MiB  ,
                 WS_EDQ = WS_CTL + 768 * 1024  ,
                 WS_NL = WS_SCR + 257 * MiB  , WS_NS = WS_NL + MiB  , WS_SCL = WS_NS + MiB  , WS_MS = WS_SCL + 64 * 1024  ;
constexpr size_t WS_BV = WS_SCR, WS_ACC = WS_SCR + 128 * MiB, WS_YO = WS_SCR;
constexpr size_t WS_G = WS_Y, WS_EDGE = WS_SCR + 128 * MiB  , WS_F = WS_SCR + 140 * MiB;
constexpr size_t WS_END = WS_SCR + 260 * MiB;
static_assert(WS_G + (size_t)R * DFF * 2 <= WS_EDGE, "G vs EDGE");
static_assert(WS_EDGE + (size_t)TR * 22 * 6 * 128 * 4 <= WS_F && WS_F + (size_t)R * 1024 * 2 <= WS_END, "EDGE / F");
static_assert(WS_MS + 128 * 18 * 4 <= WS_END && WS_EDQ + (size_t)TR * 2 * 4 * 256 * 4 <= WS_CTL + CTL_BYTES && (size_t)(1024 + 40 * 3456) * 4 <= WS_EDQ, "mlstm scan buffers / EDQ (barrier words: u32 index 1024 + 3456 per launch region)");

constexpr int CW_BAR = 1024;

constexpr int LDS_BYTES = 160 * 1024;
constexpr int RING_BYTES = 131072;
constexpr int MISC_OFF = LDS_BYTES - 256;

__device__ __forceinline__ float bf2f(bf16_t v) { return __uint_as_float((unsigned)v << 16); }
__device__ __forceinline__ unsigned f2bf(float f) { unsigned u = __float_as_uint(f); return (u + 0x7fffu + ((u >> 16) & 1u)) >> 16; }
__device__ __forceinline__ unsigned pk2(float lo, float hi) { return f2bf(lo) | (f2bf(hi) << 16); }
__device__ __forceinline__ float lo_bf(unsigned w) { return __uint_as_float(w << 16); }
__device__ __forceinline__ float hi_bf(unsigned w) { return __uint_as_float(w & 0xffff0000u); }
__device__ __forceinline__ float fexp2(float x) { return __builtin_amdgcn_exp2f(x); }
__device__ __forceinline__ float fexp(float x) { return __builtin_amdgcn_exp2f(x * LOG2E); }
__device__ __forceinline__ float frcp(float x) { return __builtin_amdgcn_rcpf(x); }
__device__ __forceinline__ float sigmoidf_(float x) { return frcp(1.0f + fexp(-x)); }
__device__ __forceinline__ float siluf_(float x) { return x * frcp(1.0f + fexp(-x)); }
__device__ __forceinline__ unsigned cvt_pk_bf16(float lo, float hi) { unsigned r; asm("v_cvt_pk_bf16_f32 %0, %1, %2" : "=v"(r) : "v"(lo), "v"(hi)); return r; }
__device__ __forceinline__ float wave_sum(float v) {
#pragma unroll
    for (int o = 1; o < 64; o <<= 1) v += __shfl_xor(v, o);
    return v;
}
__device__ __forceinline__ unsigned pack4_i8(float a, float b, float c, float d) {
    const int ia = (int)rintf(a), ib = (int)rintf(b), ic = (int)rintf(c), id = (int)rintf(d);
    return (unsigned)(ia & 0xff) | ((unsigned)(ib & 0xff) << 8) | ((unsigned)(ic & 0xff) << 16) | ((unsigned)(id & 0xff) << 24);
}
__device__ __forceinline__ unsigned pack4_fp8(float a, float b, float c, float d) { int w = 0; w = __builtin_amdgcn_cvt_pk_fp8_f32(a, b, w, false); w = __builtin_amdgcn_cvt_pk_fp8_f32(c, d, w, true); return (unsigned)w; }
__device__ __forceinline__ void store8bf(bf16_t* p, f32x4 a, f32x4 b) { u32x4 w; w.x = cvt_pk_bf16(a[0], a[1]); w.y = cvt_pk_bf16(a[2], a[3]); w.z = cvt_pk_bf16(b[0], b[1]); w.w = cvt_pk_bf16(b[2], b[3]); *(u32x4*)p = w; }
__device__ __forceinline__ void store4bf(bf16_t* p, f32x4 v) { u32x2 w; w.x = cvt_pk_bf16(v[0], v[1]); w.y = cvt_pk_bf16(v[2], v[3]); *(u32x2*)p = w; }

#define XB_TMO      128
#define XB_XCNT(j)  (256  + 64 * (j))
#define XB_XSUB(j)  (1280 + 64 * (j))
#define XB_XGEN(j)  (2304 + 64 * (j))
#define XB_TOP      3328
#define XB_TOPGEN   3392
#define XCD_BAR_WORDS 3456
#define XB_SPIN_CAP (1u << 21)

__device__ __forceinline__ unsigned xb_ld(unsigned* p)              { return __hip_atomic_load(p, __ATOMIC_RELAXED, __HIP_MEMORY_SCOPE_AGENT); }
__device__ __forceinline__ unsigned xb_add(unsigned* p, unsigned v) { return __hip_atomic_fetch_add(p, v, __ATOMIC_RELAXED, __HIP_MEMORY_SCOPE_AGENT); }
__device__ __forceinline__ unsigned xb_xcc_id() { return (unsigned)__builtin_amdgcn_s_getreg((3 << 11) | 20) & 0xFu; }
#define XB_SPIN(cond, bar) do { unsigned _sp = 0; while (cond) { __builtin_amdgcn_s_sleep(1); \
    if ((++_sp & 255u) == 0u) { if (xb_ld(&(bar)[XB_TMO])) break; if (_sp > XB_SPIN_CAP) { atomicAdd(&(bar)[XB_TMO], 1u); break; } } } } while (0)

struct XcdBarrier { unsigned* bar; unsigned x; volatile LAS unsigned* st; };

__device__ __forceinline__ XcdBarrier xcd_barrier_post(unsigned* bar, volatile LAS unsigned* st) {
    XcdBarrier b; b.bar = bar; b.x = xb_xcc_id(); b.st = st;
    if (threadIdx.x == 0) (void)xb_add(&bar[XB_XCNT(b.x)], 1u);
    return b;
}
__device__ __forceinline__ void xcd_barrier_complete(unsigned* bar, unsigned x, unsigned& nloc, unsigned& nx) {
    const unsigned G = gridDim.x * gridDim.y * gridDim.z;
    unsigned sum, cnt, mine, sp = 0u;
    for (;;) {
        sum = 0u; cnt = 0u; mine = 0u;
#pragma unroll
        for (unsigned j = 0; j < 16; ++j) { const unsigned c = xb_ld(&bar[XB_XCNT(j)]); sum += c; cnt += (c > 0u) ? 1u : 0u; mine = (j == x) ? c : mine; }
        if (sum == G) break;
        __builtin_amdgcn_s_sleep(1);
        if ((++sp & 255u) == 0u) { if (xb_ld(&bar[XB_TMO])) break; if (sp > XB_SPIN_CAP) { atomicAdd(&bar[XB_TMO], 1u); break; } }
    }
    nloc = mine > 0u ? mine : 1u; nx = cnt > 0u ? cnt : 1u;
}
__device__ __forceinline__ void xcd_barrier(const XcdBarrier& b) {
    asm volatile("s_waitcnt vmcnt(0)" ::: "memory");
    __syncthreads();
    if (threadIdx.x == 0) {
        unsigned* bar = b.bar;
        __builtin_amdgcn_s_waitcnt(0);
        unsigned nloc = b.st[0], nx = b.st[1];
        if (nloc == 0u) { xcd_barrier_complete(bar, b.x, nloc, nx); b.st[0] = nloc; b.st[1] = nx; }
        const unsigned old = xb_add(&bar[XB_XSUB(b.x)], 1u);
        const unsigned gen = old / nloc;
        if (old + 1u == (gen + 1u) * nloc) {
            __builtin_amdgcn_fence(__ATOMIC_RELEASE, "agent");
            asm volatile("s_waitcnt vmcnt(0)" ::: "memory");
            const unsigned og = xb_add(&bar[XB_TOP], 1u);
            const unsigned tg = og / nx;
            if (og + 1u == (tg + 1u) * nx) xb_add(&bar[XB_TOPGEN], 1u);
            else XB_SPIN(xb_ld(&bar[XB_TOPGEN]) == tg, bar);
            __builtin_amdgcn_fence(__ATOMIC_ACQUIRE, "agent");
            xb_add(&bar[XB_XGEN(b.x)], 1u);
            asm volatile("s_waitcnt vmcnt(0)" ::: "memory");
        } else {
            XB_SPIN(xb_ld(&bar[XB_XGEN(b.x)]) == gen, bar);
            __builtin_amdgcn_fence(__ATOMIC_ACQUIRE, "agent");
            asm volatile("s_waitcnt vmcnt(0)" ::: "memory");
        }
    }
    __syncthreads();
}

namespace pg8 {
constexpr int BM = 256, BK = 64, HALF = 128, HTB = HALF * BK * 2, STAGE_BYTES = 8 * HTB;
__host__ __device__ __forceinline__ int lds_byte(int r, int c) { const int st = (r >> 4) * 2 + (c >> 5), rr = r & 15, cc = c & 31, ob = rr * 64 + cc * 2; return st * 1024 + (ob ^ (((ob >> 9) & 1) << 5)); }
__host__ __device__ __forceinline__ void stage_rc(int b, int& Rr, int& C) { const int st = b / 1024, sb = b % 1024, swz = sb ^ (((sb >> 9) & 1) << 5); Rr = (st >> 1) * 16 + swz / 64; C = (st & 1) * 32 + (swz % 64) / 2; }

struct Unit { int pm, pn; const char* a; const char* b; int srow, scol; };

typedef int v4i32 __attribute__((ext_vector_type(4)));
template <class E> constexpr auto self_scale_of(int) -> decltype(E::SELF_SCALE) { return E::SELF_SCALE; }
template <class E> constexpr bool self_scale_of(long) { return false; }
template <class Epi, class Sched, int MODE = 0>
__device__ __forceinline__ void gemm_phase(LAS unsigned char* lds, const int K, const int lda, const int ldb, const Sched& S, const Epi& E, const float* rowscale = nullptr, const float* colscale = nullptr) {
    int tid = threadIdx.x; asm volatile("" : "+v"(tid));
    const int wid = __builtin_amdgcn_readfirstlane(tid >> 6), lane = tid & 63, wr = wid >> 2, wc = wid & 3, fr = lane & 15, fq = lane >> 4;
    int nt = K / BK; asm volatile("" : "+s"(nt));
    unsigned voffA[2], voffB[2];
#pragma unroll
    for (int i = 0; i < 2; ++i) { int Rr, C; stage_rc(tid * 16 + i * 8192, Rr, C); voffA[i] = (unsigned)(Rr * lda + C) * 2u; voffB[i] = (unsigned)(Rr * ldb + C) * 2u; }
    const size_t kstep = (size_t)(BK * 2);
    const size_t hstepA = (size_t)HALF * lda * 2, hstepB = (size_t)HALF * ldb * 2;
    const unsigned ldsw = (unsigned)wid * 1024u;
    const int aoff = lds_byte(wr * 64 + fr, fq * 8), boff = lds_byte(wc * 32 + fr, fq * 8);
#define PG8_SA(b, h) (((b) * 2 + (h)) * HTB)
#define PG8_SB(b, h) ((4 + (b) * 2 + (h)) * HTB)
#define PG8_STAGE(bufoff, gbase, voff) do { _Pragma("unroll") for (int _i = 0; _i < 2; ++_i) \
        __builtin_amdgcn_global_load_lds((const unsigned*)((const char*)(gbase) + (voff)[_i]), (LAS unsigned*)(lds + (bufoff) + ldsw + _i * 8192), 16, 0, 0); } while (0)
#define PG8_LDA(dst, b, h) do { _Pragma("unroll") for (int m = 0; m < 4; ++m) _Pragma("unroll") for (int k = 0; k < 2; ++k) dst[m][k] = *(const LAS bf16x8*)(lds + PG8_SA(b, h) + aoff + m * 2048 + k * 1024); } while (0)
#define PG8_LDB(dst, b, h) do { _Pragma("unroll") for (int n = 0; n < 2; ++n) _Pragma("unroll") for (int k = 0; k < 2; ++k) dst[n][k] = *(const LAS bf16x8*)(lds + PG8_SB(b, h) + boff + n * 2048 + k * 1024); } while (0)
#define PG8_MMA(ai, bj, At, Bt) do { __builtin_amdgcn_s_setprio(1); _Pragma("unroll") for (int m = 0; m < 4; ++m) _Pragma("unroll") for (int n = 0; n < 2; ++n) _Pragma("unroll") for (int k = 0; k < 2; ++k) { \
        if constexpr (MODE == 1) acc[ai][bj][m][n] = __builtin_bit_cast(f32x4, __builtin_amdgcn_mfma_i32_16x16x64_i8(__builtin_bit_cast(v4i32, Bt[n][k]), __builtin_bit_cast(v4i32, At[m][k]), __builtin_bit_cast(v4i32, acc[ai][bj][m][n]), 0, 0, 0)); \
        else acc[ai][bj][m][n] = __builtin_amdgcn_mfma_f32_16x16x32_bf16(Bt[n][k], At[m][k], acc[ai][bj][m][n], 0, 0, 0); } \
        __builtin_amdgcn_s_setprio(0); } while (0)
#define PG8_WAIT_V(n) asm volatile("s_waitcnt vmcnt(" #n ")" ::: "memory")
#define PG8_WAIT_L(n) asm volatile("s_waitcnt lgkmcnt(" #n ")" ::: "memory")
#define PG8_BAR __builtin_amdgcn_s_barrier()
#define PG8_SCHED __builtin_amdgcn_sched_barrier(0)
    Unit cur, nxt; int ui = 0;
    if (!S.next(0, cur)) return;
    f32x4 acc[2][2][4][2];
#pragma unroll
    for (int a = 0; a < 2; ++a)
#pragma unroll
        for (int b = 0; b < 2; ++b)
#pragma unroll
            for (int m = 0; m < 4; ++m)
#pragma unroll
                for (int n = 0; n < 2; ++n) acc[a][b][m][n] = (f32x4){0.f, 0.f, 0.f, 0.f};
    bf16x8 At[4][2], B0[2][2], B1[2][2];
    const char* cA = cur.a; const char* cB = cur.b;
    PG8_STAGE(PG8_SB(0, 0), cB, voffB); PG8_STAGE(PG8_SB(0, 1), cB + hstepB, voffB); PG8_STAGE(PG8_SA(0, 0), cA, voffA); PG8_STAGE(PG8_SA(0, 1), cA + hstepA, voffA);
    if (wr == 1) PG8_BAR;
    PG8_WAIT_V(2); PG8_BAR;
    PG8_STAGE(PG8_SB(1, 0), cB + kstep, voffB); PG8_STAGE(PG8_SA(1, 0), cA + kstep, voffA); PG8_STAGE(PG8_SB(1, 1), cB + hstepB + kstep, voffB);
    PG8_WAIT_V(6); PG8_BAR;
    for (;;) {
        const bool has_next = S.next(ui + 1, nxt);
        const char* nA = has_next ? nxt.a : cA; const char* nB = has_next ? nxt.b : cB;
        for (int t = 0; t < nt; t += 2) {
            const bool last = (t == nt - 2);
            const char* a1 = cA + (size_t)(t + 1) * kstep;
            const char* a2 = last ? nA : cA + (size_t)(t + 2) * kstep; const char* b2 = last ? nB : cB + (size_t)(t + 2) * kstep;
            const char* a3 = a2 + kstep; const char* b3 = b2 + kstep;
            PG8_LDB(B0, 0, 0); PG8_LDB(B1, 0, 1); PG8_SCHED; PG8_LDA(At, 0, 0); PG8_STAGE(PG8_SA(1, 1), a1 + hstepA, voffA);
            PG8_WAIT_V(8); PG8_WAIT_L(0); PG8_BAR; PG8_MMA(0, 0, At, B0); PG8_MMA(0, 1, At, B1); PG8_BAR; PG8_SCHED;
            PG8_LDA(At, 0, 1); PG8_STAGE(PG8_SB(0, 0), b2, voffB); PG8_STAGE(PG8_SB(0, 1), b2 + hstepB, voffB); PG8_STAGE(PG8_SA(0, 0), a2, voffA);
            PG8_WAIT_V(8); PG8_WAIT_L(0); PG8_BAR; PG8_MMA(1, 0, At, B0); PG8_MMA(1, 1, At, B1); PG8_BAR; PG8_SCHED;
            PG8_LDB(B0, 1, 0); PG8_LDB(B1, 1, 1); PG8_SCHED; PG8_LDA(At, 1, 0); PG8_STAGE(PG8_SA(0, 1), a2 + hstepA, voffA);
            PG8_WAIT_V(8); PG8_WAIT_L(0); PG8_BAR; PG8_MMA(0, 0, At, B0); PG8_MMA(0, 1, At, B1); PG8_BAR; PG8_SCHED;
            PG8_LDA(At, 1, 1); PG8_STAGE(PG8_SB(1, 0), b3, voffB); PG8_STAGE(PG8_SB(1, 1), b3 + hstepB, voffB); PG8_STAGE(PG8_SA(1, 0), a3, voffA);
            PG8_WAIT_V(8); PG8_WAIT_L(0); PG8_BAR; PG8_MMA(1, 0, At, B0); PG8_MMA(1, 1, At, B1); PG8_BAR; PG8_SCHED;
        }
        if (wr == 0) PG8_BAR;
        { int fr_ = fr, fq_ = fq; asm volatile("" : "+v"(fr_), "+v"(fq_));
          if constexpr (MODE == 1 && !self_scale_of<Epi>(0)) {
              f32x4 cs[2][2];
#pragma unroll
              for (int bj = 0; bj < 2; ++bj)
#pragma unroll
                  for (int n = 0; n < 2; ++n) cs[bj][n] = *(const f32x4*)(colscale + cur.scol + 128 * bj + 32 * wc + 16 * n + 4 * fq_);
#pragma unroll
              for (int ai = 0; ai < 2; ++ai)
#pragma unroll
                  for (int m = 0; m < 4; ++m) { const float rs = rowscale[cur.srow + 128 * ai + 64 * wr + 16 * m + fr_];
#pragma unroll
                      for (int bj = 0; bj < 2; ++bj)
#pragma unroll
                          for (int n = 0; n < 2; ++n) { const v4i32 iv = __builtin_bit_cast(v4i32, acc[ai][bj][m][n]);
                              acc[ai][bj][m][n] = (f32x4){(float)iv[0], (float)iv[1], (float)iv[2], (float)iv[3]} * cs[bj][n] * rs; } }
          }
          E(acc, cur, wr, wc, fr_, fq_, lds); }
        if (!has_next) break;
#pragma unroll
        for (int a = 0; a < 2; ++a)
#pragma unroll
            for (int b = 0; b < 2; ++b)
#pragma unroll
                for (int m = 0; m < 4; ++m)
#pragma unroll
                    for (int n = 0; n < 2; ++n) acc[a][b][m][n] = (f32x4){0.f, 0.f, 0.f, 0.f};
        cur = nxt; cA = nA; cB = nB; ++ui;
        if (wr == 1) PG8_BAR;
    }
    PG8_WAIT_V(0);
    PG8_BAR;
#undef PG8_SA
#undef PG8_SB
#undef PG8_STAGE
#undef PG8_LDA
#undef PG8_LDB
#undef PG8_MMA
#undef PG8_WAIT_V
#undef PG8_WAIT_L
#undef PG8_BAR
#undef PG8_SCHED
}
}
using pg8::Unit;

struct Frame {
    LAS unsigned char* lds;
    int tid, lane, wave, vcu, G;
    float* xl;
    unsigned char* ws;
};
typedef const char __attribute__((address_space(4)))* kaptr_t;
__device__ __forceinline__ const float* inp(int i) {
    kaptr_t ka = (kaptr_t)__builtin_amdgcn_kernarg_segment_ptr();
    asm volatile("" : "+s"(i));
    return *(const float* const __attribute__((address_space(4)))*)(ka + 8 * i);
}
#define WSP(T, off) ((T*)(F.ws + (off)))
__device__ __forceinline__ int rotc(const Frame& F, int rot) { return (F.vcu + rot) % F.G; }

__device__ __forceinline__ const float* xrow_ptr(const Frame& F, int r) { return r < RL ? F.xl + (size_t)r * D : WSP(float, WS_XC) + (size_t)(r - RL) * D; }
__device__ __forceinline__ int modrow_of(int r) { return r < RL ? (r >> 11) : 16; }

struct SchedMN {
    int m_lo, nM, nN, G, c; const char* A; const char* B; size_t a_tile, b_tile; int a_row0;
    __device__ __forceinline__ bool next(int i, Unit& u) const {
        const long L = (long)i * G + c; if (L >= (long)nM * nN) return false;
        const int band = (int)(L / (4 * nN)), rem = (int)(L % (4 * nN)); const int pm = band * 4 + (rem & 3), pn = rem >> 2;
        u.pm = m_lo + pm; u.pn = pn; u.a = A + (size_t)(m_lo + pm - a_row0) * a_tile; u.b = B + (size_t)pn * b_tile; u.srow = (m_lo + pm) * 256; u.scol = pn * 256; return true;
    }
};
struct SchedWin {
    int nfull, nrest, nsel, G, c; const char* A; const char* B; size_t rowb;
    __device__ __forceinline__ bool next(int i, Unit& u) const {
        const long L = (long)i * G + c; const long n0 = (long)nfull * 10; if (L >= n0 + (long)nrest * nsel) return false;
        int pm, pn;
        if (L < n0) { const int band = (int)(L / 40), rem = (int)(L % 40); pm = band * 4 + (rem & 3); pn = rem >> 2; }
        else { const int q = (int)(L - n0); pm = nfull + (q & 15); const int k = q >> 4; pn = k == 0 ? 1 : (k == 1 ? 3 : (k == 2 ? 4 : (k == 3 ? 7 : 9))); }
        u.pm = pm; u.pn = pn; u.a = A + (size_t)pm * 256 * rowb; u.b = B + (size_t)pn * 256 * rowb; u.srow = pm * 256; u.scol = pn * 256; return true;
    }
};
struct SchedBranch {
    int m_lo, nM, G, c; const char* Y; const char* Wb;
    __device__ __forceinline__ bool next(int i, Unit& u) const {
        const long L = (long)i * G + c; if (L >= (long)nM * 16) return false;
        const int pm = (int)(L / 16), q = (int)(L % 16), s = q >> 2, pn = q & 3;
        u.pm = m_lo + pm; u.pn = q; u.a = Y + ((size_t)(m_lo + pm) * 256 * 1024 + 256 * s) * 2; u.b = Wb + ((size_t)(s * 1024 + pn * 256) * 256) * 2; return true;
    }
};
struct SchedDft {
    int nb, nMb, G, c; const char* CS; const char* FT; size_t cs_tile, ft_b;
    __device__ __forceinline__ bool next(int i, Unit& u) const {
        const long L = (long)i * G + c; if (L >= (long)nb * nMb) return false;
        const int b = (int)(L / nMb), pm = (int)(L % nMb);
        u.pm = pm; u.pn = b; u.a = CS + (size_t)pm * cs_tile; u.b = FT + (size_t)b * ft_b; return true;
    }
};

typedef f32x4 Acc[2][2][4][2];
#define EPI_LOOP_AM for (int ai = 0; ai < 2; ++ai) _Pragma("unroll") for (int m = 0; m < 4; ++m)
#define EPI_LOOP_BN for (int bj = 0; bj < 2; ++bj) _Pragma("unroll") for (int n = 0; n < 2; ++n)

__device__ __forceinline__ float dpp_from_prev(float x) { return __int_as_float(__builtin_amdgcn_update_dpp(0, __float_as_int(x), 0x121, 0xF, 0xF, true)); }
__device__ __forceinline__ float dpp_from_next(float x) { return __int_as_float(__builtin_amdgcn_update_dpp(0, __float_as_int(x), 0x12F, 0xF, 0xF, true)); }
#define EW(T, off) ((T*)(ws + (off)))
struct EpiWin {
    unsigned char* ws; int layer;
    __device__ __forceinline__ void operator()(const Acc& acc, const Unit& u, int wr, int wc, int fr, int fq, LAS unsigned char* lds) const {
        bf16_t* const CQ = EW(bf16_t, WS_CQ); bf16_t* const CKV = EW(bf16_t, WS_CKV); bf16_t* const MQK = EW(bf16_t, WS_MQK); bf16_t* const MV = EW(bf16_t, WS_MV); bf16_t* const MO = EW(bf16_t, WS_MO);
        bf16_t* const GQ = EW(bf16_t, WS_GQ); bf16_t* const GK = EW(bf16_t, WS_GK); bf16_t* const GV = EW(bf16_t, WS_GV); bf16_t* const FAB = EW(bf16_t, WS_FAB); bf16_t* const K96 = EW(bf16_t, WS_K96);
        float* const SSP = EW(float, WS_SSP); float* const MG = EW(float, WS_MG); const float* const ropeG = EW(float, WS_TAB); const float* const ropeM = EW(float, WS_TAB + 8192);
        asm volatile("" : "+v"(fq), "+v"(fr));
        const int t = u.pn, rb = u.pm * 256 + wr * 64 + fr; const bool lat = u.pm < TL;
        const int cw = 32 * wc + 4 * fq;
        if (t <= 1) {
            bf16_t* dst = t == 0 ? CQ : CKV; float* ss = SSP + (size_t)t * R * 4;
#pragma unroll
            EPI_LOOP_AM { const int r = rb + ai * 128 + m * 16; float sq = 0.f;
#pragma unroll
                for (int bj = 0; bj < 2; ++bj) { const f32x4 v = acc[ai][bj][m][0], v2 = acc[ai][bj][m][1]; sq += ((v[0] * v[0] + v[1] * v[1]) + (v[2] * v[2] + v[3] * v[3])) + ((v2[0] * v2[0] + v2[1] * v2[1]) + (v2[2] * v2[2] + v2[3] * v2[3]));
                    store8bf(dst + (size_t)r * 256 + 128 * bj + 32 * wc + 8 * fq, v, v2); }
                sq += __shfl_xor(sq, 16); sq += __shfl_xor(sq, 32);
                if (fq == 0) ss[(size_t)r * 4 + wc] = sq; }
        } else if (t <= 3) {
            asm volatile("" : "+v"(fq), "+v"(fr));
            LAS float* XF = (LAS float*)(lds + RING_BYTES);
            LAS float* XL = XF + 1024;
            const float scl = t == 3 ? 0.125f : 1.f; const int c0 = 32 * wc + 8 * fq; const int rb = u.pm * 256 + wr * 64 + fr;
            float* const EDQ = EW(float, WS_EDQ) + (size_t)(u.pm * 2 + (t - 2)) * 4 * 256;
#pragma unroll
            for (int ai = 0; ai < 2; ++ai) { const int k = 2 * ai + wr;
#pragma unroll
                EPI_LOOP_BN {
                    if (fr == 0) *(LAS f32x4*)(XF + ((k * 4 + wc) * 2 + bj) * 32 + 16 * n + 4 * fq) = acc[ai][bj][0][n];
                    if (fr == 15) *(LAS f32x4*)(XL + ((k * 4 + wc) * 2 + bj) * 32 + 16 * n + 4 * fq) = acc[ai][bj][3][n]; } }
            if (wr == 0 && fr < 2) {
#pragma unroll
                EPI_LOOP_BN { *(f32x4*)(EDQ + (size_t)fr * 256 + 128 * bj + c0 + 4 * n) = acc[0][bj][0][n]; } }
            if (wr == 1 && fr >= 14) {
#pragma unroll
                EPI_LOOP_BN { *(f32x4*)(EDQ + (size_t)(fr - 12) * 256 + 128 * bj + c0 + 4 * n) = acc[1][bj][3][n]; } }
            asm volatile("s_waitcnt lgkmcnt(0)" ::: "memory"); __builtin_amdgcn_s_barrier(); asm volatile("" ::: "memory");
            const float* const wcv = inp(15) + (size_t)layer * 3 * 512 + (t - 2) * 256;
#pragma unroll
            for (int bj = 0; bj < 2; ++bj) {
#pragma unroll
                for (int n = 0; n < 2; ++n) { const int ch = 128 * bj + c0 + 4 * n;
                    const f32x4 w0 = *(const f32x4*)(wcv + ch), w1 = *(const f32x4*)(wcv + 512 + ch), w2 = *(const f32x4*)(wcv + 1024 + ch);
                    const f32x4 zz = (f32x4){0.f, 0.f, 0.f, 0.f}; const f32x4 w0a = fr > 0 ? w0 : zz, w0b = fr > 0 ? zz : w0, w2a = fr < 15 ? w2 : zz, w2b = fr < 15 ? zz : w2;
#pragma unroll
                    for (int ai = 0; ai < 2; ++ai) { const int k = 2 * ai + wr;
                        f32x4 hp = (f32x4){0.f, 0.f, 0.f, 0.f}, hn = hp;
                        if (k > 0) hp = *(const LAS f32x4*)(XL + (((k - 1) * 4 + wc) * 2 + bj) * 32 + 16 * n + 4 * fq);
                        if (k < 3) hn = *(const LAS f32x4*)(XF + (((k + 1) * 4 + wc) * 2 + bj) * 32 + 16 * n + 4 * fq);
                        f32x4 pprev = hp, ncur;
#pragma unroll
                        for (int j = 0; j < 4; ++j) ncur[j] = dpp_from_next(acc[ai][bj][0][n][j]);
#pragma unroll
                        for (int m = 0; m < 4; ++m) { f32x4 o, pcur, nnext = hn;
#pragma unroll
                            for (int j = 0; j < 4; ++j) { pcur[j] = dpp_from_prev(acc[ai][bj][m][n][j]); if (m < 3) nnext[j] = dpp_from_next(acc[ai][bj][m < 3 ? m + 1 : 3][n][j]); }
#pragma unroll
                            for (int j = 0; j < 4; ++j) o[j] = siluf_(w1[j] * acc[ai][bj][m][n][j] + w0a[j] * pcur[j] + w0b[j] * pprev[j] + w2a[j] * ncur[j] + w2b[j] * nnext[j]) * scl;
                            store4bf(MQK + (size_t)(rb + ai * 128 + m * 16) * 512 + (t - 2) * 256 + 128 * bj + c0 + 4 * n, o);
                            pprev = pcur; ncur = nnext; }
                        __builtin_amdgcn_sched_barrier(0); } } }
            asm volatile("s_waitcnt lgkmcnt(0)" ::: "memory"); __builtin_amdgcn_s_barrier(); asm volatile("" ::: "memory");
        } else if (t <= 5) {
            bf16_t* dst = t == 4 ? MV : MO; const int ld = 256;
#pragma unroll
            EPI_LOOP_AM { const int r = rb + ai * 128 + m * 16;
#pragma unroll
                for (int bj = 0; bj < 2; ++bj) { f32x4 v = acc[ai][bj][m][0], v2 = acc[ai][bj][m][1];
                    if (t == 5) { v[0] = sigmoidf_(v[0]); v[1] = sigmoidf_(v[1]); v[2] = sigmoidf_(v[2]); v[3] = sigmoidf_(v[3]); v2[0] = sigmoidf_(v2[0]); v2[1] = sigmoidf_(v2[1]); v2[2] = sigmoidf_(v2[2]); v2[3] = sigmoidf_(v2[3]); }
                    store8bf(dst + (size_t)r * ld + 128 * bj + 32 * wc + 8 * fq, v, v2); } }
        } else if (t == 6 || t == 7) {
#pragma unroll
            EPI_LOOP_AM { const int r = rb + ai * 128 + m * 16; const int tok = r & 2047; const int pos = (wc & 1) ? (tok & 63) : (tok >> 6);
                f32x4 cs0 = (f32x4){1.f, 0.f, 1.f, 0.f}, cs1 = cs0;
                if (lat) { const f32x4* tp = (const f32x4*)(ropeG + (size_t)(pos * 16 + 4 * fq) * 2); cs0 = tp[0]; cs1 = tp[1]; }
#pragma unroll
                for (int bj = 0; bj < 2; ++bj) {
                    f32x4 x1 = acc[ai][bj][m][0], x2 = acc[ai][bj][m][1];
                    if (t == 6 || bj == 0) {
                        f32x4 o1, o2;
                        o1[0] = x1[0] * cs0[0] - x2[0] * cs0[1]; o2[0] = x1[0] * cs0[1] + x2[0] * cs0[0];
                        o1[1] = x1[1] * cs0[2] - x2[1] * cs0[3]; o2[1] = x1[1] * cs0[3] + x2[1] * cs0[2];
                        o1[2] = x1[2] * cs1[0] - x2[2] * cs1[1]; o2[2] = x1[2] * cs1[1] + x2[2] * cs1[0];
                        o1[3] = x1[3] * cs1[2] - x2[3] * cs1[3]; o2[3] = x1[3] * cs1[3] + x2[3] * cs1[2];
                        x1 = o1; x2 = o2;
                    }
                    if (t == 6) { x1 = x1 * QS_G; x2 = x2 * QS_G; store4bf(GQ + (size_t)r * 256 + 128 * bj + cw, x1); store4bf(GQ + (size_t)r * 256 + 128 * bj + cw + 16, x2); }
                    else if (bj == 0) { store4bf(GK + (size_t)r * 128 + cw, x1); store4bf(GK + (size_t)r * 128 + cw + 16, x2); }
                    else { const int bb = r < RL ? (r >> 11) : ((r - RL) >> 8), key = r < RL ? 256 + (r & 2047) : ((r - RL) & 255);
                        bf16_t* dst = GV + ((size_t)((bb * 2 + (wc >> 1)) * 64 + 32 * (wc & 1) + 4 * fq)) * 2304 + key;
#pragma unroll
                        for (int j = 0; j < 4; ++j) { dst[(size_t)j * 2304] = (bf16_t)f2bf(x1[j]); dst[(size_t)(16 + j) * 2304] = (bf16_t)f2bf(x2[j]); } }
                } }
        } else if (t == 8) {
#pragma unroll
            EPI_LOOP_AM { const int r = rb + ai * 128 + m * 16;
#pragma unroll
                for (int bj = 0; bj < 2; ++bj) store8bf(FAB + (size_t)r * 256 + 128 * bj + 32 * wc + 8 * fq, acc[ai][bj][m][0], acc[ai][bj][m][1]); }
        } else {
            if (wc == 0) {
#pragma unroll
                EPI_LOOP_AM { const int r = rb + ai * 128 + m * 16; const int tok = r & 2047; const int pos = (fq >= 2) ? (tok & 63) : (tok >> 6);
                    f32x4 cs0 = (f32x4){1.f, 0.f, 1.f, 0.f}, cs1 = cs0;
                    if (lat) { const f32x4* tp = (const f32x4*)(ropeM + (size_t)(pos * 8 + 4 * (fq & 1)) * 2); cs0 = tp[0]; cs1 = tp[1]; }
                    const f32x4 x1 = acc[ai][0][m][0], x2 = acc[ai][0][m][1]; f32x4 o1, o2;
                    o1[0] = x1[0] * cs0[0] - x2[0] * cs0[1]; o2[0] = x1[0] * cs0[1] + x2[0] * cs0[0];
                    o1[1] = x1[1] * cs0[2] - x2[1] * cs0[3]; o2[1] = x1[1] * cs0[3] + x2[1] * cs0[2];
                    o1[2] = x1[2] * cs1[0] - x2[2] * cs1[1]; o2[2] = x1[2] * cs1[1] + x2[2] * cs1[0];
                    o1[3] = x1[3] * cs1[2] - x2[3] * cs1[3]; o2[3] = x1[3] * cs1[3] + x2[3] * cs1[2];
#pragma unroll
                    for (int h = 0; h < 4; ++h) { store4bf(K96 + (size_t)r * 384 + h * 96 + 64 + 4 * fq, o1); store4bf(K96 + (size_t)r * 384 + h * 96 + 80 + 4 * fq, o2); } }
            } else if (wc == 1) {
#pragma unroll
                EPI_LOOP_AM { const int r = rb + ai * 128 + m * 16; *(f32x4*)(MG + (size_t)r * 16 + 4 * fq) = acc[ai][0][m][0]; }
            }
        }
    }
};

struct EpiUq {
    unsigned char* ws;
    __device__ __forceinline__ void operator()(const Acc& acc, const Unit& u, int wr, int wc, int fr, int fq, LAS unsigned char* lds) const {
        if (wc == 3) return;
        bf16_t* const Q96 = EW(bf16_t, WS_Q96); const float* const SSP = EW(float, WS_SSP); const float* const ropeM = EW(float, WS_TAB + 8192);
        const int rb = u.pm * 256 + wr * 64 + fr; const bool lat = u.pm < TL;
#pragma unroll
        EPI_LOOP_AM { const int r = rb + ai * 128 + m * 16; const f32x4 s4 = *(const f32x4*)(SSP + (size_t)r * 4);
            const float sc = rsqrtf(((s4[0] + s4[1]) + (s4[2] + s4[3])) * (1.f / 256.f) + EPS) * QS_M;
            const int tok = r & 2047; const int pos = (fq >= 2) ? (tok & 63) : (tok >> 6);
            f32x4 cs0 = (f32x4){1.f, 0.f, 1.f, 0.f}, cs1 = cs0;
            if (lat && wc == 2) { const f32x4* tp = (const f32x4*)(ropeM + (size_t)(pos * 8 + 4 * (fq & 1)) * 2); cs0 = tp[0]; cs1 = tp[1]; }
#pragma unroll
            for (int bj = 0; bj < 2; ++bj) { const int hh = 2 * u.pn + bj; bf16_t* dst = Q96 + (size_t)r * 384 + hh * 96 + 32 * wc + 4 * fq;
                f32x4 x1 = acc[ai][bj][m][0] * sc, x2 = acc[ai][bj][m][1] * sc;
                if (wc == 2) { f32x4 o1, o2;
                    o1[0] = x1[0] * cs0[0] - x2[0] * cs0[1]; o2[0] = x1[0] * cs0[1] + x2[0] * cs0[0];
                    o1[1] = x1[1] * cs0[2] - x2[1] * cs0[3]; o2[1] = x1[1] * cs0[3] + x2[1] * cs0[2];
                    o1[2] = x1[2] * cs1[0] - x2[2] * cs1[1]; o2[2] = x1[2] * cs1[1] + x2[2] * cs1[0];
                    o1[3] = x1[3] * cs1[2] - x2[3] * cs1[3]; o2[3] = x1[3] * cs1[3] + x2[3] * cs1[2];
                    x1 = o1; x2 = o2; }
                store4bf(dst, x1); store4bf(dst + 16, x2); } }
    }
};
struct EpiUkv {
    unsigned char* ws;
    __device__ __forceinline__ void operator()(const Acc& acc, const Unit& u, int wr, int wc, int fr, int fq, LAS unsigned char* lds) const {
        bf16_t* const K96 = EW(bf16_t, WS_K96); bf16_t* const V = EW(bf16_t, WS_V); const float* const SSP = EW(float, WS_SSP) + (size_t)R * 4;
        const int rb = u.pm * 256 + wr * 64 + fr;
#pragma unroll
        EPI_LOOP_AM { const int r = rb + ai * 128 + m * 16; const f32x4 s4 = *(const f32x4*)(SSP + (size_t)r * 4);
            const float sc = rsqrtf(((s4[0] + s4[1]) + (s4[2] + s4[3])) * (1.f / 256.f) + EPS);
            const int bb = r < RL ? (r >> 11) : ((r - RL) >> 8), key = r < RL ? 256 + (r & 2047) : ((r - RL) & 255);
#pragma unroll
            for (int bj = 0; bj < 2; ++bj) { const int hh = 2 * u.pn + bj;
                if (wc < 2) { bf16_t* dst = K96 + (size_t)r * 384 + hh * 96 + 32 * wc + 4 * fq; store4bf(dst, acc[ai][bj][m][0] * sc); store4bf(dst + 16, acc[ai][bj][m][1] * sc); }
                else { bf16_t* dst = V + ((size_t)((bb * 4 + hh) * 64 + 32 * (wc - 2) + 4 * fq)) * 2304 + key;
#pragma unroll
                    for (int n = 0; n < 2; ++n)
#pragma unroll
                        for (int j = 0; j < 4; ++j) dst[(size_t)(16 * n + j) * 2304] = (bf16_t)f2bf(acc[ai][bj][m][n][j] * sc); } } }
    }
};
struct EpiDft {
    unsigned char* ws; int row0, nseq; float scale;
    __device__ __forceinline__ void operator()(const Acc& acc, const Unit& u, int wr, int wc, int fr, int fq, LAS unsigned char* lds) const {
        bf16_t* const Y = EW(bf16_t, WS_Y);
        const int rb = row0 + u.pn * nseq + u.pm * 256 + wr * 64 + fr;
#pragma unroll
        EPI_LOOP_AM { const int r = rb + ai * 128 + m * 16;
#pragma unroll
            EPI_LOOP_BN { store4bf(Y + (size_t)r * 1024 + 768 + 128 * bj + 32 * wc + 16 * n + 4 * fq, acc[ai][bj][m][n] * scale); } }
    }
};
struct EpiBranch {
    unsigned char* ws; int r0, crows;
    __device__ __forceinline__ void operator()(const Acc& acc, const Unit& u, int wr, int wc, int fr, int fq, LAS unsigned char* lds) const {
        const int s = u.pn >> 2, pn = u.pn & 3; const int rb = u.pm * 256 + wr * 64 + fr - r0;
        bf16_t* const base = EW(bf16_t, WS_BV) + ((size_t)s * crows + rb) * 1024 + 256 * pn + 32 * wc + 8 * fq;
#pragma unroll
        EPI_LOOP_AM {
#pragma unroll
            for (int bj = 0; bj < 2; ++bj) store8bf(base + (size_t)(ai * 128 + m * 16) * 1024 + 128 * bj, acc[ai][bj][m][0], acc[ai][bj][m][1]); }
    }
};
struct EpiGate {
    static constexpr bool SELF_SCALE = true;
    unsigned char* ws; const float* bg; int r0, crows; const float* rowscale; const float* colscale;
    __device__ __forceinline__ void operator()(const Acc& acc, const Unit& u, int wr, int wc, int fr, int fq, LAS unsigned char* lds) const {
        asm volatile("" : "+v"(fq), "+v"(fr));
        bf16_t* const ACCo = EW(bf16_t, WS_ACC);
        const int d0 = 64 * u.pn + 16 * wc + 4 * fq; const int rb = u.pm * 256 + wr * 64 + fr;
        const bf16_t* const bvp = EW(bf16_t, WS_BV) + (size_t)(rb - r0) * 1024 + d0; const size_t plane = (size_t)crows * 1024;
        const float* const rsp = rowscale + rb;
        u32x2 w[3][4]; float rs[3];
        f32x4 kc[4], bz[4];
#pragma unroll
        for (int s = 0; s < 4; ++s) { asm volatile("global_load_dwordx4 %0, %1, off" : "=v"(kc[s]) : "v"(colscale + u.scol + 128 * (s >> 1) + 32 * wc + 16 * (s & 1) + 4 * fq) : "memory");
            asm volatile("global_load_dwordx4 %0, %1, off" : "=v"(bz[s]) : "v"(bg + s * 1024 + d0) : "memory"); }
#define GATE_FETCH(q_) do { const int q = (q_), ro = (q >> 2) * 128 + (q & 3) * 16; \
            asm volatile("global_load_dword %0, %1, off" : "=v"(rs[q % 3]) : "v"(rsp + ro) : "memory"); \
            _Pragma("unroll") for (int s = 0; s < 4; ++s) asm volatile("global_load_dwordx2 %0, %1, off" : "=v"(w[q % 3][s]) : "v"(bvp + (size_t)ro * 1024 + s * plane) : "memory"); } while (0)
#define GATE_WAIT(n_, q_) asm volatile("s_waitcnt vmcnt(" #n_ ")" : "+v"(rs[(q_) % 3]), "+v"(w[(q_) % 3][0]), "+v"(w[(q_) % 3][1]), "+v"(w[(q_) % 3][2]), "+v"(w[(q_) % 3][3]) :: "memory")
        GATE_FETCH(0); GATE_FETCH(1);
#pragma unroll
        for (int p = 0; p < 8; ++p) { const int ai = p >> 2, m = p & 3;
            if (p + 2 < 8) GATE_FETCH(p + 2);
            if (p == 0) { GATE_WAIT(10, 0);
                asm volatile("" : "+v"(kc[0]), "+v"(kc[1]), "+v"(kc[2]), "+v"(kc[3]), "+v"(bz[0]), "+v"(bz[1]), "+v"(bz[2]), "+v"(bz[3]));
#pragma unroll
                for (int s = 0; s < 4; ++s) { kc[s] = kc[s] * (-LOG2E); bz[s] = bz[s] * (-LOG2E); } }
            else if (p == 1) GATE_WAIT(11, 1); else if (p == 2) GATE_WAIT(12, 2); else if (p == 3) GATE_WAIT(12, 3); else if (p == 4) GATE_WAIT(12, 4); else if (p == 5) GATE_WAIT(12, 5);
            else if (p == 6) GATE_WAIT(7, 6); else GATE_WAIT(2, 7);
            f32x4 o;
#pragma unroll
            for (int s = 0; s < 4; ++s) { const pg8::v4i32 iv = __builtin_bit_cast(pg8::v4i32, acc[ai][s >> 1][m][s & 1]);
                const u32x2 ww = w[p % 3][s]; const f32x4 bv = (f32x4){lo_bf(ww.x), hi_bf(ww.x), lo_bf(ww.y), hi_bf(ww.y)};
#pragma unroll
                for (int j = 0; j < 4; ++j) { const float sg = frcp(1.0f + fexp2(fmaf((float)iv[j] * rs[p % 3], kc[s][j], bz[s][j]))); o[j] = s == 0 ? sg * bv[j] : fmaf(sg, bv[j], o[j]); } }
            { u32x2 ow; ow.x = cvt_pk_bf16(o[0], o[1]); ow.y = cvt_pk_bf16(o[2], o[3]);
              asm volatile("global_store_dwordx2 %0, %1, off" :: "v"(ACCo + (size_t)(rb + ai * 128 + m * 16) * 1024 + d0), "v"(ow) : "memory"); } }
#undef GATE_FETCH
#undef GATE_WAIT
    }
};
struct EpiPlain {
    bf16_t* O; int ldc; int r0;
    __device__ __forceinline__ void operator()(const Acc& acc, const Unit& u, int wr, int wc, int fr, int fq, LAS unsigned char* lds) const {
        const int rb = u.pm * 256 + wr * 64 + fr - r0;
#pragma unroll
        EPI_LOOP_AM { const int r = rb + ai * 128 + m * 16;
#pragma unroll
            for (int bj = 0; bj < 2; ++bj) store8bf(O + (size_t)r * ldc + 256 * u.pn + 128 * bj + 32 * wc + 8 * fq, acc[ai][bj][m][0], acc[ai][bj][m][1]); }
    }
};

struct EpiUpConv {
    unsigned char* ws; const float* wconv; const float* bconv;
    __device__ __forceinline__ void operator()(const Acc& acc, const Unit& u, int wr, int wc, int fr, int fq, LAS unsigned char* lds) const {
        LAS float* XF = (LAS float*)(lds + RING_BYTES);
        LAS float* XL = XF + 512;
        const int c0 = 32 * wc + 8 * fq;
        const int f0 = 128 * u.pn + c0;
        bf16_t* const G = EW(bf16_t, WS_G); float* const EDGE = EW(float, WS_EDGE) + (size_t)(u.pm * 22 + u.pn) * 6 * 128;
#pragma unroll
        for (int ai = 0; ai < 2; ++ai) { const int k = 2 * ai + wr;
#pragma unroll
            for (int n = 0; n < 2; ++n) {
                if (fr == 0) *(LAS f32x4*)(XF + (k * 4 + wc) * 32 + 16 * n + 4 * fq) = acc[ai][0][0][n];
                if (fr == 15) *(LAS f32x4*)(XL + (k * 4 + wc) * 32 + 16 * n + 4 * fq) = acc[ai][0][3][n]; } }
        if (wr == 0 && fr < 2) {
#pragma unroll
            for (int n = 0; n < 2; ++n) { *(f32x4*)(EDGE + (size_t)fr * 128 + c0 + 4 * n) = acc[0][0][0][n]; if (fr == 0) *(f32x4*)(EDGE + 4 * 128 + c0 + 4 * n) = acc[0][1][0][n]; } }
        if (wr == 1 && fr >= 14) {
#pragma unroll
            for (int n = 0; n < 2; ++n) { *(f32x4*)(EDGE + (size_t)(fr - 12) * 128 + c0 + 4 * n) = acc[1][0][3][n]; if (fr == 15) *(f32x4*)(EDGE + 5 * 128 + c0 + 4 * n) = acc[1][1][3][n]; } }
        asm volatile("s_waitcnt lgkmcnt(0)" ::: "memory"); __builtin_amdgcn_s_barrier(); asm volatile("" ::: "memory");
        u32x2 stash[2][4];
#pragma unroll
        for (int n = 0; n < 2; ++n) {
            const f32x4 w0 = *(const f32x4*)(wconv + f0 + 4 * n), w1 = *(const f32x4*)(wconv + DFF + f0 + 4 * n), w2 = *(const f32x4*)(wconv + 2 * DFF + f0 + 4 * n), bb = *(const f32x4*)(bconv + f0 + 4 * n);
            const f32x4 zz = (f32x4){0.f, 0.f, 0.f, 0.f}; const f32x4 w0a = fr > 0 ? w0 : zz, w0b = fr > 0 ? zz : w0, w2a = fr < 15 ? w2 : zz, w2b = fr < 15 ? zz : w2;
#pragma unroll
            for (int ai = 0; ai < 2; ++ai) { const int k = 2 * ai + wr;
                f32x4 hp = (f32x4){0.f, 0.f, 0.f, 0.f}, hn = hp;
                if (k > 0) hp = *(const LAS f32x4*)(XL + ((k - 1) * 4 + wc) * 32 + 16 * n + 4 * fq);
                if (k < 3) hn = *(const LAS f32x4*)(XF + ((k + 1) * 4 + wc) * 32 + 16 * n + 4 * fq);
                f32x4 P[4], N[4];
#pragma unroll
                for (int m = 0; m < 4; ++m)
#pragma unroll
                    for (int j = 0; j < 4; ++j) { P[m][j] = dpp_from_prev(acc[ai][0][m][n][j]); N[m][j] = dpp_from_next(acc[ai][0][m][n][j]); }
#pragma unroll
                for (int m = 0; m < 4; ++m) { f32x4 o;
#pragma unroll
                    for (int j = 0; j < 4; ++j) {
                        const float c = bb[j] + w1[j] * acc[ai][0][m][n][j] + w0a[j] * P[m][j] + w0b[j] * (m > 0 ? P[m - 1][j] : hp[j]) + w2a[j] * N[m][j] + w2b[j] * (m < 3 ? N[m + 1][j] : hn[j]);
                        o[j] = siluf_(c) * acc[ai][1][m][n][j]; }
                    u32x2 w; w.x = cvt_pk_bf16(o[0], o[1]); w.y = cvt_pk_bf16(o[2], o[3]);
                    if (n == 0) stash[ai][m] = w;
                    else { const u32x4 ww = (u32x4){stash[ai][m].x, stash[ai][m].y, w.x, w.y}; *(u32x4*)(G + (size_t)(u.pm * 256 + 128 * ai + 64 * wr + 16 * m + fr) * DFF + f0) = ww; } } } }
        asm volatile("s_waitcnt lgkmcnt(0)" ::: "memory"); __builtin_amdgcn_s_barrier(); asm volatile("" ::: "memory");
    }
};
__device__ __forceinline__ void phase_conv_fixup(const Frame& F, int l, int t_lo, int ntile) {
    const float* EDGE = WSP(float, WS_EDGE); bf16_t* Gb = WSP(bf16_t, WS_G); const float* wc = inp(23) + (size_t)l * 3 * DFF; const float* bc = inp(24) + (size_t)l * DFF;
    const long total = (long)ntile * 2 * (DFF / 4); const long gt = (long)F.vcu * NTHR + F.tid, gs = (long)F.G * NTHR;
    for (long it = gt; it < total; it += gs) {
        const int f4 = (int)(it % (DFF / 4)); const int q = (int)(it / (DFF / 4)); const int which = q & 1, pm = t_lo + (q >> 1); const int f = 4 * f4, pn = f >> 7, c = f & 127;
        const bool seq_first = pm >= TL || (pm & 7) == 0, seq_last = pm >= TL || (pm & 7) == 7;
        const float* e = EDGE + (size_t)(pm * 22 + pn) * 768 + c;
        f32x4 ap = (f32x4){0.f, 0.f, 0.f, 0.f}, an = ap, ac, vv;
        if (which == 0) { if (!seq_first) ap = *(const f32x4*)(e - 22 * 768 + 3 * 128); ac = *(const f32x4*)e; an = *(const f32x4*)(e + 128); vv = *(const f32x4*)(e + 4 * 128); }
        else { ap = *(const f32x4*)(e + 2 * 128); ac = *(const f32x4*)(e + 3 * 128); if (!seq_last) an = *(const f32x4*)(e + 22 * 768); vv = *(const f32x4*)(e + 5 * 128); }
        const f32x4 w0 = *(const f32x4*)(wc + f), w1 = *(const f32x4*)(wc + DFF + f), w2 = *(const f32x4*)(wc + 2 * DFF + f), bb = *(const f32x4*)(bc + f);
        f32x4 o;
#pragma unroll
        for (int j = 0; j < 4; ++j) o[j] = siluf_(w0[j] * ap[j] + w1[j] * ac[j] + w2[j] * an[j] + bb[j]) * vv[j];
        store4bf(Gb + (size_t)(pm * 256 + (which ? 255 : 0)) * DFF + f, o);
    }
}

__device__ __forceinline__ int perm32(int rho) { const int n = rho >> 4, i = rho & 15; return 8 * (i >> 2) + 4 * n + (i & 3); }
__device__ __forceinline__ int permcol(int n) { return (n & ~31) + perm32(n & 31); }
struct MapIdent { __device__ int operator()(int n) const { return n; } };
struct MapIdentP { __device__ int operator()(int n) const { return permcol(n); } };
struct MapWin { __device__ int operator()(int n) const { const int t = n >> 8; const int i = t <= 5 ? permcol(n & 255) : (n & 255);
    switch (t) { case 0: return i; case 1: return 256 + i; case 2: return 544 + i; case 3: return 800 + i; case 4: return 1056 + i; case 5: return 1312 + i; case 6: return 1584 + i; case 7: return 1840 + i;
        case 9: { if (i < 32) { const int nn = i >> 4, ii = i & 15; return 512 + ((ii < 8 ? ii : 8 + ii) + 8 * nn); } if (i < 48) return 1568 + (i - 32); return -1; }
        default: return -1; } } };
struct MapUq { __device__ int operator()(int n) const { const int hh = n >> 7, w = n & 127; if (w < 64) return 96 * hh + w; if (w < 96) { const int c = w - 64, nn = c >> 4, ii = c & 15; return 96 * hh + 64 + ((ii < 8 ? ii : 8 + ii) + 8 * nn); } return -1; } };
struct MapGate { __device__ int operator()(int n) const { const int pn = n >> 8, rem = n & 255, bj = rem >> 7, wc = (rem & 127) >> 5, nn = (rem & 31) >> 4, q4 = rem & 15; const int s = 2 * bj + nn, d = 64 * pn + 16 * wc + q4; return s * 1048576 + d; } };
struct MapBranch { __device__ int operator()(int n) const { const int s = n >> 10, d = permcol(n & 1023); return s * 262144 + d; } };
struct MapUp { __device__ int operator()(int n) const { const int pn = n >> 8, i = permcol(n & 255); return i < 128 ? 128 * pn + i : 2816 + 128 * pn + (i - 128); } };

template <class Map>
__device__ __forceinline__ void conv_weight(const Frame& F, const float* W, int ldw, int K, bf16_t* Wt, int nrows, const float* ks, Map map, int skip_lo, int skip_hi, int vc, int nvc) {
    LAS float* scr = (LAS float*)(F.lds + F.wave * 8448);
    const int nblk = nrows / 32, kblk = K / 64; const int gw = vc * 8 + F.wave, ngw = nvc * 8; const int lane = F.lane;
    for (int it = gw; it < nblk * kblk; it += ngw) {
        const int nb = it % nblk, kb = it / nblk; const int n0 = 32 * nb, k0 = 64 * kb;
        if (n0 >= skip_lo && n0 < skip_hi) continue;
        const int col = map(n0 + (lane & 31));
        float v[32];
        const float* wp = W + (size_t)(k0 + (lane >> 5)) * ldw + (col >= 0 ? col : 0);
#pragma unroll
        for (int i = 0; i < 32; ++i) v[i] = wp[(size_t)(2 * i) * ldw];
        if (ks) {
#pragma unroll
            for (int i = 0; i < 32; ++i) v[i] *= ks[k0 + 2 * i + (lane >> 5)]; }
#pragma unroll
        for (int i = 0; i < 32; ++i) scr[(2 * i + (lane >> 5)) * 33 + (lane & 31)] = col >= 0 ? v[i] : 0.f;
        asm volatile("s_waitcnt lgkmcnt(0)" ::: "memory");
        const int c = lane & 7;
#pragma unroll
        for (int j = 0; j < 4; ++j) { const int n = (lane >> 3) + 8 * j; const LAS float* sp = scr + (8 * c) * 33 + n;
            u32x4 o; o.x = cvt_pk_bf16(sp[0 * 33], sp[1 * 33]); o.y = cvt_pk_bf16(sp[2 * 33], sp[3 * 33]); o.z = cvt_pk_bf16(sp[4 * 33], sp[5 * 33]); o.w = cvt_pk_bf16(sp[6 * 33], sp[7 * 33]);
            *(u32x4*)(Wt + (size_t)(n0 + n) * K + k0 + 8 * c) = o; }
        asm volatile("s_waitcnt lgkmcnt(0)" ::: "memory");
    }
}
template <class Map>
__device__ __forceinline__ void conv_weight_i8(const Frame& F, const float* W, int ldw, unsigned char* Wt, int nrows, Map map, float* colscale, int vc, int nvc, int skip_lo = 0, int skip_hi = 0) {
    LAS float* scr = (LAS float*)(F.lds + F.wave * 8448);
    LAS float* cmx = (LAS float*)(F.lds + 68 * 1024);
    const int lane = F.lane;
    for (int it = vc; it < nrows / 32; it += nvc) {
        const int n0 = 32 * it; if (n0 >= skip_lo && n0 < skip_hi) continue;
        const int col = map(n0 + (lane & 31));
        float v[2][32]; float mx = 0.f;
#pragma unroll
        for (int t = 0; t < 2; ++t) { const int k0 = 64 * (2 * F.wave + t); const float* wp = W + (size_t)(k0 + (lane >> 5)) * ldw + (col >= 0 ? col : 0);
#pragma unroll
            for (int i = 0; i < 32; ++i) { v[t][i] = col >= 0 ? wp[(size_t)(2 * i) * ldw] : 0.f; } }
#pragma unroll
        for (int t = 0; t < 2; ++t)
#pragma unroll
            for (int i = 0; i < 32; ++i) mx = fmaxf(mx, fabsf(v[t][i]));
        mx = fmaxf(mx, __shfl_xor(mx, 32));
        __syncthreads();
        if (lane < 32) cmx[F.wave * 32 + lane] = mx;
        __syncthreads();
        float cm = 0.f;
#pragma unroll
        for (int w = 0; w < 8; ++w) cm = fmaxf(cm, cmx[w * 32 + (lane & 31)]);
        const float inv = cm > 0.f ? 127.f / cm : 0.f;
        if (F.wave == 0 && lane < 32) colscale[n0 + lane] = cm * (1.f / 127.f);
#pragma unroll
        for (int t = 0; t < 2; ++t) { const int k0 = 64 * (2 * F.wave + t);
#pragma unroll
            for (int i = 0; i < 32; ++i) scr[(2 * i + (lane >> 5)) * 33 + (lane & 31)] = v[t][i] * inv;
            asm volatile("s_waitcnt lgkmcnt(0)" ::: "memory");
            const int c = lane & 7;
#pragma unroll
            for (int j = 0; j < 4; ++j) { const int n = (lane >> 3) + 8 * j; const LAS float* sp = scr + (8 * c) * 33 + n;
                u32x2 o; o.x = pack4_i8(sp[0 * 33], sp[1 * 33], sp[2 * 33], sp[3 * 33]); o.y = pack4_i8(sp[4 * 33], sp[5 * 33], sp[6 * 33], sp[7 * 33]);
                *(u32x2*)(Wt + (size_t)(n0 + n) * 1024 + k0 + 8 * c) = o; }
            asm volatile("s_waitcnt lgkmcnt(0)" ::: "memory"); }
    }
}
__device__ __forceinline__ void quant_rows_i8(const Frame& F, const float* src, unsigned char* dst, float* rscale, int nrows, int vc, int nvc) {
    LAS float* cmx = (LAS float*)(F.lds + 68 * 1024);
    for (int it = vc; it < nrows / 32; it += nvc) {
        const int row = 32 * it + (F.tid & 31), kq = F.tid >> 5;
        f32x4 v[16]; float mx = 0.f;
#pragma unroll
        for (int i = 0; i < 16; ++i) { v[i] = *(const f32x4*)(src + (size_t)row * 1024 + 64 * kq + 4 * i); mx = fmaxf(fmaxf(mx, fmaxf(fabsf(v[i][0]), fabsf(v[i][1]))), fmaxf(fabsf(v[i][2]), fabsf(v[i][3]))); }
        __syncthreads();
        cmx[kq * 32 + (F.tid & 31)] = mx;
        __syncthreads();
        float cm = 0.f;
#pragma unroll
        for (int w = 0; w < 16; ++w) cm = fmaxf(cm, cmx[w * 32 + (F.tid & 31)]);
        const float inv = cm > 0.f ? 127.f / cm : 0.f;
        if (kq == 0) rscale[row] = cm * (1.f / 127.f);
#pragma unroll
        for (int i = 0; i < 16; i += 4) { u32x4 o; o.x = pack4_i8(v[i][0] * inv, v[i][1] * inv, v[i][2] * inv, v[i][3] * inv); o.y = pack4_i8(v[i + 1][0] * inv, v[i + 1][1] * inv, v[i + 1][2] * inv, v[i + 1][3] * inv);
            o.z = pack4_i8(v[i + 2][0] * inv, v[i + 2][1] * inv, v[i + 2][2] * inv, v[i + 2][3] * inv); o.w = pack4_i8(v[i + 3][0] * inv, v[i + 3][1] * inv, v[i + 3][2] * inv, v[i + 3][3] * inv);
            *(u32x4*)(dst + (size_t)row * 1024 + 64 * kq + 4 * i) = o; }
    }
}
__device__ __forceinline__ void conv_fourier_rows(const Frame& F, const float* W, float* Ft  , bool i8, int vc, int nvc) {
    LAS float* Wl = (LAS float*)(F.lds + 68 * 1024);
    LAS float* Tc = Wl + 64 * 65;
    for (int item = vc; item < 64; item += nvc) {
        const int g = item & 3, kb = item >> 2; const int k0 = 64 * kb;
        __syncthreads();
        for (int i = F.tid; i < 4096; i += NTHR) { const int kk = i >> 6, c = i & 63; Wl[kk * 65 + c] = W[(size_t)(k0 + kk) * NIN_SRC + 2096 + g * 64 + c]; }
        if (F.tid < 64) Tc[F.tid] = cospif((float)F.tid * (1.f / 32.f));
        __syncthreads();
        const int q = F.tid & 63, kq = F.tid >> 6; const bool issin = q >= 33; const int j = issin ? q - 32 : q;
        float acc[8];
#pragma unroll
        for (int i = 0; i < 8; ++i) acc[i] = 0.f;
        for (int c = 0; c < 64; ++c) { const int mm = (j * c) & 63; const float tw = issin ? -Tc[(mm + 48) & 63] : Tc[mm];
#pragma unroll
            for (int i = 0; i < 8; ++i) acc[i] += Wl[(8 * kq + i) * 65 + c] * tw; }
        const int fc = g * 64 + q; const int qq = fc & 31; const int fq = qq >> 3, nn = (qq >> 2) & 1, jj = qq & 3; const int rho = 16 * nn + 4 * fq + jj;
        if (i8) { float* dst = Ft + (size_t)((fc & ~31) + rho) * 1024 + k0 + 8 * kq;
            *(f32x4*)dst = (f32x4){acc[0], acc[1], acc[2], acc[3]}; *(f32x4*)(dst + 4) = (f32x4){acc[4], acc[5], acc[6], acc[7]}; }
        else { bf16_t* dst = (bf16_t*)Ft + (size_t)(2048 + (fc & ~31) + rho) * 1024 + k0 + 8 * kq;
            u32x4 o0; o0.x = cvt_pk_bf16(acc[0], acc[1]); o0.y = cvt_pk_bf16(acc[2], acc[3]); o0.z = cvt_pk_bf16(acc[4], acc[5]); o0.w = cvt_pk_bf16(acc[6], acc[7]);
            *(u32x4*)dst = o0; }
    }
}
__device__ __forceinline__ void build_cs(const Frame& F, bf16_t* CS, int N) {
    const long total = (long)N * (2 * N / 8); const long gt = (long)F.vcu * NTHR + F.tid, gs = (long)F.G * NTHR; const float inv = 2.0f / (float)N;
    for (long it = gt; it < total; it += gs) {
        const int cc = (int)(it % (2 * N / 8)), k = (int)(it / (2 * N / 8)); float v[8];
#pragma unroll
        for (int i = 0; i < 8; ++i) { const int col = cc * 8 + i; const int part = col >= N, n = col - part * N; const int mm = (int)(((long)k * n) % N); const float a = (float)mm * inv; v[i] = part ? sinpif(a) : cospif(a); }
        u32x4 o; o.x = pk2(v[0], v[1]); o.y = pk2(v[2], v[3]); o.z = pk2(v[4], v[5]); o.w = pk2(v[6], v[7]);
        *(u32x4*)(CS + (size_t)k * 2 * N + cc * 8) = o;
    }
}
__device__ __forceinline__ void build_cs2(const Frame& F, bf16_t* CS) {
    const long total = 1024L * 256; const long gt = (long)F.vcu * NTHR + F.tid, gs = (long)F.G * NTHR;
    for (long it = gt; it < total; it += gs) {
        const int cc = (int)(it & 255), k = (int)(it >> 8); float v[8];
#pragma unroll
        for (int i = 0; i < 8; ++i) { const int col = cc * 8 + i; const int part = col >> 10, n = col & 1023; const int mm = (k * n) & 2047; const float a = (float)mm * (1.f / 1024.f); v[i] = part ? sinpif(a) : cospif(a); }
        u32x4 o; o.x = pk2(v[0], v[1]); o.y = pk2(v[2], v[3]); o.z = pk2(v[4], v[5]); o.w = pk2(v[6], v[7]);
        *(u32x4*)(CS + (size_t)k * 2048 + cc * 8) = o;
    }
}
__device__ __forceinline__ void mod_gemv(const Frame& F) {
    LAS float* sc = (LAS float*)F.lds;
    LAS float* red = (LAS float*)(F.lds + 17 * 1024 * 4);
    const float* c = inp(1); const float* cctx = inp(3); const float* wm = inp(4); const float* bm = inp(5); float* mod = WSP(float, WS_MOD);
    bool loaded = false;
    for (int item = F.vcu; item < DEPTH * 128; item += F.G) {
        if (!loaded) { for (int i = F.tid; i < 17 * 1024; i += NTHR) { const float x = i < 16 * 1024 ? c[i] : cctx[i - 16 * 1024]; sc[i] = siluf_(x); } __syncthreads(); loaded = true; }
        const int l = item >> 7, cb = item & 127; const int cl = F.tid % 48, kp = F.tid / 48;
        if (kp < 8) {
            float a[17];
#pragma unroll
            for (int j = 0; j < 17; ++j) a[j] = 0.f;
            const float* wp = wm + (size_t)l * 1024 * 6144 + cb * 48 + cl;
#pragma unroll 2
            for (int k = kp * 128; k < kp * 128 + 128; k += 4) { const float w0 = wp[(size_t)k * 6144], w1 = wp[(size_t)(k + 1) * 6144], w2 = wp[(size_t)(k + 2) * 6144], w3 = wp[(size_t)(k + 3) * 6144];
#pragma unroll
                for (int j = 0; j < 17; ++j) { const f32x4 s4 = *(const LAS f32x4*)(sc + j * 1024 + k); a[j] += (s4[0] * w0 + s4[1] * w1) + (s4[2] * w2 + s4[3] * w3); } }
#pragma unroll
            for (int j = 0; j < 17; ++j) red[(kp * 48 + cl) * 17 + j] = a[j];
        }
        __syncthreads();
        for (int o = F.tid; o < 48 * 17; o += NTHR) { const int cc = o / 17, j = o % 17; float sacc = 0.f;
#pragma unroll
            for (int q = 0; q < 8; ++q) sacc += red[(q * 48 + cc) * 17 + j];
            mod[((size_t)l * 17 + j) * 6144 + cb * 48 + cc] = sacc + bm[(size_t)l * 6144 + cb * 48 + cc]; }
        __syncthreads();
    }
}
__device__ __forceinline__ void build_tables(const Frame& F) {
    float* rg = WSP(float, WS_TAB); float* rm = WSP(float, WS_TAB + 8192);
    const int gt = F.vcu * NTHR + F.tid;
    if (gt < 64 * 16) { const int pos = gt >> 4, i = gt & 15; const float inv = exp2f(-(float)i * (1.f / 16.f) * 13.287712379549449f); const float a = (float)pos * inv; rg[gt * 2] = cosf(a); rg[gt * 2 + 1] = sinf(a); }
    else if (gt < 64 * 16 + 64 * 8) { const int q = gt - 64 * 16; const int pos = q >> 3, i = q & 7; const float inv = exp2f(-(float)i * (1.f / 8.f) * 13.287712379549449f); const float a = (float)pos * inv; rm[q * 2] = cosf(a); rm[q * 2 + 1] = sinf(a); }
}
__device__ __forceinline__ void copy_f32(const Frame& F, const float* src, float* dst, size_t n4) {
    const size_t gt = (size_t)F.vcu * NTHR + F.tid, gs = (size_t)F.G * NTHR;
    for (size_t i = gt; i < n4; i += gs) ((f32x4*)dst)[i] = ((const f32x4*)src)[i];
}

__device__ __forceinline__ void convert_layer_weights(const Frame& F, int l, int vc, int nvc, int parts) {
    unsigned char* wl = F.ws + WS_W + (size_t)l * W_LAYER;
  if (parts & 1) {
    if (win8(l)) {
        conv_weight_i8(F, inp(10) + (size_t)l * 1024 * NIN_SRC, NIN_SRC, wl + W_IN, NIN, MapWin(), WSP(float, WS_WSCW) + l * 2560, vc, nvc, 2048, 2304);
        conv_fourier_rows(F, inp(10) + (size_t)l * 1024 * NIN_SRC, WSP(float, WS_FTMP) + (size_t)l * 256 * 1024, true, vc, nvc);
    } else {
        conv_weight(F, inp(10) + (size_t)l * 1024 * NIN_SRC, NIN_SRC, 1024, (bf16_t*)(wl + W_IN), NIN, nullptr, MapWin(), 2048, 2304, vc, nvc);
        conv_fourier_rows(F, inp(10) + (size_t)l * 1024 * NIN_SRC, (float*)(wl + W_IN), false, vc, nvc);
    }
    conv_weight(F, inp(12) + (size_t)l * 256 * 384, 384, 256, (bf16_t*)(wl + W_UQ), 512, inp(11) + l * 256, MapUq(), 0, 0, vc, nvc);
    conv_weight(F, inp(14) + (size_t)l * 256 * 512, 512, 256, (bf16_t*)(wl + W_UKV), 512, inp(13) + l * 256, MapIdent(), 0, 0, vc, nvc);
  }
  if (parts & 2) {
    conv_weight_i8(F, inp(18) + (size_t)l * 4 * 1024 * 1024, 1024, wl + W_G, 4096, MapGate(), WSP(float, WS_WSCG) + l * 4096, vc, nvc);
    conv_weight(F, inp(20) + (size_t)l * 4 * 256 * 1024, 1024, 256, (bf16_t*)(wl + W_B), 4096, nullptr, MapBranch(), 0, 0, vc, nvc);
    conv_weight(F, inp(21) + (size_t)l * 1024 * 1024, 1024, 1024, (bf16_t*)(wl + W_OUT), 1024, nullptr, MapIdentP(), 0, 0, vc, nvc);
  }
  if (parts & 4)
    conv_weight_i8(F, inp(22) + (size_t)l * 1024 * 5632, 5632, wl + W_UP, 5632, MapUp(), WSP(float, WS_WSCU) + l * 5632, vc, nvc);
  if (parts & 8)
    conv_weight(F, inp(25) + (size_t)l * 2816 * 1024, 1024, 2816, (bf16_t*)(wl + W_DOWN), 1024, nullptr, MapIdentP(), 0, 0, vc, nvc);
}

__device__ __forceinline__ void quant_row_store(const Frame& F, const f32x4 (&o)[4], unsigned char* o8row, float* scale_out) {
    float mx = 0.f;
#pragma unroll
    for (int j = 0; j < 4; ++j) mx = fmaxf(fmaxf(mx, fmaxf(fabsf(o[j][0]), fabsf(o[j][1]))), fmaxf(fabsf(o[j][2]), fabsf(o[j][3])));
#pragma unroll
    for (int d = 1; d < 64; d <<= 1) mx = fmaxf(mx, __shfl_xor(mx, d));
    const float inv = mx > 0.f ? 127.f / mx : 0.f;
#pragma unroll
    for (int j = 0; j < 4; ++j) *(unsigned*)(o8row + 4 * (F.lane + 64 * j)) = pack4_i8(o[j][0] * inv, o[j][1] * inv, o[j][2] * inv, o[j][3] * inv);
    if (F.lane == 0) *scale_out = mx * (1.f / 127.f);
}
__device__ __forceinline__ void norm_mod_row(const Frame& F, const float* xr, const float* gain, const float* sh, const float* sc, bf16_t* orow  , unsigned char* o8row, float* scale_out) {
    f32x4 v[4]; float s = 0.f;
#pragma unroll
    for (int j = 0; j < 4; ++j) { v[j] = ((const f32x4*)xr)[F.lane + 64 * j]; s += (v[j][0] * v[j][0] + v[j][1] * v[j][1]) + (v[j][2] * v[j][2] + v[j][3] * v[j][3]); }
    const float rstd = rsqrtf(wave_sum(s) * (1.f / D) + EPS);
    f32x4 o[4];
#pragma unroll
    for (int j = 0; j < 4; ++j) { const int c4 = F.lane + 64 * j; const f32x4 g = ((const f32x4*)gain)[c4], a = ((const f32x4*)sc)[c4], b = ((const f32x4*)sh)[c4];
#pragma unroll
        for (int e = 0; e < 4; ++e) o[j][e] = v[j][e] * rstd * g[e] * (1.f + a[e]) + b[e];
        if (orow) store4bf(orow + 4 * c4, o[j]);
    }
    quant_row_store(F, o, o8row, scale_out);
}
__device__ __forceinline__ void phase_norm1_in(const Frame& F) {
    const float* mod = WSP(float, WS_MOD); const float* gain = inp(6); const float* xin = inp(0); const float* cin = inp(2);
    const int gw = F.vcu * 8 + F.wave, ngw = F.G * 8;
    for (int r = gw; r < R; r += ngw) { const float* mr = mod + (size_t)modrow_of(r) * 6144; const float* xr = r < RL ? xin + (size_t)r * D : cin + (size_t)(r - RL) * D;
        if (win8(0)) norm_mod_row(F, xr, gain, mr, mr + 1024, nullptr, WSP(unsigned char, WS_H) + (size_t)r * D, WSP(float, WS_HS) + r);
        else norm_mod_row(F, xr, gain, mr, mr + 1024, WSP(bf16_t, WS_H) + (size_t)r * D, WSP(unsigned char, WS_H8A) + (size_t)r * D, WSP(float, WS_HS) + r);
    }
}
__device__ __forceinline__ void phase_post(const Frame& F, int l, const bf16_t* Yin, int nrows, bool second, bool from_input) {
    const float* mod = WSP(float, WS_MOD) + (size_t)l * 17 * 6144;
    const float* gpost = inp(second ? 9 : 7) + (size_t)l * D;
    const bool donorm = !second || l + 1 < DEPTH; const int ln = second ? l + 1 : l;
    const float* gpre = inp(second ? 6 : 8) + (size_t)ln * D; const float* modn = WSP(float, WS_MOD) + (size_t)ln * 17 * 6144;
    const float* xin0 = inp(0); const float* cin0 = inp(2);
    const int gw = F.vcu * 8 + F.wave, ngw = F.G * 8;
    for (int r = gw; r < nrows; r += ngw) {
        const int mrow = modrow_of(r); const float* mr = mod + (size_t)mrow * 6144; const float* gate = mr + (second ? 5 * 1024 : 2 * 1024);
        float* xo = (float*)xrow_ptr(F, r); const float* xi = from_input ? (r < RL ? xin0 + (size_t)r * D : cin0 + (size_t)(r - RL) * D) : xo; const bf16_t* yr = Yin + (size_t)r * D;
        f32x4 y[4]; float s = 0.f;
#pragma unroll
        for (int j = 0; j < 4; ++j) { const u32x2 w = ((const u32x2*)yr)[F.lane + 64 * j]; y[j] = (f32x4){lo_bf(w.x), hi_bf(w.x), lo_bf(w.y), hi_bf(w.y)}; s += (y[j][0] * y[j][0] + y[j][1] * y[j][1]) + (y[j][2] * y[j][2] + y[j][3] * y[j][3]); }
        const float rstd = rsqrtf(wave_sum(s) * (1.f / D) + EPS);
        f32x4 xn[4]; float s2 = 0.f;
#pragma unroll
        for (int j = 0; j < 4; ++j) { const int c4 = F.lane + 64 * j; const f32x4 g = ((const f32x4*)gpost)[c4], ga = ((const f32x4*)gate)[c4], xv = ((const f32x4*)xi)[c4];
#pragma unroll
            for (int e = 0; e < 4; ++e) xn[j][e] = xv[e] + ga[e] * (y[j][e] * rstd * g[e]);
            ((f32x4*)xo)[c4] = xn[j]; s2 += (xn[j][0] * xn[j][0] + xn[j][1] * xn[j][1]) + (xn[j][2] * xn[j][2] + xn[j][3] * xn[j][3]); }
        if (donorm) {
            const float rstd2 = rsqrtf(wave_sum(s2) * (1.f / D) + EPS); const float* mn = modn + (size_t)mrow * 6144; const float* shn = mn + (second ? 0 : 3 * 1024); const float* scn = mn + (second ? 1024 : 4 * 1024);
            f32x4 o[4];
#pragma unroll
            for (int j = 0; j < 4; ++j) { const int c4 = F.lane + 64 * j; const f32x4 g = ((const f32x4*)gpre)[c4], a = ((const f32x4*)scn)[c4], bsh = ((const f32x4*)shn)[c4];
#pragma unroll
                for (int e = 0; e < 4; ++e) o[j][e] = xn[j][e] * rstd2 * g[e] * (1.f + a[e]) + bsh[e];
                if (second && !win8(ln)) store4bf(WSP(bf16_t, WS_H) + (size_t)r * D + 4 * c4, o[j]);
            }
            if (!second) quant_row_store(F, o, WSP(unsigned char, WS_H2) + (size_t)r * D, WSP(float, WS_H2S) + r);
            else if (win8(ln)) quant_row_store(F, o, WSP(unsigned char, WS_H) + (size_t)r * D, WSP(float, WS_HS) + r);
            else if (r < RL) quant_row_store(F, o, WSP(unsigned char, WS_H8B) + (size_t)r * D, WSP(float, WS_HS) + r);
        }
    }
}
__device__ __forceinline__ void phase_fab_transpose(const Frame& F, int row0, int N, int nb, bf16_t* FT) {
    const bf16_t* FAB = WSP(bf16_t, WS_FAB);
    const long total = (long)nb * 2 * (N / 8) * 256; const long gt = (long)F.vcu * NTHR + F.tid, gs = (long)F.G * NTHR;
    for (long it = gt; it < total; it += gs) {
        const int col = (int)(it & 255); long q = it >> 8; const int nc = (int)(q % (N / 8)); q /= (N / 8); const int part = (int)(q & 1), b = (int)(q >> 1);
        const int g = col >> 6, j = col & 63; const int jj = j <= 32 ? j : 64 - j;
        const bool zer = part == 1 && (j == 0 || j == 32); const unsigned short flip = (part == 1 && j > 32) ? 0x8000u : 0u;
        const int slot = part == 0 ? jj : 32 + jj;
        unsigned short v[8];
#pragma unroll
        for (int i = 0; i < 8; ++i) v[i] = zer ? (unsigned short)0 : (unsigned short)(FAB[(size_t)(row0 + b * N + nc * 8 + i) * 256 + g * 64 + slot] ^ flip);
        u32x4 o; o.x = v[0] | ((unsigned)v[1] << 16); o.y = v[2] | ((unsigned)v[3] << 16); o.z = v[4] | ((unsigned)v[5] << 16); o.w = v[6] | ((unsigned)v[7] << 16);
        *(u32x4*)(FT + ((size_t)(b * 256 + col) * 2 * N + part * N + nc * 8)) = o;
    }
}
__device__ __forceinline__ void fold_unit(const Frame& F, int b, int g, int blk) {
    const bf16_t* FAB = WSP(bf16_t, WS_FAB); bf16_t* FT = WSP(bf16_t, WS_FABT); float* ALT = WSP(float, WS_TAB + 65536); float* A1024 = WSP(float, WS_TAB + 81920);
    LAS bf16_t* T = (LAS bf16_t*)F.lds;
    LAS float* red = (LAS float*)(F.lds + 131072);
    __syncthreads();
#pragma unroll 4
    for (int it = 0; it < 16; ++it) { const int n = it * 128 + (F.tid >> 2), ch = F.tid & 3;
        *(LAS u32x4*)(T + n * 32 + ch * 8) = *(const u32x4*)(FAB + (size_t)(b * SEQ + n) * 256 + g * 64 + blk * 32 + ch * 8); }
    __syncthreads();
    const int c = F.tid & 31; const bool cosrc = blk == 0 || c == 0;
    const int j1 = blk == 0 ? c : (c == 0 ? 32 : c); const int j2 = (c == 0) ? -1 : 64 - c;
    bf16_t* const d1 = FT + ((size_t)(b * 512 + g * 64 + j1)) * 2048 + (cosrc ? 0 : 1024);
    bf16_t* const d2 = FT + ((size_t)(b * 512 + g * 64 + (j2 < 0 ? 0 : j2))) * 2048 + (cosrc ? 0 : 1024);
#pragma unroll 2
    for (int it = 0; it < 8; ++it) { const int n0 = (it * 16 + (F.tid >> 5)) * 8; float v[8];
#pragma unroll
        for (int i = 0; i < 8; ++i) { const int n = n0 + i; const float x = bf2f(T[n * 32 + c]); const float y = n > 0 ? bf2f(T[(2048 - n) * 32 + c]) : 0.f; v[i] = cosrc ? x + y : (n > 0 ? x - y : 0.f); }
        u32x4 o; o.x = cvt_pk_bf16(v[0], v[1]); o.y = cvt_pk_bf16(v[2], v[3]); o.z = cvt_pk_bf16(v[4], v[5]); o.w = cvt_pk_bf16(v[6], v[7]);
        u32x4 on = o; on.x ^= 0x80008000u; on.y ^= 0x80008000u; on.z ^= 0x80008000u; on.w ^= 0x80008000u;
        if (cosrc) { *(u32x4*)(d1 + n0) = o; *(u32x4*)(d1 + (size_t)256 * 2048 + n0) = o; if (j2 >= 0) { *(u32x4*)(d2 + n0) = o; *(u32x4*)(d2 + (size_t)256 * 2048 + n0) = o; } }
        else { *(u32x4*)(d1 + n0) = o; *(u32x4*)(d1 + (size_t)256 * 2048 + n0) = on; *(u32x4*)(d2 + n0) = on; *(u32x4*)(d2 + (size_t)256 * 2048 + n0) = o; }
        if (blk == 1 && c == 0) {
            const u32x4 z = (u32x4){0u, 0u, 0u, 0u}; bf16_t* z0 = FT + ((size_t)(b * 512 + g * 64)) * 2048 + 1024 + n0; bf16_t* z1 = z0 + (size_t)32 * 2048;
            *(u32x4*)z0 = z; *(u32x4*)(z0 + (size_t)256 * 2048) = z; *(u32x4*)z1 = z; *(u32x4*)(z1 + (size_t)256 * 2048) = z; } }
    { const int q = F.tid >> 5; float sacc = 0.f;
      for (int n = q * 128; n < q * 128 + 128; n += 2) sacc += bf2f(T[n * 32 + c]) - bf2f(T[(n + 1) * 32 + c]);
      red[q * 32 + c] = sacc; __syncthreads();
      if (F.tid < 32 && (blk == 0 || F.tid == 0)) { float t = 0.f;
#pragma unroll
          for (int qq = 0; qq < 16; ++qq) t += red[qq * 32 + F.tid];
          const float a1024 = bf2f(T[1024 * 32 + F.tid]);
          ALT[b * 256 + g * 64 + j1] = t; A1024[b * 256 + g * 64 + j1] = a1024;
          if (j2 >= 0) { ALT[b * 256 + g * 64 + j2] = t; A1024[b * 256 + g * 64 + j2] = a1024; } } }
}
struct SchedDft2 {
    int G, c; const char* CS; const char* FT;
    __device__ __forceinline__ bool next(int i, Unit& u) const {
        const long L = (long)i * G + c; if (L >= 128) return false;
        const int b = (int)(L >> 3), pm = (int)((L >> 1) & 3), v = (int)(L & 1);
        u.pm = pm; u.pn = b * 2 + v; u.a = CS + (size_t)pm * 256 * 2048 * 2; u.b = FT + (size_t)(b * 512 + v * 256) * 2048 * 2; return true;
    }
};
struct EpiDft2 {
    unsigned char* ws;
    __device__ __forceinline__ void operator()(const Acc& acc, const Unit& u, int wr, int wc, int fr, int fq, LAS unsigned char* lds) const {
        bf16_t* const Y = EW(bf16_t, WS_Y); const float* const ALT = EW(float, WS_TAB + 65536); const float* const A1024 = EW(float, WS_TAB + 81920);
        const int b = u.pn >> 1, v = u.pn & 1; const float scale = 0.0027621358640099515f; const float sg = (fr & 1) ? -1.f : 1.f;
#pragma unroll
        EPI_LOOP_BN { const int col = 128 * bj + 32 * wc + 16 * n + 4 * fq; const f32x4 a4 = *(const f32x4*)(A1024 + b * 256 + col) * sg;
#pragma unroll
            EPI_LOOP_AM { const int k = 256 * u.pm + 128 * ai + 64 * wr + 16 * m + fr;
                f32x4 o = (acc[ai][bj][m][n] + a4) * scale; int row = v ? 2048 - k : k;
                if (v && k == 0) { row = 1024; o = *(const f32x4*)(ALT + b * 256 + col) * scale; }
                store4bf(Y + (size_t)(b * SEQ + row) * 1024 + 768 + col, o); } }
    }
};

template <int DQK, bool WIN>
__device__ __forceinline__ void attn_unit(LAS unsigned char* lds, const int tid,
        const bf16_t* qptr, const int ldq, const bf16_t* Kc, const bf16_t* Kl, const int ldk, const bf16_t* VT,
        const int nctx, const int lt0, const int lt1, const int qpos, const float m_init, const float l_init, bf16_t* optr) {
    constexpr int NS = DQK / 32, KB = 64 * DQK * 2, VB = 64 * 144, BUFB = KB + VB, KCH = DQK / 8;
    const int lane = tid & 63, quad = lane >> 4, l15 = lane & 15;
    const int nt = nctx + (lt1 - lt0);
    bf16x8 Qf[2][NS];
#pragma unroll
    for (int qt = 0; qt < 2; ++qt)
#pragma unroll
        for (int sx = 0; sx < NS; ++sx) Qf[qt][sx] = *(const bf16x8*)(qptr + (size_t)qt * 16 * ldq + 32 * sx);
    f32x4 O[4][2];
#pragma unroll
    for (int a = 0; a < 4; ++a) { O[a][0] = (f32x4){0.f, 0.f, 0.f, 0.f}; O[a][1] = (f32x4){0.f, 0.f, 0.f, 0.f}; }
    float mrun[2] = {m_init, m_init}, lrun[2] = {l_init, l_init};
    const int kkey0 = tid / KCH, kcc0 = tid % KCH, kkey1 = (tid + 512) / KCH, kcc1 = (tid + 512) % KCH;
    const bool k1on = (tid + 512) < 64 * KCH;
    int ko0, ko1;
    { int ob = (kkey0 & 15) * 64 + (kcc0 & 3) * 16; ob ^= ((ob >> 9) & 1) << 5; ko0 = ((kkey0 >> 4) * NS + (kcc0 >> 2)) * 1024 + ob; }
    { int ob = (kkey1 & 15) * 64 + (kcc1 & 3) * 16; ob ^= ((ob >> 9) & 1) << 5; ko1 = ((kkey1 >> 4) * NS + (kcc1 >> 2)) * 1024 + ob; }
    const int vdv = tid >> 3, vkc = tid & 7;
    int kfo; { int ob = l15 * 64 + quad * 16; ob ^= ((ob >> 9) & 1) << 5; kfo = ob; }
    const int vfo = l15 * 144 + quad * 8;
    u32x4 kr0, kr1, vr0, nk0, nk1, nv0;
    kr1 = (u32x4){0u, 0u, 0u, 0u}; nk1 = kr1;
#define ATT_LOAD(ti_, K0, K1, V0) do { const int ti__ = (ti_); const bool isc = ti__ < nctx; const int lt = lt0 + ti__ - nctx; \
        const bf16_t* kb = isc ? Kc + (size_t)ti__ * 64 * ldk : Kl + (size_t)lt * 64 * ldk; const int vcol = isc ? 64 * ti__ : 256 + 64 * lt; \
        K0 = *(const u32x4*)(kb + (size_t)kkey0 * ldk + 8 * kcc0); if (k1on) K1 = *(const u32x4*)(kb + (size_t)kkey1 * ldk + 8 * kcc1); \
        V0 = *(const u32x4*)(VT + (size_t)vdv * 2304 + vcol + 8 * vkc); } while (0)
#define ATT_WRITE(buf_, K0, K1, V0) do { LAS unsigned char* bp_ = lds + (buf_) * BUFB; *(LAS u32x4*)(bp_ + ko0) = K0; if (k1on) *(LAS u32x4*)(bp_ + ko1) = K1; *(LAS u32x4*)(bp_ + KB + vdv * 144 + vkc * 16) = V0; } while (0)
#define ATT_BAR() do { asm volatile("s_waitcnt lgkmcnt(0)" ::: "memory"); __builtin_amdgcn_s_barrier(); asm volatile("" ::: "memory"); } while (0)
    __syncthreads();
    ATT_LOAD(0, kr0, kr1, vr0); ATT_WRITE(0, kr0, kr1, vr0);
    if (nt > 1) ATT_LOAD(1, kr0, kr1, vr0);
    ATT_BAR();
#pragma unroll 1
    for (int ti = 0; ti < nt; ++ti) {
        if (ti + 2 < nt) ATT_LOAD(ti + 2, nk0, nk1, nv0);
        const LAS unsigned char* bp = lds + (ti & 1) * BUFB;
        f32x4 S[4][2];
        bf16x8 kfr[4][NS];
#pragma unroll
        for (int kt = 0; kt < 4; ++kt)
#pragma unroll
            for (int sx = 0; sx < NS; ++sx) kfr[kt][sx] = *(const LAS bf16x8*)(bp + (kt * NS + sx) * 1024 + kfo);
        __builtin_amdgcn_sched_barrier(0);
        __builtin_amdgcn_s_setprio(1);
#pragma unroll
        for (int kt = 0; kt < 4; ++kt) { S[kt][0] = (f32x4){-mrun[0], -mrun[0], -mrun[0], -mrun[0]}; S[kt][1] = (f32x4){-mrun[1], -mrun[1], -mrun[1], -mrun[1]}; }
#pragma unroll
        for (int sx = 0; sx < NS; ++sx)
#pragma unroll
            for (int kt = 0; kt < 4; ++kt) {
                S[kt][0] = __builtin_amdgcn_mfma_f32_16x16x32_bf16(kfr[kt][sx], Qf[0][sx], S[kt][0], 0, 0, 0);
                S[kt][1] = __builtin_amdgcn_mfma_f32_16x16x32_bf16(kfr[kt][sx], Qf[1][sx], S[kt][1], 0, 0, 0); }
        __builtin_amdgcn_s_setprio(0);
        u32x2 vfr[2][4][2];
#pragma unroll
        for (int ks = 0; ks < 2; ++ks)
#pragma unroll
            for (int a = 0; a < 4; ++a) { vfr[ks][a][0] = *(const LAS u32x2*)(bp + KB + a * 16 * 144 + ks * 64 + vfo); vfr[ks][a][1] = *(const LAS u32x2*)(bp + KB + a * 16 * 144 + ks * 64 + 32 + vfo); }
        __builtin_amdgcn_sched_barrier(0);
        if (WIN && ti >= nctx) { const int kp0 = 64 * (lt0 + ti - nctx) + 4 * quad;
#pragma unroll
            for (int qt = 0; qt < 2; ++qt) { const int qp = qpos + 16 * qt;
#pragma unroll
                for (int kt = 0; kt < 4; ++kt)
#pragma unroll
                    for (int j = 0; j < 4; ++j) { const int dl = kp0 + 16 * kt + j - qp; if (dl > 128 || dl < -128) S[kt][qt][j] = -1e30f; } } }
        unsigned Pw[2][2][4];
        float ps[2];
#define ATT_EXP() do { _Pragma("unroll") for (int qt = 0; qt < 2; ++qt) { float acc_ = 0.f; \
            _Pragma("unroll") for (int kt = 0; kt < 4; ++kt) { const float p0 = fexp2(S[kt][qt][0]), p1 = fexp2(S[kt][qt][1]), p2 = fexp2(S[kt][qt][2]), p3 = fexp2(S[kt][qt][3]); \
                acc_ += (p0 + p1) + (p2 + p3); Pw[qt][kt >> 1][(kt & 1) * 2] = cvt_pk_bf16(p0, p1); Pw[qt][kt >> 1][(kt & 1) * 2 + 1] = cvt_pk_bf16(p2, p3); } ps[qt] = acc_; } } while (0)
        ATT_EXP();
        if (ti == 0 || __any(!(ps[0] < 1.0e18f) || !(ps[1] < 1.0e18f))) {
#pragma unroll
            for (int qt = 0; qt < 2; ++qt) {
                float mx = fmaxf(fmaxf(S[0][qt][0], S[0][qt][1]), fmaxf(S[0][qt][2], S[0][qt][3]));
#pragma unroll
                for (int kt = 1; kt < 4; ++kt) mx = fmaxf(mx, fmaxf(fmaxf(S[kt][qt][0], S[kt][qt][1]), fmaxf(S[kt][qt][2], S[kt][qt][3])));
                mx = fmaxf(mx, __shfl_xor(mx, 16)); mx = fmaxf(mx, __shfl_xor(mx, 32));
                const float d = (ti == 0 && !WIN) ? mx : fmaxf(mx, 0.f);
                const float al = (ti == 0 && !WIN) ? 0.f : fexp2(-d); mrun[qt] += d; lrun[qt] *= al;
#pragma unroll
                for (int a = 0; a < 4; ++a) O[a][qt] = O[a][qt] * al;
#pragma unroll
                for (int kt = 0; kt < 4; ++kt) S[kt][qt] = S[kt][qt] - d; }
            ATT_EXP();
        }
#undef ATT_EXP
        lrun[0] += ps[0]; lrun[1] += ps[1];
        __builtin_amdgcn_s_setprio(1);
#pragma unroll
        for (int ks = 0; ks < 2; ++ks) {
            bf16x8 pf0, pf1;
            { u32x4 t0 = (u32x4){Pw[0][ks][0], Pw[0][ks][1], Pw[0][ks][2], Pw[0][ks][3]}, t1 = (u32x4){Pw[1][ks][0], Pw[1][ks][1], Pw[1][ks][2], Pw[1][ks][3]};
              pf0 = __builtin_bit_cast(bf16x8, t0); pf1 = __builtin_bit_cast(bf16x8, t1); }
#pragma unroll
            for (int a = 0; a < 4; ++a) {
                const u32x4 vv = (u32x4){vfr[ks][a][0].x, vfr[ks][a][0].y, vfr[ks][a][1].x, vfr[ks][a][1].y}; const bf16x8 vf = __builtin_bit_cast(bf16x8, vv);
                O[a][0] = __builtin_amdgcn_mfma_f32_16x16x32_bf16(vf, pf0, O[a][0], 0, 0, 0);
                O[a][1] = __builtin_amdgcn_mfma_f32_16x16x32_bf16(vf, pf1, O[a][1], 0, 0, 0); }
        }
        __builtin_amdgcn_s_setprio(0);
        if (ti + 1 < nt) ATT_WRITE((ti + 1) & 1, kr0, kr1, vr0);
        ATT_BAR();
        kr0 = nk0; kr1 = nk1; vr0 = nv0;
    }
#undef ATT_LOAD
#undef ATT_WRITE
#pragma unroll
    for (int qt = 0; qt < 2; ++qt) { float l = lrun[qt]; l += __shfl_xor(l, 16); l += __shfl_xor(l, 32); const float inv = frcp(l);
#pragma unroll
        for (int a = 0; a < 4; ++a) { const f32x4 o = O[a][qt] * inv; u32x2 w; w.x = cvt_pk_bf16(o[0], o[1]); w.y = cvt_pk_bf16(o[2], o[3]); *(u32x2*)(optr + (size_t)qt * 16 * 1024 + 16 * a) = w; } }
}
__device__ __forceinline__ void mla_unit(const Frame& F, int b, int h, int q0, bool ctxq) {
    const bf16_t* Q96 = WSP(bf16_t, WS_Q96); const bf16_t* K96 = WSP(bf16_t, WS_K96); const bf16_t* VT = WSP(bf16_t, WS_V); bf16_t* Y = WSP(bf16_t, WS_Y);
    const int quad = F.lane >> 4, l15 = F.lane & 15; const int qrow = (ctxq ? RL + b * CTX : b * SEQ + q0) + 32 * F.wave + l15;
    attn_unit<96, false>(F.lds, F.tid, Q96 + (size_t)qrow * 384 + h * 96 + 8 * quad, 384, K96 + (size_t)(RL + b * CTX) * 384 + h * 96, K96 + (size_t)(b * SEQ) * 384 + h * 96, 384,
                         VT + (size_t)((b * 4 + h) * 64) * 2304, 4, 0, ctxq ? 0 : 32, 0, 0.f, 0.f, Y + (size_t)qrow * 1024 + h * 64 + 4 * quad);
}
__device__ __forceinline__ void gqa_unit(const Frame& F, int l, int b, int kvh, int p0, bool ctxq) {
    const bf16_t* GQ = WSP(bf16_t, WS_GQ); const bf16_t* GK = WSP(bf16_t, WS_GK); const bf16_t* GVT = WSP(bf16_t, WS_GV); bf16_t* Y = WSP(bf16_t, WS_Y);
    const int quad = F.lane >> 4, l15 = F.lane & 15; const int hq = 2 * kvh + (F.wave >> 2); const int pos = p0 + 32 * (F.wave & 3) + l15;
    const int qrow = (ctxq ? RL + b * CTX : b * SEQ) + pos; const float sink = inp(17)[l * 4 + hq] * LOG2E;
    const int lt0 = ctxq ? 0 : max(0, p0 - 128) / 64, lt1 = ctxq ? 0 : min(SEQ, p0 + 256) / 64;
    attn_unit<64, true>(F.lds, F.tid, GQ + (size_t)qrow * 256 + hq * 64 + 8 * quad, 256, GK + (size_t)(RL + b * CTX) * 128 + kvh * 64, GK + (size_t)(b * SEQ) * 128 + kvh * 64, 128,
                        GVT + (size_t)((b * 2 + kvh) * 64) * 2304, 4, lt0, lt1, pos, sink, quad == 0 ? 1.f : 0.f, Y + (size_t)qrow * 1024 + 512 + hq * 64 + 4 * quad);
}
__device__ __forceinline__ float logsigmoidf_(float x) { return fminf(x, 0.f) - log1pf(__expf(-fabsf(x))); }
__device__ __forceinline__ void mlstm_naive_unit(const Frame& F, int l, int b, int h, bool ctx_out) {
    const bf16_t* MQK = WSP(bf16_t, WS_MQK); const bf16_t* MV = WSP(bf16_t, WS_MV); const bf16_t* MO = WSP(bf16_t, WS_MO); const float* MG = WSP(float, WS_MG);
    float* HF = WSP(float, WS_HF); bf16_t* Y = WSP(bf16_t, WS_Y);
    const float* wcv = inp(15) + (size_t)l * 3 * 512; const float* bgate = inp(16) + (size_t)l * 16;
    LAS float* qs = (LAS float*)F.lds; LAS float* ks = qs + 8192; LAS float* vs = ks + 8192; LAS float* Cs = vs + 8192; LAS float* ns = Cs + 4096;
    LAS float* gs = ns + 64; LAS float* Ms = gs + 128; LAS float* cums = Ms + 128; LAS float* lis = cums + 128; LAS float* lfs = lis + 128; LAS float* mst = lfs + 128;
    const int tid = F.tid;
    for (int dir = 0; dir < 2; ++dir) {
        __syncthreads();
        for (int i = tid; i < 4096; i += NTHR) Cs[i] = 0.f;
        if (tid < 64) ns[tid] = 0.f;
        if (tid == 0) mst[0] = 0.f;
        __syncthreads();
        for (int j = 0; j < 18; ++j) {
            const bool isctx = j < 2; const int nseq = isctx ? CTX : SEQ; const int cj = isctx ? j : j - 2; const int base = isctx ? RL + b * CTX : b * SEQ;
            for (int i = tid; i < 128 * 64; i += NTHR) { const int p = i >> 6, d = i & 63; const int sp = cj * 128 + p; const int t = dir ? nseq - 1 - sp : sp; const size_t r = (size_t)(base + t);
                const int cq = h * 64 + d, ck = 256 + h * 64 + d;
                float aq = wcv[512 + cq] * bf2f(MQK[r * 512 + cq]), ak = wcv[512 + ck] * bf2f(MQK[r * 512 + ck]);
                if (t > 0) { aq += wcv[cq] * bf2f(MQK[(r - 1) * 512 + cq]); ak += wcv[ck] * bf2f(MQK[(r - 1) * 512 + ck]); }
                if (t < nseq - 1) { aq += wcv[1024 + cq] * bf2f(MQK[(r + 1) * 512 + cq]); ak += wcv[1024 + ck] * bf2f(MQK[(r + 1) * 512 + ck]); }
                qs[i] = siluf_(aq); ks[i] = siluf_(ak) * 0.125f; vs[i] = bf2f(MV[r * 256 + h * 64 + d]); }
            if (tid < 128) { const int sp = cj * 128 + tid; const int t = dir ? nseq - 1 - sp : sp; const size_t r = (size_t)(base + t);
                lis[tid] = MG[r * 16 + 8 * dir + h] + bgate[8 * dir + h]; lfs[tid] = logsigmoidf_(MG[r * 16 + 8 * dir + 4 + h] + bgate[8 * dir + 4 + h]); }
            __syncthreads();
            if (tid == 0) { float cum = 0.f, pm = -INFINITY; const float m0 = mst[0];
                for (int p = 0; p < 128; ++p) { cum += lfs[p]; const float g = lis[p] - cum; pm = fmaxf(pm, g); cums[p] = cum; gs[p] = g; Ms[p] = fmaxf(m0, pm); } }
            __syncthreads();
            const float m0 = mst[0];
            { const int p = tid >> 2, eg = tid & 3; float q[16], num[16]; float den = 0.f; const float Mp = Ms[p];
#pragma unroll
              for (int d = 0; d < 16; d += 4) { const f32x4 t4 = *(const LAS f32x4*)(qs + p * 64 + 16 * eg + d); q[d] = t4[0]; q[d + 1] = t4[1]; q[d + 2] = t4[2]; q[d + 3] = t4[3]; }
#pragma unroll
              for (int e = 0; e < 16; ++e) num[e] = 0.f;
              const int pmax = (p | 15);
              for (int s = 0; s <= pmax; ++s) { float dot = 0.f;
#pragma unroll
                  for (int d = 0; d < 16; d += 4) { const f32x4 kv = *(const LAS f32x4*)(ks + s * 64 + 16 * eg + d); dot += q[d] * kv[0] + q[d + 1] * kv[1] + q[d + 2] * kv[2] + q[d + 3] * kv[3]; }
                  dot += __shfl_xor(dot, 1); dot += __shfl_xor(dot, 2);
                  const float S = s <= p ? dot * __expf(gs[s] - Mp) : 0.f; den += S;
#pragma unroll
                  for (int e = 0; e < 16; e += 4) { const f32x4 vv = *(const LAS f32x4*)(vs + s * 64 + 16 * eg + e); num[e] += S * vv[0]; num[e + 1] += S * vv[1]; num[e + 2] += S * vv[2]; num[e + 3] += S * vv[3]; } }
              const float wint = __expf(m0 - Mp); float qn = 0.f;
              for (int d = 0; d < 64; ++d) { const float qd = qs[p * 64 + d]; qn += qd * ns[d]; const float wq = wint * qd;
#pragma unroll
                  for (int e = 0; e < 16; e += 4) { const f32x4 cv = *(const LAS f32x4*)(Cs + d * 64 + 16 * eg + e); num[e] += wq * cv[0]; num[e + 1] += wq * cv[1]; num[e + 2] += wq * cv[2]; num[e + 3] += wq * cv[3]; } }
              den += wint * qn; const float dn = fmaxf(fabsf(den), __expf(-(cums[p] + Mp))); const float inv = 1.f / dn;
              const int sp = cj * 128 + p; const int t = dir ? nseq - 1 - sp : sp; const size_t r = (size_t)(base + t);
              if (!isctx || ctx_out) {
                  if (dir == 0) {
#pragma unroll
                      for (int e = 0; e < 16; e += 4) *(f32x4*)(HF + r * 256 + h * 64 + 16 * eg + e) = (f32x4){num[e] * inv, num[e + 1] * inv, num[e + 2] * inv, num[e + 3] * inv};
                  } else {
#pragma unroll
                      for (int e = 0; e < 16; e += 4) { const f32x4 hf = *(const f32x4*)(HF + r * 256 + h * 64 + 16 * eg + e); const u32x2 ow = *(const u32x2*)(MO + r * 256 + h * 64 + 16 * eg + e);
                          f32x4 o; o[0] = lo_bf(ow.x) * (hf[0] + num[e] * inv); o[1] = hi_bf(ow.x) * (hf[1] + num[e + 1] * inv); o[2] = lo_bf(ow.y) * (hf[2] + num[e + 2] * inv); o[3] = hi_bf(ow.y) * (hf[3] + num[e + 3] * inv);
                          store4bf(Y + r * 1024 + 256 + h * 64 + 16 * eg + e, o); }
                  }
              }
            }
            __syncthreads();
            { const int d = tid >> 3, e0 = (tid & 7) * 8; const float M127 = Ms[127]; const float decay = __expf(m0 - M127);
              float a[8]; float an = 0.f;
#pragma unroll
              for (int e = 0; e < 8; ++e) a[e] = 0.f;
              for (int s = 0; s < 128; ++s) { const float wk = __expf(gs[s] - M127) * ks[s * 64 + d]; an += wk;
                  const f32x4 v0 = *(const LAS f32x4*)(vs + s * 64 + e0), v1 = *(const LAS f32x4*)(vs + s * 64 + e0 + 4);
                  a[0] += wk * v0[0]; a[1] += wk * v0[1]; a[2] += wk * v0[2]; a[3] += wk * v0[3]; a[4] += wk * v1[0]; a[5] += wk * v1[1]; a[6] += wk * v1[2]; a[7] += wk * v1[3]; }
#pragma unroll
              for (int e = 0; e < 8; ++e) Cs[d * 64 + e0 + e] = decay * Cs[d * 64 + e0 + e] + a[e];
              if ((tid & 7) == 0) ns[d] = decay * ns[d] + an;
              __syncthreads();
              if (tid == 0) mst[0] = cums[127] + M127;
            }
            __syncthreads();
        }
    }
}
__device__ __forceinline__ int swz16(int row16, int byte_in_row) { const int ob = row16 * 64 + byte_in_row; return ob ^ (((ob >> 9) & 1) << 5); }
__device__ __forceinline__ void conv_silu8(const bf16_t* MQK, const float* EDQ, const float* wcv, size_t r, int t, int nseq, int col0, float scale, float (&o)[8]) {
    const int rr = (int)(r & 255);
    if (rr != 0 && rr != 255) {
        const u32x4 x = *(const u32x4*)(MQK + r * 512 + col0);
        o[0] = lo_bf(x.x); o[1] = hi_bf(x.x); o[2] = lo_bf(x.y); o[3] = hi_bf(x.y); o[4] = lo_bf(x.z); o[5] = hi_bf(x.z); o[6] = lo_bf(x.w); o[7] = hi_bf(x.w);
    } else {
        const int pm = (int)(r >> 8), tq = col0 >> 8, cc = col0 & 255; const float* e = EDQ + (size_t)(pm * 2 + tq) * 1024 + cc;
        f32x4 p0 = (f32x4){0.f, 0.f, 0.f, 0.f}, p1 = p0, n0 = p0, n1 = p0, c0v, c1v;
        if (rr == 0) { if (t > 0) { p0 = *(const f32x4*)(e - 2048 + 768); p1 = *(const f32x4*)(e - 2048 + 768 + 4); } c0v = *(const f32x4*)e; c1v = *(const f32x4*)(e + 4); n0 = *(const f32x4*)(e + 256); n1 = *(const f32x4*)(e + 256 + 4); }
        else { p0 = *(const f32x4*)(e + 512); p1 = *(const f32x4*)(e + 512 + 4); c0v = *(const f32x4*)(e + 768); c1v = *(const f32x4*)(e + 768 + 4); if (t < nseq - 1) { n0 = *(const f32x4*)(e + 2048); n1 = *(const f32x4*)(e + 2048 + 4); } }
        const f32x4 wa0 = *(const f32x4*)(wcv + col0), wa1 = *(const f32x4*)(wcv + col0 + 4), wb0 = *(const f32x4*)(wcv + 512 + col0), wb1 = *(const f32x4*)(wcv + 512 + col0 + 4), wc0 = *(const f32x4*)(wcv + 1024 + col0), wc1 = *(const f32x4*)(wcv + 1024 + col0 + 4);
#pragma unroll
        for (int i = 0; i < 4; ++i) { o[i] = siluf_(wa0[i] * p0[i] + wb0[i] * c0v[i] + wc0[i] * n0[i]) * scale; o[4 + i] = siluf_(wa1[i] * p1[i] + wb1[i] * c1v[i] + wc1[i] * n1[i]) * scale; }
    }
}
__device__ __forceinline__ void mlstm_gate_load(int tid, const float* MG, size_t r0, int h, float (&gv)[4]) {
    gv[0] = gv[1] = gv[2] = gv[3] = 0.f;
    if (tid < 128) { const int dir = tid >> 6, l = tid & 63; const int t0 = dir ? 127 - 2 * l : 2 * l, t1 = dir ? 126 - 2 * l : 2 * l + 1;
        gv[0] = MG[(r0 + t0) * 16 + 8 * dir + h]; gv[1] = MG[(r0 + t1) * 16 + 8 * dir + h]; gv[2] = MG[(r0 + t0) * 16 + 8 * dir + 4 + h]; gv[3] = MG[(r0 + t1) * 16 + 8 * dir + 4 + h]; }
}
__device__ __forceinline__ void mlstm_gate_scan(int tid, const float (&gv)[4], const float* bgate, int h, LAS float* gF, LAS float* gB, LAS float* cF, LAS float* cB, LAS float* pF, LAS float* pB) {
    if (tid < 128) {
        const int dir = tid >> 6, l = tid & 63; const int t0 = dir ? 127 - 2 * l : 2 * l, t1 = dir ? 126 - 2 * l : 2 * l + 1;
        const float bi = bgate[8 * dir + h], bfg = bgate[8 * dir + 4 + h];
        const float li0 = gv[0] + bi, li1 = gv[1] + bi; const float lf0 = logsigmoidf_(gv[2] + bfg), lf1 = logsigmoidf_(gv[3] + bfg);
        float sc = lf0 + lf1;
#pragma unroll
        for (int d = 1; d < 64; d <<= 1) { const float t = __shfl_up(sc, d); if (l >= d) sc += t; }
        const float c1 = sc, c0 = sc - lf1; const float g0 = li0 - c0, g1 = li1 - c1;
        float mx = fmaxf(g0, g1);
#pragma unroll
        for (int d = 1; d < 64; d <<= 1) { const float t = __shfl_up(mx, d); if (l >= d) mx = fmaxf(mx, t); }
        float mprev = __shfl_up(mx, 1); if (l == 0) mprev = -INFINITY;
        const float p0 = fmaxf(mprev, g0), p1 = mx;
        LAS float* g = dir ? gB : gF; LAS float* c = dir ? cB : cF; LAS float* p = dir ? pB : pF;
        g[t0] = g0; g[t1] = g1; c[t0] = c0; c[t1] = c1; p[t0] = p0; p[t1] = p1;
    }
    __syncthreads();
}
__device__ __forceinline__ void mlstm_passA_unit(const Frame& F, int l, int b, int h, int jj) {
    const bf16_t* MQK = WSP(bf16_t, WS_MQK); const bf16_t* MV = WSP(bf16_t, WS_MV); const float* MG = WSP(float, WS_MG);
    const float* wcv = inp(15) + (size_t)l * 3 * 512; const float* bgate = inp(16) + (size_t)l * 16;
    const bool isctx = jj < 2; const int nseq = isctx ? CTX : SEQ; const int c = isctx ? jj : jj - 2; const size_t r0 = (size_t)(isctx ? RL + b * CTX : b * SEQ) + 128 * c;
    LAS unsigned char* Vt = F.lds;
    LAS unsigned char* Kw = F.lds + 16384;
    LAS float* gF = (LAS float*)(F.lds + 49152); LAS float* gB = gF + 128; LAS float* cF = gB + 128; LAS float* cB = cF + 128; LAS float* pF = cB + 128; LAS float* pB = pF + 128;
    const int tid = F.tid;
    float gv[4]; mlstm_gate_load(tid, MG, r0, h, gv);
    const int sx = tid >> 2, part = tid & 3; const size_t r = r0 + sx; const int t = 128 * c + sx;
    float kv[2][8]; u32x4 vv2[2];
#pragma unroll
    for (int hh = 0; hh < 2; ++hh) { const int d0 = 16 * part + 8 * hh; conv_silu8(MQK, WSP(float, WS_EDQ), wcv, r, t, nseq, 256 + h * 64 + d0, 0.125f, kv[hh]); vv2[hh] = *(const u32x4*)(MV + r * 256 + h * 64 + d0); }
    __syncthreads();
    mlstm_gate_scan(tid, gv, bgate, h, gF, gB, cF, cB, pF, pB);
    const float pmF = pF[127], pmB = pB[0];
    { const float wF = fexp(gF[sx] - pmF), wB = fexp(gB[sx] - pmB);
#pragma unroll
      for (int hh = 0; hh < 2; ++hh) { const int d0 = 16 * part + 8 * hh;
#pragma unroll
          for (int i = 0; i < 8; ++i) { const int d = d0 + i; const int off = ((d >> 4) * 4 + (sx >> 5)) * 1024 + swz16(d & 15, (sx & 31) * 2);
              *(LAS bf16_t*)(Kw + off) = (bf16_t)f2bf(kv[hh][i] * wF); *(LAS bf16_t*)(Kw + 16384 + off) = (bf16_t)f2bf(kv[hh][i] * wB); }
          const unsigned vw[4] = {vv2[hh].x, vv2[hh].y, vv2[hh].z, vv2[hh].w};
#pragma unroll
          for (int i = 0; i < 8; ++i) { const int e = d0 + i; const int off = ((e >> 4) * 4 + (sx >> 5)) * 1024 + swz16(e & 15, (sx & 31) * 2);
              *(LAS bf16_t*)(Vt + off) = (bf16_t)((i & 1) ? (vw[i >> 1] >> 16) : (vw[i >> 1] & 0xffffu)); } } }
    __syncthreads();
    const int dir = F.wave >> 2, et = F.wave & 3, quad = F.lane >> 4, l15 = F.lane & 15; const int kfo = swz16(l15, quad * 16);
    const int chain = (b * 4 + h) * 2 + dir; const int j = dir == 0 ? jj : (isctx ? 1 - c : 17 - c);
    f32x4 acc[4];
#pragma unroll
    for (int dt = 0; dt < 4; ++dt) acc[dt] = (f32x4){0.f, 0.f, 0.f, 0.f};
#pragma unroll
    for (int ks = 0; ks < 4; ++ks) { const bf16x8 af = *(const LAS bf16x8*)(Vt + (et * 4 + ks) * 1024 + kfo);
#pragma unroll
        for (int dt = 0; dt < 4; ++dt) { const bf16x8 bf = *(const LAS bf16x8*)(Kw + dir * 16384 + (dt * 4 + ks) * 1024 + kfo); acc[dt] = __builtin_amdgcn_mfma_f32_16x16x32_bf16(af, bf, acc[dt], 0, 0, 0); } }
    bf16_t* KVL = WSP(bf16_t, WS_KVL) + ((size_t)chain * 18 + j) * 4096;
#pragma unroll
    for (int dt = 0; dt < 4; ++dt)
#pragma unroll
        for (int i = 0; i < 4; ++i) KVL[(16 * et + 4 * quad + i) * 64 + 16 * dt + l15] = (bf16_t)f2bf(acc[dt][i]);
    if (tid < 128) { const int dr = tid >> 6, d = tid & 63; float sacc = 0.f;
        for (int sx = 0; sx < 128; ++sx) sacc += bf2f(*(const LAS bf16_t*)(Kw + dr * 16384 + ((d >> 4) * 4 + (sx >> 5)) * 1024 + swz16(d & 15, (sx & 31) * 2)));
        const int ch2 = (b * 4 + h) * 2 + dr; const int j2 = dr == 0 ? jj : (isctx ? 1 - c : 17 - c);
        WSP(float, WS_NL)[((size_t)ch2 * 18 + j2) * 64 + d] = sacc;
        if (d == 0) { float* scl = WSP(float, WS_SCL) + ((size_t)ch2 * 18 + j2) * 2; scl[0] = dr == 0 ? cF[127] : cB[0]; scl[1] = dr == 0 ? pmF : pmB; } }
}
__device__ __forceinline__ void mlstm_passB_unit(const Frame& F, int chain, int half) {
    const bf16_t* KVL = WSP(bf16_t, WS_KVL) + (size_t)chain * 18 * 4096; bf16_t* CT = WSP(bf16_t, WS_CT) + (size_t)chain * 18 * 4096;
    const float* NL = WSP(float, WS_NL) + (size_t)chain * 18 * 64; float* NS = WSP(float, WS_NS) + (size_t)chain * 18 * 64; const float* SCL = WSP(float, WS_SCL) + (size_t)chain * 18 * 2; float* MS = WSP(float, WS_MS) + (size_t)chain * 18;
    const int idx = half * 2048 + F.tid * 4; const bool nthr = half == 0 && F.tid < 64;
    f32x4 C = (f32x4){0.f, 0.f, 0.f, 0.f}; float nst = 0.f, mst = 0.f;
    u32x2 kv[18]; float nl[18]; f32x2 sc[18];
#pragma unroll
    for (int j = 0; j < 18; ++j) { kv[j] = *(const u32x2*)(KVL + (size_t)j * 4096 + idx); nl[j] = nthr ? NL[j * 64 + F.tid] : 0.f; sc[j] = *(const f32x2*)(SCL + j * 2); }
#pragma unroll
    for (int j = 0; j < 18; ++j) {
        u32x2 cw; cw.x = cvt_pk_bf16(C[0], C[1]); cw.y = cvt_pk_bf16(C[2], C[3]); *(u32x2*)(CT + (size_t)j * 4096 + idx) = cw;
        if (nthr) NS[j * 64 + F.tid] = nst;
        if (half == 0 && F.tid == 0) MS[j] = mst;
        const float Mx = fmaxf(mst, sc[j][1]), decay = fexp(mst - Mx), sl = fexp(sc[j][1] - Mx);
        C[0] = decay * C[0] + sl * lo_bf(kv[j].x); C[1] = decay * C[1] + sl * hi_bf(kv[j].x); C[2] = decay * C[2] + sl * lo_bf(kv[j].y); C[3] = decay * C[3] + sl * hi_bf(kv[j].y);
        nst = decay * nst + sl * nl[j]; mst = sc[j][0] + Mx;
    }
}
__device__ __forceinline__ void mlstm_passC_unit(const Frame& F, int l, int b, int h, int jj) {
    const bf16_t* MQK = WSP(bf16_t, WS_MQK); const bf16_t* MV = WSP(bf16_t, WS_MV); const bf16_t* MO = WSP(bf16_t, WS_MO); const float* MG = WSP(float, WS_MG); bf16_t* Y = WSP(bf16_t, WS_Y);
    const float* wcv = inp(15) + (size_t)l * 3 * 512; const float* bgate = inp(16) + (size_t)l * 16;
    const bool isctx = jj < 2; const int nseq = isctx ? CTX : SEQ; const int c = isctx ? jj : jj - 2; const size_t r0 = (size_t)(isctx ? RL + b * CTX : b * SEQ) + 128 * c;
    const int chF = (b * 4 + h) * 2, chB = chF + 1; const int jF = jj, jB = isctx ? 1 - c : 17 - c;
    LAS unsigned char* Qs = F.lds;
    LAS unsigned char* Ks = F.lds + 16384;
    LAS unsigned char* Vt = F.lds + 32768;
    LAS unsigned char* CF = F.lds + 50176;
    LAS unsigned char* CB = F.lds + 58368;
    LAS float* gF = (LAS float*)(F.lds + 66560); LAS float* gB = gF + 128; LAS float* cF = gB + 128; LAS float* cB = cF + 128; LAS float* pF = cB + 128; LAS float* pB = pF + 128; LAS float* nF = pB + 128; LAS float* nB = nF + 64;
    const int tid = F.tid;
    float gv[4]; mlstm_gate_load(tid, MG, r0, h, gv);
    __syncthreads();
    { const int sx = tid >> 2, cg = tid & 3; const size_t r = r0 + sx; const int t = 128 * c + sx;
      const bool isk = cg >= 2; const int dbase = 32 * (cg & 1); LAS unsigned char* dst = isk ? Ks : Qs;
#pragma unroll
      for (int q4 = 0; q4 < 4; ++q4) { const int d0 = dbase + 8 * q4; float o[8]; conv_silu8(MQK, WSP(float, WS_EDQ), wcv, r, t, nseq, (isk ? 256 : 0) + h * 64 + d0, isk ? 0.125f : 1.f, o);
          u32x4 w; w.x = cvt_pk_bf16(o[0], o[1]); w.y = cvt_pk_bf16(o[2], o[3]); w.z = cvt_pk_bf16(o[4], o[5]); w.w = cvt_pk_bf16(o[6], o[7]);
          *(LAS u32x4*)(dst + ((sx >> 4) * 2 + (d0 >> 5)) * 1024 + swz16(sx & 15, (d0 & 31) * 2)) = w; }
#pragma unroll
      for (int hh = 0; hh < 2; ++hh) { const int e0 = 16 * cg + 8 * hh; const u32x4 vv = *(const u32x4*)(MV + r * 256 + h * 64 + e0); const unsigned vw[4] = {vv.x, vv.y, vv.z, vv.w};
#pragma unroll
          for (int i = 0; i < 8; ++i) *(LAS bf16_t*)(Vt + (e0 + i) * 272 + sx * 2) = (bf16_t)((i & 1) ? (vw[i >> 1] >> 16) : (vw[i >> 1] & 0xffffu)); }
      { const int e = tid >> 3, dc = tid & 7; const int off = ((e >> 4) * 2 + (dc >> 2)) * 1024 + swz16(e & 15, (dc & 3) * 16);
        *(LAS u32x4*)(CF + off) = *(const u32x4*)(WSP(bf16_t, WS_CT) + ((size_t)chF * 18 + jF) * 4096 + e * 64 + dc * 8);
        *(LAS u32x4*)(CB + off) = *(const u32x4*)(WSP(bf16_t, WS_CT) + ((size_t)chB * 18 + jB) * 4096 + e * 64 + dc * 8); }
      if (tid < 64) nF[tid] = WSP(float, WS_NS)[((size_t)chF * 18 + jF) * 64 + tid]; else if (tid < 128) nB[tid - 64] = WSP(float, WS_NS)[((size_t)chB * 18 + jB) * 64 + tid - 64];
    }
    const float mF = WSP(float, WS_MS)[chF * 18 + jF], mB = WSP(float, WS_MS)[chB * 18 + jB];
    mlstm_gate_scan(tid, gv, bgate, h, gF, gB, cF, cB, pF, pB);
    const int w = F.wave, quad = F.lane >> 4, l15 = F.lane & 15; const int kfo = swz16(l15, quad * 16); const int p = 16 * w + l15;
    u32x2 mo[4];
#pragma unroll
    for (int et = 0; et < 4; ++et) mo[et] = *(const u32x2*)(MO + (r0 + p) * 256 + h * 64 + 16 * et + 4 * quad);
    bf16x8 Qf[2];
#pragma unroll
    for (int sx = 0; sx < 2; ++sx) Qf[sx] = *(const LAS bf16x8*)(Qs + (w * 2 + sx) * 1024 + kfo);
    f32x4 S[8];
#pragma unroll
    for (int st = 0; st < 8; ++st) { S[st] = (f32x4){0.f, 0.f, 0.f, 0.f};
#pragma unroll
        for (int sx = 0; sx < 2; ++sx) { const bf16x8 kf = *(const LAS bf16x8*)(Ks + (st * 2 + sx) * 1024 + kfo); S[st] = __builtin_amdgcn_mfma_f32_16x16x32_bf16(kf, Qf[sx], S[st], 0, 0, 0); } }
    const float MFp = fmaxf(mF, pF[p]), MBp = fmaxf(mB, pB[p]);
    __builtin_amdgcn_sched_barrier(0);
    float sF = 0.f, sB = 0.f;
#pragma unroll
    for (int st = 0; st < 8; ++st) { const f32x4 g4 = *(const LAS f32x4*)(gF + 16 * st + 4 * quad), h4 = *(const LAS f32x4*)(gB + 16 * st + 4 * quad);
#pragma unroll
        for (int i = 0; i < 4; ++i) { const int sx = 16 * st + 4 * quad + i;
            float eF = fexp(g4[i] - MFp), eB = fexp(h4[i] - MBp); eF = sx <= p ? eF : 0.f; eB = sx >= p ? eB : 0.f;
            sF += S[st][i] * eF; sB += S[st][i] * eB; } }
    __builtin_amdgcn_sched_barrier(0);
    sF += __shfl_xor(sF, 16); sF += __shfl_xor(sF, 32); sB += __shfl_xor(sB, 16); sB += __shfl_xor(sB, 32);
    float qnF = 0.f, qnB = 0.f; float qv[2][8];
#pragma unroll
    for (int sx = 0; sx < 2; ++sx) { const u32x4 qw = __builtin_bit_cast(u32x4, Qf[sx]); const unsigned qq[4] = {qw.x, qw.y, qw.z, qw.w};
        const f32x4 nf0 = *(const LAS f32x4*)(nF + 32 * sx + 8 * quad), nf1 = *(const LAS f32x4*)(nF + 32 * sx + 8 * quad + 4), nb0 = *(const LAS f32x4*)(nB + 32 * sx + 8 * quad), nb1 = *(const LAS f32x4*)(nB + 32 * sx + 8 * quad + 4);
#pragma unroll
        for (int i = 0; i < 8; ++i) { const float qf = (i & 1) ? hi_bf(qq[i >> 1]) : lo_bf(qq[i >> 1]); qv[sx][i] = qf; qnF += qf * (i < 4 ? nf0[i & 3] : nf1[i & 3]); qnB += qf * (i < 4 ? nb0[i & 3] : nb1[i & 3]); } }
    qnF += __shfl_xor(qnF, 16); qnF += __shfl_xor(qnF, 32); qnB += __shfl_xor(qnB, 16); qnB += __shfl_xor(qnB, 32);
    const float wiF = fexp(mF - MFp), wiB = fexp(mB - MBp);
    const float rF = frcp(fmaxf(fabsf(sF + wiF * qnF), fexp(-(cF[p] + MFp)))), rB = frcp(fmaxf(fabsf(sB + wiB * qnB), fexp(-(cB[p] + MBp))));
    const float qsF = wiF * rF, qsB = wiB * rB;
    __builtin_amdgcn_sched_barrier(0);
    f32x4 O[4];
#pragma unroll
    for (int et = 0; et < 4; ++et) O[et] = (f32x4){0.f, 0.f, 0.f, 0.f};
#pragma unroll
    for (int sx = 0; sx < 2; ++sx) { u32x4 a, bq;
        a.x = cvt_pk_bf16(qv[sx][0] * qsF, qv[sx][1] * qsF); a.y = cvt_pk_bf16(qv[sx][2] * qsF, qv[sx][3] * qsF); a.z = cvt_pk_bf16(qv[sx][4] * qsF, qv[sx][5] * qsF); a.w = cvt_pk_bf16(qv[sx][6] * qsF, qv[sx][7] * qsF);
        bq.x = cvt_pk_bf16(qv[sx][0] * qsB, qv[sx][1] * qsB); bq.y = cvt_pk_bf16(qv[sx][2] * qsB, qv[sx][3] * qsB); bq.z = cvt_pk_bf16(qv[sx][4] * qsB, qv[sx][5] * qsB); bq.w = cvt_pk_bf16(qv[sx][6] * qsB, qv[sx][7] * qsB);
        const bf16x8 qF8 = __builtin_bit_cast(bf16x8, a), qB8 = __builtin_bit_cast(bf16x8, bq);
#pragma unroll
        for (int et = 0; et < 4; ++et) { const bf16x8 cf = *(const LAS bf16x8*)(CF + (et * 2 + sx) * 1024 + kfo), cb = *(const LAS bf16x8*)(CB + (et * 2 + sx) * 1024 + kfo);
            O[et] = __builtin_amdgcn_mfma_f32_16x16x32_bf16(cf, qF8, O[et], 0, 0, 0); O[et] = __builtin_amdgcn_mfma_f32_16x16x32_bf16(cb, qB8, O[et], 0, 0, 0); } }
    __builtin_amdgcn_sched_barrier(0);
#pragma unroll
    for (int ks = 0; ks < 4; ++ks) { __builtin_amdgcn_sched_barrier(0); u32x4 pw; float pv[8];
#pragma unroll
        for (int hh = 0; hh < 2; ++hh) { const int st = 2 * ks + hh; const f32x4 g4 = *(const LAS f32x4*)(gF + 16 * st + 4 * quad), h4 = *(const LAS f32x4*)(gB + 16 * st + 4 * quad);
#pragma unroll
            for (int i = 0; i < 4; ++i) { const int sx = 16 * st + 4 * quad + i;
                float eF = fexp(g4[i] - MFp) * rF, eB = fexp(h4[i] - MBp) * rB; eF = sx <= p ? eF : 0.f; eB = sx >= p ? eB : 0.f; pv[4 * hh + i] = S[st][i] * (eF + eB); } }
        pw.x = cvt_pk_bf16(pv[0], pv[1]); pw.y = cvt_pk_bf16(pv[2], pv[3]); pw.z = cvt_pk_bf16(pv[4], pv[5]); pw.w = cvt_pk_bf16(pv[6], pv[7]);
        const bf16x8 pf = __builtin_bit_cast(bf16x8, pw);
#pragma unroll
        for (int et = 0; et < 4; ++et) { const LAS unsigned char* vp = Vt + (16 * et + l15) * 272 + ks * 64 + quad * 8; const u32x2 v0 = *(const LAS u32x2*)vp, v1 = *(const LAS u32x2*)(vp + 32);
            const u32x4 vv = (u32x4){v0.x, v0.y, v1.x, v1.y}; O[et] = __builtin_amdgcn_mfma_f32_16x16x32_bf16(__builtin_bit_cast(bf16x8, vv), pf, O[et], 0, 0, 0); } }
    { const size_t r = r0 + p;
#pragma unroll
      for (int et = 0; et < 4; ++et) { const int e = 16 * et + 4 * quad; const u32x2 ow = mo[et];
          f32x4 o; o[0] = lo_bf(ow.x) * O[et][0]; o[1] = hi_bf(ow.x) * O[et][1]; o[2] = lo_bf(ow.y) * O[et][2]; o[3] = hi_bf(ow.y) * O[et][3];
          store4bf(Y + r * 1024 + 256 + h * 64 + e, o); } }
}
__device__ __forceinline__ void phase_mlstm_A(const Frame& F, int l, int rot) { for (int u = rotc(F, rot); u < 64 * 18; u += F.G) mlstm_passA_unit(F, l, u / 72, (u / 18) & 3, u % 18); }
__device__ __forceinline__ void phase_mlstm_B(const Frame& F, int rot) { for (int u = rotc(F, rot); u < 256; u += F.G) mlstm_passB_unit(F, u >> 1, u & 1); }
__device__ __forceinline__ void phase_mlstm_C(const Frame& F, int l, bool ctx_out, int rot) {
    const int per = ctx_out ? 18 : 16, j0 = ctx_out ? 0 : 2;
    for (int u = rotc(F, rot); u < 64 * per; u += F.G) mlstm_passC_unit(F, l, u / (4 * per), (u / per) & 3, j0 + u % per);
}
__device__ __forceinline__ void phase_fold(const Frame& F, int rot) { for (int u = rotc(F, rot); u < 128; u += F.G) fold_unit(F, u >> 3, (u >> 1) & 3, u & 1); }
__device__ __forceinline__ void phase_mla(const Frame& F, bool ctx_out) {
    const int nm = 512 + (ctx_out ? 64 : 0);
    for (int q = F.vcu; q < nm; q += F.G) { const bool cq = q >= 512; const int qq = q - 512;
        mla_unit(F, cq ? qq >> 2 : q >> 5, cq ? qq & 3 : (q >> 3) & 3, cq ? 0 : (q & 7) * 256, cq); }
}
__device__ __forceinline__ void phase_gqa(const Frame& F, int l, bool ctx_out) {
    const int nm = 512 + (ctx_out ? 64 : 0);
    if (F.G == 256) {
        const int v = F.vcu; int q0, qs, nq;
        if (v < 128) { q0 = v; qs = 128; nq = 3; } else { q0 = 384 + (v - 128); qs = 128; nq = (q0 + 128 < nm) ? 2 : 1; }
        for (int i = 0; i < nq; ++i) { const int q = q0 + i * qs; const bool cq = q >= 512; const int qq = q - 512;
            gqa_unit(F, l, cq ? qq >> 2 : q >> 5, cq ? (qq >> 1) & 1 : (q >> 4) & 1, cq ? (qq & 1) * 128 : (q & 15) * 128, cq); }
    } else {
        for (int q = F.vcu; q < nm; q += F.G) { const bool cq = q >= 512; const int qq = q - 512;
            gqa_unit(F, l, cq ? qq >> 2 : q >> 5, cq ? (qq >> 1) & 1 : (q >> 4) & 1, cq ? (qq & 1) * 128 : (q & 15) * 128, cq); }
    }
}

struct Params { const float* in[26]; float* out; unsigned char* ws; int ph_lo, ph_hi, li, pad; };

__global__ void __launch_bounds__(NTHR, 2) mk_fwd(Params P) {
    extern __shared__ __attribute__((aligned(16))) unsigned char lds_raw[];
    volatile LAS unsigned* MISC = (volatile LAS unsigned*)((LAS unsigned char*)lds_raw + MISC_OFF);
    if (threadIdx.x < 64) MISC[threadIdx.x] = 0u;
    __syncthreads();
    XcdBarrier bar = xcd_barrier_post((unsigned*)(P.ws + WS_CTL) + CW_BAR + P.li * XCD_BAR_WORDS, MISC + 8);
    const int lo = P.ph_lo, hi = P.ph_hi; int ph = 0;
#define MAKE_FRAME Frame F; { int t_ = threadIdx.x, b_ = blockIdx.x; asm volatile("" : "+v"(t_)); asm volatile("" : "+s"(b_)); F.lds = (LAS unsigned char*)lds_raw; F.tid = t_; F.lane = t_ & 63; \
        F.wave = __builtin_amdgcn_readfirstlane(t_ >> 6); F.G = gridDim.x; F.vcu = (F.G % 8 == 0) ? (b_ % 8) * (F.G / 8) + b_ / 8 : b_; F.xl = P.out; F.ws = P.ws; }
#ifndef SITE_MASK
#define SITE_MASK 0x1FFFFFF
#endif
#ifndef REP_MASK
#define REP_MASK 0
#endif
#define SITE(k) if (SITE_MASK & (1 << (k))) for (int rep_ = 0; rep_ <= ((REP_MASK >> (k)) & 1); ++rep_)
#define PHASE_BEGIN if (ph >= lo && ph < hi) {
#define PHASE_END   if (ph + 1 < hi) xcd_barrier(bar); } ++ph;

    PHASE_BEGIN SITE(0) { MAKE_FRAME
        mod_gemv(F);
        __syncthreads();
        convert_layer_weights(F, 0, F.vcu, F.G, F.G == 256 ? 1 : 15);
        build_cs2(F, WSP(bf16_t, WS_CS));
        build_cs(F, WSP(bf16_t, WS_CSC), CTX);
        build_tables(F);
    } PHASE_END
    PHASE_BEGIN SITE(1) { MAKE_FRAME
        phase_norm1_in(F);
        if (win8(0)) { __syncthreads();
        quant_rows_i8(F, WSP(float, WS_FTMP), F.ws + WS_W + W_IN + (size_t)2048 * 1024, WSP(float, WS_WSCW) + 2048, 256, F.vcu, F.G); }
    } PHASE_END

    for (int l = 0; l < DEPTH; ++l) {
        const bool ctx_out = l < DEPTH - 1;
        const unsigned char* wl = P.ws + WS_W + (size_t)l * W_LAYER;
        const int mrows = ctx_out ? R : RL;
        const int mtiles = ctx_out ? TR : TL;

        PHASE_BEGIN SITE(2) { MAKE_FRAME
            if (!win8(l)) {
                SchedWin S{ctx_out ? TR : TL, ctx_out ? 0 : TC, 5, F.G, F.vcu, (const char*)WSP(unsigned char, WS_H), (const char*)(wl + W_IN), 2048};
                EpiWin E{F.ws, l};
                pg8::gemm_phase(F.lds, 1024, 1024, 1024, S, E); }
        }
        SITE(24) { MAKE_FRAME
            if (win8(l)) {
                SchedWin S{ctx_out ? TR : TL, ctx_out ? 0 : TC, 5, F.G, F.vcu, (const char*)WSP(unsigned char, WS_H), (const char*)(wl + W_IN), 1024};
                EpiWin E{F.ws, l};
                pg8::gemm_phase<EpiWin, SchedWin, 1>(F.lds, 512, 512, 512, S, E, WSP(float, WS_HS), WSP(float, WS_WSCW) + l * 2560); }
        }
        SITE(21) { MAKE_FRAME
            if (l == 0 && F.G == 256 && F.vcu >= 160) { __syncthreads(); convert_layer_weights(F, 0, F.vcu - 160, 96, 2); }
        } PHASE_END

        PHASE_BEGIN
          SITE(3) { MAKE_FRAME
            { SchedMN S{0, ctx_out ? TR : TL, 2, F.G, rotc(F, 192)  , (const char*)WSP(bf16_t, WS_CQ), (const char*)(wl + W_UQ), (size_t)256 * 256 * 2, (size_t)256 * 256 * 2, 0};
              EpiUq E{F.ws};
              pg8::gemm_phase(F.lds, 256, 256, 256, S, E); }
            { SchedMN S{0, TR, 2, F.G, rotc(F, 160)  , (const char*)WSP(bf16_t, WS_CKV), (const char*)(wl + W_UKV), (size_t)256 * 256 * 2, (size_t)256 * 256 * 2, 0};
              EpiUkv E{F.ws};
              pg8::gemm_phase(F.lds, 256, 256, 256, S, E); }
            if (ctx_out) phase_fab_transpose(F, RL, CTX, NB, WSP(bf16_t, WS_FABT + 32 * MiB));
          }
          SITE(19) { MAKE_FRAME
            phase_fold(F, 64);
          }
          SITE(4) { MAKE_FRAME
            phase_mlstm_A(F, l, 128);
          }
        PHASE_END

        PHASE_BEGIN
          SITE(17) { MAKE_FRAME
            phase_mlstm_B(F, 0);
          }
          SITE(14) { MAKE_FRAME
            __syncthreads();
            SchedDft2 S{F.G, rotc(F, 128), (const char*)WSP(bf16_t, WS_CS), (const char*)WSP(bf16_t, WS_FABT)};
            EpiDft2 E{F.ws};
            pg8::gemm_phase(F.lds, 2048, 2048, 2048, S, E);
          }
          SITE(13) { MAKE_FRAME
            if (ctx_out) { __syncthreads(); SchedDft S{NB, 1, F.G, rotc(F, 192), (const char*)WSP(bf16_t, WS_CSC), (const char*)WSP(bf16_t, WS_FABT + 32 * MiB), (size_t)256 * 512 * 2, (size_t)256 * 512 * 2};
              EpiDft E{F.ws, RL, CTX, 0.0078125f};
              pg8::gemm_phase(F.lds, 512, 512, 512, S, E); }
          }
          SITE(16) { MAKE_FRAME
            __syncthreads();
            phase_gqa(F, l, ctx_out);
          }
        PHASE_END

        PHASE_BEGIN
          SITE(18) { MAKE_FRAME
            phase_mlstm_C(F, l, ctx_out, 128);
          }
          SITE(15) { MAKE_FRAME
            __syncthreads();
            phase_mla(F, ctx_out);
          }
        PHASE_END

        { const int nch = ctx_out ? 3 : 2, cht = ctx_out ? 48 : 64;
          for (int ch = 0; ch < nch; ++ch) {
            PHASE_BEGIN SITE(5) { MAKE_FRAME
                SchedBranch S{ch * cht, cht, F.G, F.vcu, (const char*)WSP(bf16_t, WS_Y), (const char*)(wl + W_B)};
                EpiBranch E{F.ws, ch * cht * 256, cht * 256};
                pg8::gemm_phase(F.lds, 256, 1024, 256, S, E);
            } PHASE_END
            PHASE_BEGIN SITE(6) { MAKE_FRAME
                SchedMN S{ch * cht, cht, 16, F.G, F.vcu, (const char*)(F.ws + (win8(l) ? WS_H : (l == 0 ? WS_H8A : WS_H8B))), (const char*)(wl + W_G), (size_t)256 * 1024, (size_t)256 * 1024, 0};
                EpiGate E{F.ws, inp(19) + (size_t)l * 4 * 1024, ch * cht * 256, cht * 256, WSP(float, WS_HS), WSP(float, WS_WSCG) + l * 4096};
                pg8::gemm_phase<EpiGate, SchedMN, 1>(F.lds, 512, 512, 512, S, E, WSP(float, WS_HS), WSP(float, WS_WSCG) + l * 4096);
            } PHASE_END
          } }

        PHASE_BEGIN SITE(7) { MAKE_FRAME
            SchedMN S{0, mtiles, 4, F.G, F.vcu, (const char*)WSP(bf16_t, WS_ACC), (const char*)(wl + W_OUT), (size_t)256 * 1024 * 2, (size_t)256 * 1024 * 2, 0};
            EpiPlain E{WSP(bf16_t, WS_YO), 1024, 0};
            pg8::gemm_phase(F.lds, 1024, 1024, 1024, S, E);
        }
        SITE(22) { MAKE_FRAME
            if (l == 0 && F.G == 256 && F.vcu >= 64) { __syncthreads(); convert_layer_weights(F, 0, F.vcu - 64, 192, 12); }
        } PHASE_END

        PHASE_BEGIN SITE(8) { MAKE_FRAME
            phase_post(F, l, WSP(bf16_t, WS_YO), mrows, false, l == 0);
        } PHASE_END

        PHASE_BEGIN SITE(9) { MAKE_FRAME
            SchedMN S{0, mtiles, 22, F.G, F.vcu, (const char*)WSP(unsigned char, WS_H2), (const char*)(wl + W_UP), (size_t)256 * 1024, (size_t)256 * 1024, 0};
            EpiUpConv E{F.ws, inp(23) + (size_t)l * 3 * DFF, inp(24) + (size_t)l * DFF};
            pg8::gemm_phase<EpiUpConv, SchedMN, 1>(F.lds, 512, 512, 512, S, E, WSP(float, WS_H2S), WSP(float, WS_WSCU) + l * 5632);
        } PHASE_END
        PHASE_BEGIN SITE(10) { MAKE_FRAME
            phase_conv_fixup(F, l, 0, mtiles);
        } PHASE_END

        PHASE_BEGIN SITE(11) { MAKE_FRAME
            SchedMN S{0, mtiles, 4, F.G, F.vcu, (const char*)WSP(bf16_t, WS_G), (const char*)(wl + W_DOWN), (size_t)256 * 2816 * 2, (size_t)256 * 2816 * 2, 0};
            EpiPlain E{WSP(bf16_t, WS_F), 1024, 0};
            pg8::gemm_phase(F.lds, 2816, 2816, 2816, S, E);
        }
        SITE(20) { MAKE_FRAME
            if (l + 1 < DEPTH && F.G == 256 && F.vcu >= 64) { __syncthreads(); convert_layer_weights(F, l + 1, F.vcu - 64, F.G - 64, 15); }
            else if (l + 1 < DEPTH && F.G != 256) { __syncthreads(); convert_layer_weights(F, l + 1, F.vcu, F.G, 15); }
        } PHASE_END

        PHASE_BEGIN SITE(12) { MAKE_FRAME
            phase_post(F, l, WSP(bf16_t, WS_F), mrows, true, false);
            if (l + 1 < DEPTH && win8(l + 1)) { __syncthreads(); quant_rows_i8(F, WSP(float, WS_FTMP) + (size_t)(l + 1) * 256 * 1024, F.ws + WS_W + (size_t)(l + 1) * W_LAYER + W_IN + (size_t)2048 * 1024, WSP(float, WS_WSCW) + (l + 1) * 2560 + 2048, 256, F.vcu, F.G); }
        } PHASE_END
    }
#undef PHASE_BEGIN
#undef PHASE_END
}

constexpr int N_PHASES = 32;

extern "C" void kernel_launch(void* const* d_in, const int* in_sizes, int n_in, void* d_out, int out_size, void* d_ws, size_t ws_size, hipStream_t stream) {
    static int grid = 0;
    if (grid == 0) {
        if (n_in != 26 || out_size != RL * D || ws_size < WS_END) { fprintf(stderr, "kernel_launch: unexpected problem (n_in %d out %d ws %zu need %zu)\n", n_in, out_size, ws_size, (size_t)WS_END); grid = -1; return; }
        int dev = 0, cus = 0;
        if (hipGetDevice(&dev) != hipSuccess || hipDeviceGetAttribute(&cus, hipDeviceAttributeMultiprocessorCount, dev) != hipSuccess) { grid = -1; return; }
        if (hipFuncSetAttribute((const void*)mk_fwd, hipFuncAttributeMaxDynamicSharedMemorySize, LDS_BYTES) != hipSuccess) { fprintf(stderr, "kernel_launch: hipFuncSetAttribute failed\n"); grid = -1; return; }
        int per_cu = 0;
        if (hipOccupancyMaxActiveBlocksPerMultiprocessor(&per_cu, (const void*)mk_fwd, NTHR, LDS_BYTES) != hipSuccess || per_cu < 1) { fprintf(stderr, "kernel_launch: occupancy query says %d\n", per_cu); (void)hipGetLastError(); grid = -1; return; }
        grid = cus;
    }
    if (grid < 0) return;
    (void)hipMemsetAsync((char*)d_ws + WS_CTL, 0, CTL_BYTES, stream);
    Params p{};
    for (int i = 0; i < 26; ++i) p.in[i] = (const float*)d_in[i];
    p.out = (float*)d_out; p.ws = (unsigned char*)d_ws; p.pad = 0;
#if MK_SINGLE_LAUNCH
    p.ph_lo = 0; p.ph_hi = N_PHASES; p.li = 0;
    hipLaunchKernelGGL(mk_fwd, dim3(grid), dim3(NTHR), LDS_BYTES, stream, p);
#else
    {
        int sites[N_PHASES]; int n = 0; sites[n++] = 0; sites[n++] = 1;
        for (int l = 0; l < DEPTH; ++l) { const bool co = l < DEPTH - 1; const int seq1[4] = {2, 3, 17, 18};
            for (int i = 0; i < 4; ++i) sites[n++] = seq1[i];
            for (int ch = 0; ch < (co ? 3 : 2); ++ch) { sites[n++] = 5; sites[n++] = 6; }
            sites[n++] = 7; sites[n++] = 8; sites[n++] = 9; sites[n++] = 10; sites[n++] = 11; sites[n++] = 12; }
        for (int i = 0; i < N_PHASES; ++i) { p.ph_lo = i; p.ph_hi = i + 1; p.li = i;
            const int reps = ((PROBE_DUP_SITES >> sites[i]) & 1) ? 2 : 1;
            for (int r = 0; r < reps; ++r) hipLaunchKernelGGL(mk_fwd, dim3(grid), dim3(NTHR), LDS_BYTES, stream, p); }
    }
#endif
}
```

```cpp
#include <hip/hip_runtime.h>
#include <cstdio>
#include <cstdint>

#ifndef PROBE_DUP_SITES
#define PROBE_DUP_SITES 0
#endif
#ifndef WIN_I8_MASK
#define WIN_I8_MASK 3
#endif
__host__ __device__ constexpr bool win8(int l) { return ((WIN_I8_MASK >> l) & 1) != 0; }
#ifndef MK_SINGLE_LAUNCH
#define MK_SINGLE_LAUNCH 1
#endif

#define LAS __attribute__((address_space(3)))
#define GAS __attribute__((address_space(1)))
typedef unsigned short bf16_t;
typedef short bf16x8 __attribute__((ext_vector_type(8)));
typedef float f32x4 __attribute__((ext_vector_type(4)));
typedef float f32x2 __attribute__((ext_vector_type(2)));
typedef unsigned u32x4 __attribute__((ext_vector_type(4)));
typedef unsigned u32x2 __attribute__((ext_vector_type(2)));

constexpr int D = 1024, NB = 16, SEQ = 2048, CTX = 256, DEPTH = 2, DFF = 2816;
constexpr int NIN_SRC = 2352, NIN = 2560;
constexpr int RL = NB * SEQ, RC = NB * CTX, R = RL + RC;
constexpr int TL = RL / 256, TC = RC / 256, TR = R / 256;
constexpr float EPS = 1e-6f;
constexpr float LOG2E = 1.4426950408889634f;
constexpr float QS_M = 0.10206207261596575f * LOG2E;
constexpr float QS_G = 0.125f * LOG2E;
constexpr int NTHR = 512;

constexpr size_t MiB = 1u << 20;
constexpr size_t WS_CTL = 0, CTL_BYTES = 2 * MiB;
constexpr size_t WS_MOD = 2 * MiB;
constexpr size_t WS_TAB = 3 * MiB;
constexpr size_t WS_HS = WS_TAB + 128 * 1024, WS_H2S = WS_TAB + 320 * 1024;
constexpr size_t WS_WSCG = WS_TAB + 512 * 1024, WS_WSCU = WS_TAB + 576 * 1024, WS_WSCW = WS_TAB + 640 * 1024;
constexpr size_t WS_XC = 4 * MiB;
constexpr size_t WS_W = 20 * MiB, W_LAYER = 35 * MiB;
constexpr size_t W_IN = 0, W_UQ = 5632 * 1024, W_UKV = W_UQ + 256 * 1024, W_G = 6 * MiB, W_B = 14 * MiB, W_OUT = 16 * MiB, W_UP = 18 * MiB, W_DOWN = 29 * MiB;
constexpr size_t WS_CS = 94 * MiB;
constexpr size_t WS_H8A = WS_W + W_LAYER;
constexpr size_t WS_H8B = WS_W;
constexpr size_t WS_FTMP = 98 * MiB;
constexpr size_t WS_CSC = 106 * MiB;
constexpr size_t WS_H = 107 * MiB;
constexpr size_t WS_H2 = WS_H;
constexpr size_t WS_Y = 179 * MiB;
constexpr size_t WS_SCR = 251 * MiB;
static_assert(WS_H8A + (size_t)R * 1024 <= WS_CS && WS_H8B + (size_t)RL * 1024 <= WS_W + W_LAYER && WS_CS + 4 * MiB <= WS_FTMP && WS_FTMP + 2 * MiB <= WS_CSC && WS_H + (size_t)R * 2048 <= WS_Y, "map");
constexpr size_t WS_CQ = WS_Y, WS_CKV = WS_Y + 18 * MiB, WS_FAB = WS_Y + 36 * MiB;
constexpr size_t WS_SSP = WS_SCR, WS_MQK = WS_SCR + 2 * MiB, WS_MV = WS_SCR + 38 * MiB, WS_MO = WS_SCR + 56 * MiB, WS_MG = WS_SCR + 74 * MiB,
                 WS_GQ = WS_SCR + 77 * MiB, WS_GK = WS_SCR + 95 * MiB, WS_GV = WS_SCR + 104 * MiB, WS_FABT = WS_SCR + 113 * MiB,
                 WS_Q96 = WS_SCR + 149 * MiB, WS_K96 = WS_SCR + 176 * MiB, WS_V = WS_SCR + 203 * MiB, WS_HF = WS_SCR + 221 * MiB,
                 WS_KVL = WS_SCR + 221 * MiB  , WS_CT = WS_SCR + 239 * MiB  ,
                 WS_EDQ = WS_CTL + 768 * 1024  ,
                 WS_NL = WS_SCR + 257 * MiB  , WS_NS = WS_NL + MiB  , WS_SCL = WS_NS + MiB  , WS_MS = WS_SCL + 64 * 1024  ;
constexpr size_t WS_BV = WS_SCR, WS_ACC = WS_SCR + 128 * MiB, WS_YO = WS_SCR;
constexpr size_t WS_G = WS_Y, WS_EDGE = WS_SCR + 128 * MiB  , WS_F = WS_SCR + 140 * MiB;
constexpr size_t WS_END = WS_SCR + 260 * MiB;
static_assert(WS_G + (size_t)R * DFF * 2 <= WS_EDGE, "G vs EDGE");
static_assert(WS_EDGE + (size_t)TR * 22 * 6 * 128 * 4 <= WS_F && WS_F + (size_t)R * 1024 * 2 <= WS_END, "EDGE / F");
static_assert(WS_MS + 128 * 18 * 4 <= WS_END && WS_EDQ + (size_t)TR * 2 * 4 * 256 * 4 <= WS_CTL + CTL_BYTES && (size_t)(1024 + 40 * 3456) * 4 <= WS_EDQ, "mlstm scan buffers / EDQ (barrier words: u32 index 1024 + 3456 per launch region)");

constexpr int CW_BAR = 1024;
constexpr int CW_QUEUE = 190000;
static_assert((size_t)(CW_BAR + 40 * 3456) * 4 <= (size_t)CW_QUEUE * 4 && (size_t)(CW_QUEUE + 64 * 8) * 4 <= 768 * 1024, "queue heads");

constexpr int LDS_BYTES = 160 * 1024;
constexpr int RING_BYTES = 131072;
constexpr int MISC_OFF = LDS_BYTES - 256;

__device__ __forceinline__ float bf2f(bf16_t v) { return __uint_as_float((unsigned)v << 16); }
__device__ __forceinline__ unsigned f2bf(float f) { unsigned u = __float_as_uint(f); return (u + 0x7fffu + ((u >> 16) & 1u)) >> 16; }
__device__ __forceinline__ unsigned pk2(float lo, float hi) { return f2bf(lo) | (f2bf(hi) << 16); }
__device__ __forceinline__ float lo_bf(unsigned w) { return __uint_as_float(w << 16); }
__device__ __forceinline__ float hi_bf(unsigned w) { return __uint_as_float(w & 0xffff0000u); }
__device__ __forceinline__ float fexp2(float x) { return __builtin_amdgcn_exp2f(x); }
__device__ __forceinline__ float fexp(float x) { return __builtin_amdgcn_exp2f(x * LOG2E); }
__device__ __forceinline__ float frcp(float x) { return __builtin_amdgcn_rcpf(x); }
__device__ __forceinline__ float sigmoidf_(float x) { return frcp(1.0f + fexp(-x)); }
__device__ __forceinline__ float siluf_(float x) { return x * frcp(1.0f + fexp(-x)); }
__device__ __forceinline__ unsigned cvt_pk_bf16(float lo, float hi) { unsigned r; asm("v_cvt_pk_bf16_f32 %0, %1, %2" : "=v"(r) : "v"(lo), "v"(hi)); return r; }
__device__ __forceinline__ float wave_sum(float v) {
#pragma unroll
    for (int o = 1; o < 64; o <<= 1) v += __shfl_xor(v, o);
    return v;
}
__device__ __forceinline__ unsigned pack4_i8(float a, float b, float c, float d) {
    const int ia = (int)rintf(a), ib = (int)rintf(b), ic = (int)rintf(c), id = (int)rintf(d);
    return (unsigned)(ia & 0xff) | ((unsigned)(ib & 0xff) << 8) | ((unsigned)(ic & 0xff) << 16) | ((unsigned)(id & 0xff) << 24);
}
__device__ __forceinline__ unsigned pack4_fp8(float a, float b, float c, float d) { int w = 0; w = __builtin_amdgcn_cvt_pk_fp8_f32(a, b, w, false); w = __builtin_amdgcn_cvt_pk_fp8_f32(c, d, w, true); return (unsigned)w; }
__device__ __forceinline__ void store8bf(bf16_t* p, f32x4 a, f32x4 b) { u32x4 w; w.x = cvt_pk_bf16(a[0], a[1]); w.y = cvt_pk_bf16(a[2], a[3]); w.z = cvt_pk_bf16(b[0], b[1]); w.w = cvt_pk_bf16(b[2], b[3]); *(u32x4*)p = w; }
__device__ __forceinline__ void store4bf(bf16_t* p, f32x4 v) { u32x2 w; w.x = cvt_pk_bf16(v[0], v[1]); w.y = cvt_pk_bf16(v[2], v[3]); *(u32x2*)p = w; }

#define XB_TMO      128
#define XB_XCNT(j)  (256  + 64 * (j))
#define XB_XSUB(j)  (1280 + 64 * (j))
#define XB_XGEN(j)  (2304 + 64 * (j))
#define XB_TOP      3328
#define XB_TOPGEN   3392
#define XCD_BAR_WORDS 3456
#define XB_SPIN_CAP (1u << 21)

__device__ __forceinline__ unsigned xb_ld(unsigned* p)              { return __hip_atomic_load(p, __ATOMIC_RELAXED, __HIP_MEMORY_SCOPE_AGENT); }
__device__ __forceinline__ unsigned xb_add(unsigned* p, unsigned v) { return __hip_atomic_fetch_add(p, v, __ATOMIC_RELAXED, __HIP_MEMORY_SCOPE_AGENT); }
__device__ __forceinline__ unsigned xb_xcc_id() { return (unsigned)__builtin_amdgcn_s_getreg((3 << 11) | 20) & 0xFu; }
#define XB_SPIN(cond, bar) do { unsigned _sp = 0; while (cond) { __builtin_amdgcn_s_sleep(1); \
    if ((++_sp & 255u) == 0u) { if (xb_ld(&(bar)[XB_TMO])) break; if (_sp > XB_SPIN_CAP) { atomicAdd(&(bar)[XB_TMO], 1u); break; } } } } while (0)

struct XcdBarrier { unsigned* bar; unsigned x; volatile LAS unsigned* st; };

__device__ __forceinline__ XcdBarrier xcd_barrier_post(unsigned* bar, volatile LAS unsigned* st) {
    XcdBarrier b; b.bar = bar; b.x = xb_xcc_id(); b.st = st;
    if (threadIdx.x == 0) (void)xb_add(&bar[XB_XCNT(b.x)], 1u);
    return b;
}
__device__ __forceinline__ void xcd_barrier_complete(unsigned* bar, unsigned x, unsigned& nloc, unsigned& nx) {
    const unsigned G = gridDim.x * gridDim.y * gridDim.z;
    unsigned sum, cnt, mine, sp = 0u;
    for (;;) {
        sum = 0u; cnt = 0u; mine = 0u;
#pragma unroll
        for (unsigned j = 0; j < 16; ++j) { const unsigned c = xb_ld(&bar[XB_XCNT(j)]); sum += c; cnt += (c > 0u) ? 1u : 0u; mine = (j == x) ? c : mine; }
        if (sum == G) break;
        __builtin_amdgcn_s_sleep(1);
        if ((++sp & 255u) == 0u) { if (xb_ld(&bar[XB_TMO])) break; if (sp > XB_SPIN_CAP) { atomicAdd(&bar[XB_TMO], 1u); break; } }
    }
    nloc = mine > 0u ? mine : 1u; nx = cnt > 0u ? cnt : 1u;
}
__device__ __forceinline__ void xcd_barrier(const XcdBarrier& b) {
    asm volatile("s_waitcnt vmcnt(0)" ::: "memory");
    __syncthreads();
    if (threadIdx.x == 0) {
        unsigned* bar = b.bar;
        __builtin_amdgcn_s_waitcnt(0);
        unsigned nloc = b.st[0], nx = b.st[1];
        if (nloc == 0u) { xcd_barrier_complete(bar, b.x, nloc, nx); b.st[0] = nloc; b.st[1] = nx; }
        const unsigned old = xb_add(&bar[XB_XSUB(b.x)], 1u);
        const unsigned gen = old / nloc;
        if (old + 1u == (gen + 1u) * nloc) {
            __builtin_amdgcn_fence(__ATOMIC_RELEASE, "agent");
            asm volatile("s_waitcnt vmcnt(0)" ::: "memory");
            const unsigned og = xb_add(&bar[XB_TOP], 1u);
            const unsigned tg = og / nx;
            if (og + 1u == (tg + 1u) * nx) xb_add(&bar[XB_TOPGEN], 1u);
            else XB_SPIN(xb_ld(&bar[XB_TOPGEN]) == tg, bar);
            __builtin_amdgcn_fence(__ATOMIC_ACQUIRE, "agent");
            xb_add(&bar[XB_XGEN(b.x)], 1u);
            asm volatile("s_waitcnt vmcnt(0)" ::: "memory");
        } else {
            XB_SPIN(xb_ld(&bar[XB_XGEN(b.x)]) == gen, bar);
            __builtin_amdgcn_fence(__ATOMIC_ACQUIRE, "agent");
            asm volatile("s_waitcnt vmcnt(0)" ::: "memory");
        }
    }
    __syncthreads();
}

namespace pg8 {
constexpr int BM = 256, BK = 64, HALF = 128, HTB = HALF * BK * 2, STAGE_BYTES = 8 * HTB;
__host__ __device__ __forceinline__ int lds_byte(int r, int c) { const int st = (r >> 4) * 2 + (c >> 5), rr = r & 15, cc = c & 31, ob = rr * 64 + cc * 2; return st * 1024 + (ob ^ (((ob >> 9) & 1) << 5)); }
__host__ __device__ __forceinline__ void stage_rc(int b, int& Rr, int& C) { const int st = b / 1024, sb = b % 1024, swz = sb ^ (((sb >> 9) & 1) << 5); Rr = (st >> 1) * 16 + swz / 64; C = (st & 1) * 32 + (swz % 64) / 2; }

struct Unit { int pm, pn; const char* a; const char* b; int srow, scol; };

typedef int v4i32 __attribute__((ext_vector_type(4)));
template <class E> constexpr auto self_scale_of(int) -> decltype(E::SELF_SCALE) { return E::SELF_SCALE; }
template <class E> constexpr bool self_scale_of(long) { return false; }
template <class Epi, class Sched, int MODE = 0>
__device__ __forceinline__ void gemm_phase(LAS unsigned char* lds, const int K, const int lda, const int ldb, const Sched& S, const Epi& E, const float* rowscale = nullptr, const float* colscale = nullptr) {
    int tid = threadIdx.x; asm volatile("" : "+v"(tid));
    const int wid = __builtin_amdgcn_readfirstlane(tid >> 6), lane = tid & 63, wr = wid >> 2, wc = wid & 3, fr = lane & 15, fq = lane >> 4;
    int nt = K / BK; asm volatile("" : "+s"(nt));
    unsigned voffA[2], voffB[2];
#pragma unroll
    for (int i = 0; i < 2; ++i) { int Rr, C; stage_rc(tid * 16 + i * 8192, Rr, C); voffA[i] = (unsigned)(Rr * lda + C) * 2u; voffB[i] = (unsigned)(Rr * ldb + C) * 2u; }
    const size_t kstep = (size_t)(BK * 2);
    const size_t hstepA = (size_t)HALF * lda * 2, hstepB = (size_t)HALF * ldb * 2;
    const unsigned ldsw = (unsigned)wid * 1024u;
    const int aoff = lds_byte(wr * 64 + fr, fq * 8), boff = lds_byte(wc * 32 + fr, fq * 8);
#define PG8_SA(b, h) (((b) * 2 + (h)) * HTB)
#define PG8_SB(b, h) ((4 + (b) * 2 + (h)) * HTB)
#define PG8_STAGE(bufoff, gbase, voff) do { _Pragma("unroll") for (int _i = 0; _i < 2; ++_i) \
        __builtin_amdgcn_global_load_lds((const unsigned*)((const char*)(gbase) + (voff)[_i]), (LAS unsigned*)(lds + (bufoff) + ldsw + _i * 8192), 16, 0, 0); } while (0)
#define PG8_LDA(dst, b, h) do { _Pragma("unroll") for (int m = 0; m < 4; ++m) _Pragma("unroll") for (int k = 0; k < 2; ++k) dst[m][k] = *(const LAS bf16x8*)(lds + PG8_SA(b, h) + aoff + m * 2048 + k * 1024); } while (0)
#define PG8_LDB(dst, b, h) do { _Pragma("unroll") for (int n = 0; n < 2; ++n) _Pragma("unroll") for (int k = 0; k < 2; ++k) dst[n][k] = *(const LAS bf16x8*)(lds + PG8_SB(b, h) + boff + n * 2048 + k * 1024); } while (0)
#define PG8_PRIO1 __builtin_amdgcn_s_setprio(1)
#define PG8_MMA(ai, bj, At, Bt) do { _Pragma("unroll") for (int m = 0; m < 4; ++m) _Pragma("unroll") for (int n = 0; n < 2; ++n) _Pragma("unroll") for (int k = 0; k < 2; ++k) { \
        if constexpr (MODE == 1) acc[ai][bj][m][n] = __builtin_bit_cast(f32x4, __builtin_amdgcn_mfma_i32_16x16x64_i8(__builtin_bit_cast(v4i32, Bt[n][k]), __builtin_bit_cast(v4i32, At[m][k]), __builtin_bit_cast(v4i32, acc[ai][bj][m][n]), 0, 0, 0)); \
        else acc[ai][bj][m][n] = __builtin_amdgcn_mfma_f32_16x16x32_bf16(Bt[n][k], At[m][k], acc[ai][bj][m][n], 0, 0, 0); } \
        } while (0)
#define PG8_PRIO0 __builtin_amdgcn_s_setprio(0)
#define PG8_WAIT_V(n) asm volatile("s_waitcnt vmcnt(" #n ")" ::: "memory")
#define PG8_WAIT_L(n) asm volatile("s_waitcnt lgkmcnt(" #n ")" ::: "memory")
#define PG8_BAR __builtin_amdgcn_s_barrier()
#define PG8_SCHED __builtin_amdgcn_sched_barrier(0)
    Unit cur, nxt; int ui = 0;
    if (!S.next(0, cur)) return;
    f32x4 acc[2][2][4][2];
#pragma unroll
    for (int a = 0; a < 2; ++a)
#pragma unroll
        for (int b = 0; b < 2; ++b)
#pragma unroll
            for (int m = 0; m < 4; ++m)
#pragma unroll
                for (int n = 0; n < 2; ++n) acc[a][b][m][n] = (f32x4){0.f, 0.f, 0.f, 0.f};
    bf16x8 At[4][2], B0[2][2], B1[2][2];
    const char* cA = cur.a; const char* cB = cur.b;
    PG8_STAGE(PG8_SB(0, 0), cB, voffB); PG8_STAGE(PG8_SB(0, 1), cB + hstepB, voffB); PG8_STAGE(PG8_SA(0, 0), cA, voffA); PG8_STAGE(PG8_SA(0, 1), cA + hstepA, voffA);
    if (wr == 1) PG8_BAR;
    PG8_WAIT_V(2); PG8_BAR;
    PG8_STAGE(PG8_SB(1, 0), cB + kstep, voffB); PG8_STAGE(PG8_SA(1, 0), cA + kstep, voffA); PG8_STAGE(PG8_SB(1, 1), cB + hstepB + kstep, voffB);
    PG8_WAIT_V(6); PG8_BAR;
    for (;;) {
        const bool has_next = S.next(ui + 1, nxt);
        const char* nA = has_next ? nxt.a : cA; const char* nB = has_next ? nxt.b : cB;
        for (int t = 0; t < nt; t += 2) {
            const bool last = (t == nt - 2);
            const char* a1 = cA + (size_t)(t + 1) * kstep;
            const char* a2 = last ? nA : cA + (size_t)(t + 2) * kstep; const char* b2 = last ? nB : cB + (size_t)(t + 2) * kstep;
            const char* a3 = a2 + kstep; const char* b3 = b2 + kstep;
            PG8_LDB(B0, 0, 0); PG8_LDB(B1, 0, 1); PG8_SCHED; PG8_LDA(At, 0, 0); PG8_STAGE(PG8_SA(1, 1), a1 + hstepA, voffA);
            PG8_WAIT_V(8); PG8_WAIT_L(0); PG8_PRIO1; PG8_BAR; PG8_MMA(0, 0, At, B0); PG8_MMA(0, 1, At, B1); PG8_PRIO0; PG8_BAR; PG8_SCHED;
            PG8_LDA(At, 0, 1); PG8_STAGE(PG8_SB(0, 0), b2, voffB); PG8_STAGE(PG8_SB(0, 1), b2 + hstepB, voffB); PG8_STAGE(PG8_SA(0, 0), a2, voffA);
            PG8_WAIT_V(8); PG8_WAIT_L(0); PG8_PRIO1; PG8_BAR; PG8_MMA(1, 0, At, B0); PG8_MMA(1, 1, At, B1); PG8_PRIO0; PG8_BAR; PG8_SCHED;
            PG8_LDB(B0, 1, 0); PG8_LDB(B1, 1, 1); PG8_SCHED; PG8_LDA(At, 1, 0); PG8_STAGE(PG8_SA(0, 1), a2 + hstepA, voffA);
            PG8_WAIT_V(8); PG8_WAIT_L(0); PG8_PRIO1; PG8_BAR; PG8_MMA(0, 0, At, B0); PG8_MMA(0, 1, At, B1); PG8_PRIO0; PG8_BAR; PG8_SCHED;
            PG8_LDA(At, 1, 1); PG8_STAGE(PG8_SB(1, 0), b3, voffB); PG8_STAGE(PG8_SB(1, 1), b3 + hstepB, voffB); PG8_STAGE(PG8_SA(1, 0), a3, voffA);
            PG8_WAIT_V(8); PG8_WAIT_L(0); PG8_PRIO1; PG8_BAR; PG8_MMA(1, 0, At, B0); PG8_MMA(1, 1, At, B1); PG8_PRIO0; PG8_BAR; PG8_SCHED;
        }
        if (wr == 0) PG8_BAR;
        { int fr_ = fr, fq_ = fq; asm volatile("" : "+v"(fr_), "+v"(fq_));
          if constexpr (MODE == 1 && !self_scale_of<Epi>(0)) {
              f32x4 cs[2][2];
#pragma unroll
              for (int bj = 0; bj < 2; ++bj)
#pragma unroll
                  for (int n = 0; n < 2; ++n) cs[bj][n] = *(const f32x4*)(colscale + cur.scol + 128 * bj + 32 * wc + 16 * n + 4 * fq_);
#pragma unroll
              for (int ai = 0; ai < 2; ++ai)
#pragma unroll
                  for (int m = 0; m < 4; ++m) { const float rs = rowscale[cur.srow + 128 * ai + 64 * wr + 16 * m + fr_];
#pragma unroll
                      for (int bj = 0; bj < 2; ++bj)
#pragma unroll
                          for (int n = 0; n < 2; ++n) { const v4i32 iv = __builtin_bit_cast(v4i32, acc[ai][bj][m][n]);
                              acc[ai][bj][m][n] = (f32x4){(float)iv[0], (float)iv[1], (float)iv[2], (float)iv[3]} * cs[bj][n] * rs; } }
          }
          E(acc, cur, wr, wc, fr_, fq_, lds); }
        if (!has_next) break;
#pragma unroll
        for (int a = 0; a < 2; ++a)
#pragma unroll
            for (int b = 0; b < 2; ++b)
#pragma unroll
                for (int m = 0; m < 4; ++m)
#pragma unroll
                    for (int n = 0; n < 2; ++n) acc[a][b][m][n] = (f32x4){0.f, 0.f, 0.f, 0.f};
        cur = nxt; cA = nA; cB = nB; ++ui;
        if (wr == 1) PG8_BAR;
    }
    PG8_WAIT_V(0);
    PG8_BAR;
#undef PG8_SA
#undef PG8_SB
#undef PG8_STAGE
#undef PG8_LDA
#undef PG8_LDB
#undef PG8_MMA
#undef PG8_WAIT_V
#undef PG8_WAIT_L
#undef PG8_BAR
#undef PG8_SCHED
}
}
using pg8::Unit;

struct Frame {
    LAS unsigned char* lds;
    int tid, lane, wave, vcu, G;
    float* xl;
    unsigned char* ws;
};
typedef const char __attribute__((address_space(4)))* kaptr_t;
__device__ __forceinline__ const float* inp(int i) {
    kaptr_t ka = (kaptr_t)__builtin_amdgcn_kernarg_segment_ptr();
    asm volatile("" : "+s"(i));
    return *(const float* const __attribute__((address_space(4)))*)(ka + 8 * i);
}
#define WSP(T, off) ((T*)(F.ws + (off)))
__device__ __forceinline__ int rotc(const Frame& F, int rot) { return (F.vcu + rot) % F.G; }

__device__ __forceinline__ const float* xrow_ptr(const Frame& F, int r) { return r < RL ? F.xl + (size_t)r * D : WSP(float, WS_XC) + (size_t)(r - RL) * D; }
__device__ __forceinline__ int modrow_of(int r) { return r < RL ? (r >> 11) : 16; }

struct SchedMN {
    int m_lo, nM, nN, G, c; const char* A; const char* B; size_t a_tile, b_tile; int a_row0;
    __device__ __forceinline__ bool next(int i, Unit& u) const {
        const long L = (long)i * G + c; if (L >= (long)nM * nN) return false;
        const int band = (int)(L / (4 * nN)), rem = (int)(L % (4 * nN)); const int pm = band * 4 + (rem & 3), pn = rem >> 2;
        u.pm = m_lo + pm; u.pn = pn; u.a = A + (size_t)(m_lo + pm - a_row0) * a_tile; u.b = B + (size_t)pn * b_tile; u.srow = (m_lo + pm) * 256; u.scol = pn * 256; return true;
    }
};
struct SchedWin {
    int nfull, nrest, nsel, G, c; const char* A; const char* B; size_t rowb;
    __device__ __forceinline__ bool next(int i, Unit& u) const {
        const long L = (long)i * G + c; const long n0 = (long)nfull * 10; if (L >= n0 + (long)nrest * nsel) return false;
        int pm, pn;
        if (L < n0) { const int band = (int)(L / 40), rem = (int)(L % 40); pm = band * 4 + (rem & 3); pn = rem >> 2; }
        else { const int q = (int)(L - n0); pm = nfull + (q & 15); const int k = q >> 4; pn = k == 0 ? 1 : (k == 1 ? 3 : (k == 2 ? 4 : (k == 3 ? 7 : 9))); }
        u.pm = pm; u.pn = pn; u.a = A + (size_t)pm * 256 * rowb; u.b = B + (size_t)pn * 256 * rowb; u.srow = pm * 256; u.scol = pn * 256; return true;
    }
};
struct SchedBranch {
    int m_lo, nM, G, c; const char* Y; const char* Wb;
    __device__ __forceinline__ bool next(int i, Unit& u) const {
        const long L = (long)i * G + c; if (L >= (long)nM * 16) return false;
        const int pm = (int)(L / 16), q = (int)(L % 16), s = q >> 2, pn = q & 3;
        u.pm = m_lo + pm; u.pn = q; u.a = Y + ((size_t)(m_lo + pm) * 256 * 1024 + 256 * s) * 2; u.b = Wb + ((size_t)(s * 1024 + pn * 256) * 256) * 2; return true;
    }
};
struct SchedDft {
    int nb, nMb, G, c; const char* CS; const char* FT; size_t cs_tile, ft_b;
    __device__ __forceinline__ bool next(int i, Unit& u) const {
        const long L = (long)i * G + c; if (L >= (long)nb * nMb) return false;
        const int b = (int)(L / nMb), pm = (int)(L % nMb);
        u.pm = pm; u.pn = b; u.a = CS + (size_t)pm * cs_tile; u.b = FT + (size_t)b * ft_b; return true;
    }
};

typedef f32x4 Acc[2][2][4][2];
#define EPI_LOOP_AM for (int ai = 0; ai < 2; ++ai) _Pragma("unroll") for (int m = 0; m < 4; ++m)
#define EPI_LOOP_BN for (int bj = 0; bj < 2; ++bj) _Pragma("unroll") for (int n = 0; n < 2; ++n)

__device__ __forceinline__ float dpp_from_prev(float x) { return __int_as_float(__builtin_amdgcn_update_dpp(0, __float_as_int(x), 0x121, 0xF, 0xF, true)); }
__device__ __forceinline__ float dpp_from_next(float x) { return __int_as_float(__builtin_amdgcn_update_dpp(0, __float_as_int(x), 0x12F, 0xF, 0xF, true)); }
#define EW(T, off) ((T*)(ws + (off)))
struct EpiWin {
    unsigned char* ws; int layer;
    __device__ __forceinline__ void operator()(const Acc& acc, const Unit& u, int wr, int wc, int fr, int fq, LAS unsigned char* lds) const {
        bf16_t* const CQ = EW(bf16_t, WS_CQ); bf16_t* const CKV = EW(bf16_t, WS_CKV); bf16_t* const MQK = EW(bf16_t, WS_MQK); bf16_t* const MV = EW(bf16_t, WS_MV); bf16_t* const MO = EW(bf16_t, WS_MO);
        bf16_t* const GQ = EW(bf16_t, WS_GQ); bf16_t* const GK = EW(bf16_t, WS_GK); bf16_t* const GV = EW(bf16_t, WS_GV); bf16_t* const FAB = EW(bf16_t, WS_FAB); bf16_t* const K96 = EW(bf16_t, WS_K96);
        float* const SSP = EW(float, WS_SSP); float* const MG = EW(float, WS_MG); const float* const ropeG = EW(float, WS_TAB); const float* const ropeM = EW(float, WS_TAB + 8192);
        asm volatile("" : "+v"(fq), "+v"(fr));
        const int t = u.pn, rb = u.pm * 256 + wr * 64 + fr; const bool lat = u.pm < TL;
        const int cw = 32 * wc + 4 * fq;
        if (t <= 1) {
            bf16_t* dst = t == 0 ? CQ : CKV; float* ss = SSP + (size_t)t * R * 4;
#pragma unroll
            EPI_LOOP_AM { const int r = rb + ai * 128 + m * 16; float sq = 0.f;
#pragma unroll
                for (int bj = 0; bj < 2; ++bj) { const f32x4 v = acc[ai][bj][m][0], v2 = acc[ai][bj][m][1]; sq += ((v[0] * v[0] + v[1] * v[1]) + (v[2] * v[2] + v[3] * v[3])) + ((v2[0] * v2[0] + v2[1] * v2[1]) + (v2[2] * v2[2] + v2[3] * v2[3]));
                    store8bf(dst + (size_t)r * 256 + 128 * bj + 32 * wc + 8 * fq, v, v2); }
                sq += __shfl_xor(sq, 16); sq += __shfl_xor(sq, 32);
                if (fq == 0) ss[(size_t)r * 4 + wc] = sq; }
        } else if (t <= 3) {
            asm volatile("" : "+v"(fq), "+v"(fr));
            LAS float* XF = (LAS float*)(lds + RING_BYTES);
            LAS float* XL = XF + 1024;
            const float scl = t == 3 ? 0.125f : 1.f; const int c0 = 32 * wc + 8 * fq; const int rb = u.pm * 256 + wr * 64 + fr;
            float* const EDQ = EW(float, WS_EDQ) + (size_t)(u.pm * 2 + (t - 2)) * 4 * 256;
#pragma unroll
            for (int ai = 0; ai < 2; ++ai) { const int k = 2 * ai + wr;
#pragma unroll
                EPI_LOOP_BN {
                    if (fr == 0) *(LAS f32x4*)(XF + ((k * 4 + wc) * 2 + bj) * 32 + 16 * n + 4 * fq) = acc[ai][bj][0][n];
                    if (fr == 15) *(LAS f32x4*)(XL + ((k * 4 + wc) * 2 + bj) * 32 + 16 * n + 4 * fq) = acc[ai][bj][3][n]; } }
            if (wr == 0 && fr < 2) {
#pragma unroll
                EPI_LOOP_BN { *(f32x4*)(EDQ + (size_t)fr * 256 + 128 * bj + c0 + 4 * n) = acc[0][bj][0][n]; } }
            if (wr == 1 && fr >= 14) {
#pragma unroll
                EPI_LOOP_BN { *(f32x4*)(EDQ + (size_t)(fr - 12) * 256 + 128 * bj + c0 + 4 * n) = acc[1][bj][3][n]; } }
            asm volatile("s_waitcnt lgkmcnt(0)" ::: "memory"); __builtin_amdgcn_s_barrier(); asm volatile("" ::: "memory");
            const float* const wcv = inp(15) + (size_t)layer * 3 * 512 + (t - 2) * 256;
#pragma unroll
            for (int bj = 0; bj < 2; ++bj) {
#pragma unroll
                for (int n = 0; n < 2; ++n) { const int ch = 128 * bj + c0 + 4 * n;
                    const f32x4 w0 = *(const f32x4*)(wcv + ch), w1 = *(const f32x4*)(wcv + 512 + ch), w2 = *(const f32x4*)(wcv + 1024 + ch);
                    const f32x4 zz = (f32x4){0.f, 0.f, 0.f, 0.f}; const f32x4 w0a = fr > 0 ? w0 : zz, w0b = fr > 0 ? zz : w0, w2a = fr < 15 ? w2 : zz, w2b = fr < 15 ? zz : w2;
#pragma unroll
                    for (int ai = 0; ai < 2; ++ai) { const int k = 2 * ai + wr;
                        f32x4 hp = (f32x4){0.f, 0.f, 0.f, 0.f}, hn = hp;
                        if (k > 0) hp = *(const LAS f32x4*)(XL + (((k - 1) * 4 + wc) * 2 + bj) * 32 + 16 * n + 4 * fq);
                        if (k < 3) hn = *(const LAS f32x4*)(XF + (((k + 1) * 4 + wc) * 2 + bj) * 32 + 16 * n + 4 * fq);
                        f32x4 pprev = hp, ncur;
#pragma unroll
                        for (int j = 0; j < 4; ++j) ncur[j] = dpp_from_next(acc[ai][bj][0][n][j]);
#pragma unroll
                        for (int m = 0; m < 4; ++m) { f32x4 o, pcur, nnext = hn;
#pragma unroll
                            for (int j = 0; j < 4; ++j) { pcur[j] = dpp_from_prev(acc[ai][bj][m][n][j]); if (m < 3) nnext[j] = dpp_from_next(acc[ai][bj][m < 3 ? m + 1 : 3][n][j]); }
#pragma unroll
                            for (int j = 0; j < 4; ++j) o[j] = siluf_(w1[j] * acc[ai][bj][m][n][j] + w0a[j] * pcur[j] + w0b[j] * pprev[j] + w2a[j] * ncur[j] + w2b[j] * nnext[j]) * scl;
                            store4bf(MQK + (size_t)(rb + ai * 128 + m * 16) * 512 + (t - 2) * 256 + 128 * bj + c0 + 4 * n, o);
                            pprev = pcur; ncur = nnext; }
                        __builtin_amdgcn_sched_barrier(0); } } }
            asm volatile("s_waitcnt lgkmcnt(0)" ::: "memory"); __builtin_amdgcn_s_barrier(); asm volatile("" ::: "memory");
        } else if (t <= 5) {
            bf16_t* dst = t == 4 ? MV : MO; const int ld = 256;
#pragma unroll
            EPI_LOOP_AM { const int r = rb + ai * 128 + m * 16;
#pragma unroll
                for (int bj = 0; bj < 2; ++bj) { f32x4 v = acc[ai][bj][m][0], v2 = acc[ai][bj][m][1];
                    if (t == 5) { v[0] = sigmoidf_(v[0]); v[1] = sigmoidf_(v[1]); v[2] = sigmoidf_(v[2]); v[3] = sigmoidf_(v[3]); v2[0] = sigmoidf_(v2[0]); v2[1] = sigmoidf_(v2[1]); v2[2] = sigmoidf_(v2[2]); v2[3] = sigmoidf_(v2[3]); }
                    store8bf(dst + (size_t)r * ld + 128 * bj + 32 * wc + 8 * fq, v, v2); } }
        } else if (t == 6 || t == 7) {
#pragma unroll
            EPI_LOOP_AM { const int r = rb + ai * 128 + m * 16; const int tok = r & 2047; const int pos = (wc & 1) ? (tok & 63) : (tok >> 6);
                f32x4 cs0 = (f32x4){1.f, 0.f, 1.f, 0.f}, cs1 = cs0;
                if (lat) { const f32x4* tp = (const f32x4*)(ropeG + (size_t)(pos * 16 + 4 * fq) * 2); cs0 = tp[0]; cs1 = tp[1]; }
#pragma unroll
                for (int bj = 0; bj < 2; ++bj) {
                    f32x4 x1 = acc[ai][bj][m][0], x2 = acc[ai][bj][m][1];
                    if (t == 6 || bj == 0) {
                        f32x4 o1, o2;
                        o1[0] = x1[0] * cs0[0] - x2[0] * cs0[1]; o2[0] = x1[0] * cs0[1] + x2[0] * cs0[0];
                        o1[1] = x1[1] * cs0[2] - x2[1] * cs0[3]; o2[1] = x1[1] * cs0[3] + x2[1] * cs0[2];
                        o1[2] = x1[2] * cs1[0] - x2[2] * cs1[1]; o2[2] = x1[2] * cs1[1] + x2[2] * cs1[0];
                        o1[3] = x1[3] * cs1[2] - x2[3] * cs1[3]; o2[3] = x1[3] * cs1[3] + x2[3] * cs1[2];
                        x1 = o1; x2 = o2;
                    }
                    if (t == 6) { x1 = x1 * QS_G; x2 = x2 * QS_G; store4bf(GQ + (size_t)r * 256 + 128 * bj + cw, x1); store4bf(GQ + (size_t)r * 256 + 128 * bj + cw + 16, x2); }
                    else if (bj == 0) { store4bf(GK + (size_t)r * 128 + cw, x1); store4bf(GK + (size_t)r * 128 + cw + 16, x2); }
                    else { const int bb = r < RL ? (r >> 11) : ((r - RL) >> 8), key = r < RL ? 256 + (r & 2047) : ((r - RL) & 255);
                        bf16_t* dst = GV + ((size_t)((bb * 2 + (wc >> 1)) * 64 + 32 * (wc & 1) + 4 * fq)) * 2304 + key;
#pragma unroll
                        for (int j = 0; j < 4; ++j) { dst[(size_t)j * 2304] = (bf16_t)f2bf(x1[j]); dst[(size_t)(16 + j) * 2304] = (bf16_t)f2bf(x2[j]); } }
                } }
        } else if (t == 8) {
#pragma unroll
            EPI_LOOP_AM { const int r = rb + ai * 128 + m * 16;
#pragma unroll
                for (int bj = 0; bj < 2; ++bj) store8bf(FAB + (size_t)r * 256 + 128 * bj + 32 * wc + 8 * fq, acc[ai][bj][m][0], acc[ai][bj][m][1]); }
        } else {
            if (wc == 0) {
#pragma unroll
                EPI_LOOP_AM { const int r = rb + ai * 128 + m * 16; const int tok = r & 2047; const int pos = (fq >= 2) ? (tok & 63) : (tok >> 6);
                    f32x4 cs0 = (f32x4){1.f, 0.f, 1.f, 0.f}, cs1 = cs0;
                    if (lat) { const f32x4* tp = (const f32x4*)(ropeM + (size_t)(pos * 8 + 4 * (fq & 1)) * 2); cs0 = tp[0]; cs1 = tp[1]; }
                    const f32x4 x1 = acc[ai][0][m][0], x2 = acc[ai][0][m][1]; f32x4 o1, o2;
                    o1[0] = x1[0] * cs0[0] - x2[0] * cs0[1]; o2[0] = x1[0] * cs0[1] + x2[0] * cs0[0];
                    o1[1] = x1[1] * cs0[2] - x2[1] * cs0[3]; o2[1] = x1[1] * cs0[3] + x2[1] * cs0[2];
                    o1[2] = x1[2] * cs1[0] - x2[2] * cs1[1]; o2[2] = x1[2] * cs1[1] + x2[2] * cs1[0];
                    o1[3] = x1[3] * cs1[2] - x2[3] * cs1[3]; o2[3] = x1[3] * cs1[3] + x2[3] * cs1[2];
#pragma unroll
                    for (int h = 0; h < 4; ++h) { store4bf(K96 + (size_t)r * 384 + h * 96 + 64 + 4 * fq, o1); store4bf(K96 + (size_t)r * 384 + h * 96 + 80 + 4 * fq, o2); } }
            } else if (wc == 1) {
#pragma unroll
                EPI_LOOP_AM { const int r = rb + ai * 128 + m * 16; *(f32x4*)(MG + (size_t)r * 16 + 4 * fq) = acc[ai][0][m][0]; }
            }
        }
    }
};

struct EpiUq {
    unsigned char* ws;
    __device__ __forceinline__ void operator()(const Acc& acc, const Unit& u, int wr, int wc, int fr, int fq, LAS unsigned char* lds) const {
        if (wc == 3) return;
        bf16_t* const Q96 = EW(bf16_t, WS_Q96); const float* const SSP = EW(float, WS_SSP); const float* const ropeM = EW(float, WS_TAB + 8192);
        const int rb = u.pm * 256 + wr * 64 + fr; const bool lat = u.pm < TL;
#pragma unroll
        EPI_LOOP_AM { const int r = rb + ai * 128 + m * 16; const f32x4 s4 = *(const f32x4*)(SSP + (size_t)r * 4);
            const float sc = rsqrtf(((s4[0] + s4[1]) + (s4[2] + s4[3])) * (1.f / 256.f) + EPS) * QS_M;
            const int tok = r & 2047; const int pos = (fq >= 2) ? (tok & 63) : (tok >> 6);
            f32x4 cs0 = (f32x4){1.f, 0.f, 1.f, 0.f}, cs1 = cs0;
            if (lat && wc == 2) { const f32x4* tp = (const f32x4*)(ropeM + (size_t)(pos * 8 + 4 * (fq & 1)) * 2); cs0 = tp[0]; cs1 = tp[1]; }
#pragma unroll
            for (int bj = 0; bj < 2; ++bj) { const int hh = 2 * u.pn + bj; bf16_t* dst = Q96 + (size_t)r * 384 + hh * 96 + 32 * wc + 4 * fq;
                f32x4 x1 = acc[ai][bj][m][0] * sc, x2 = acc[ai][bj][m][1] * sc;
                if (wc == 2) { f32x4 o1, o2;
                    o1[0] = x1[0] * cs0[0] - x2[0] * cs0[1]; o2[0] = x1[0] * cs0[1] + x2[0] * cs0[0];
                    o1[1] = x1[1] * cs0[2] - x2[1] * cs0[3]; o2[1] = x1[1] * cs0[3] + x2[1] * cs0[2];
                    o1[2] = x1[2] * cs1[0] - x2[2] * cs1[1]; o2[2] = x1[2] * cs1[1] + x2[2] * cs1[0];
                    o1[3] = x1[3] * cs1[2] - x2[3] * cs1[3]; o2[3] = x1[3] * cs1[3] + x2[3] * cs1[2];
                    x1 = o1; x2 = o2; }
                store4bf(dst, x1); store4bf(dst + 16, x2); } }
    }
};
struct EpiUkv {
    unsigned char* ws;
    __device__ __forceinline__ void operator()(const Acc& acc, const Unit& u, int wr, int wc, int fr, int fq, LAS unsigned char* lds) const {
        bf16_t* const K96 = EW(bf16_t, WS_K96); bf16_t* const V = EW(bf16_t, WS_V); const float* const SSP = EW(float, WS_SSP) + (size_t)R * 4;
        const int rb = u.pm * 256 + wr * 64 + fr;
#pragma unroll
        EPI_LOOP_AM { const int r = rb + ai * 128 + m * 16; const f32x4 s4 = *(const f32x4*)(SSP + (size_t)r * 4);
            const float sc = rsqrtf(((s4[0] + s4[1]) + (s4[2] + s4[3])) * (1.f / 256.f) + EPS);
            const int bb = r < RL ? (r >> 11) : ((r - RL) >> 8), key = r < RL ? 256 + (r & 2047) : ((r - RL) & 255);
#pragma unroll
            for (int bj = 0; bj < 2; ++bj) { const int hh = 2 * u.pn + bj;
                if (wc < 2) { bf16_t* dst = K96 + (size_t)r * 384 + hh * 96 + 32 * wc + 4 * fq; store4bf(dst, acc[ai][bj][m][0] * sc); store4bf(dst + 16, acc[ai][bj][m][1] * sc); }
                else { bf16_t* dst = V + ((size_t)((bb * 4 + hh) * 64 + 32 * (wc - 2) + 4 * fq)) * 2304 + key;
#pragma unroll
                    for (int n = 0; n < 2; ++n)
#pragma unroll
                        for (int j = 0; j < 4; ++j) dst[(size_t)(16 * n + j) * 2304] = (bf16_t)f2bf(acc[ai][bj][m][n][j] * sc); } } }
    }
};
struct EpiDft {
    unsigned char* ws; int row0, nseq; float scale;
    __device__ __forceinline__ void operator()(const Acc& acc, const Unit& u, int wr, int wc, int fr, int fq, LAS unsigned char* lds) const {
        bf16_t* const Y = EW(bf16_t, WS_Y);
        const int rb = row0 + u.pn * nseq + u.pm * 256 + wr * 64 + fr;
#pragma unroll
        EPI_LOOP_AM { const int r = rb + ai * 128 + m * 16;
#pragma unroll
            EPI_LOOP_BN { store4bf(Y + (size_t)r * 1024 + 768 + 128 * bj + 32 * wc + 16 * n + 4 * fq, acc[ai][bj][m][n] * scale); } }
    }
};
struct EpiBranch {
    unsigned char* ws; int r0, crows;
    __device__ __forceinline__ void operator()(const Acc& acc, const Unit& u, int wr, int wc, int fr, int fq, LAS unsigned char* lds) const {
        const int s = u.pn >> 2, pn = u.pn & 3; const int rb = u.pm * 256 + wr * 64 + fr - r0;
        bf16_t* const base = EW(bf16_t, WS_BV) + ((size_t)s * crows + rb) * 1024 + 256 * pn + 32 * wc + 8 * fq;
#pragma unroll
        EPI_LOOP_AM {
#pragma unroll
            for (int bj = 0; bj < 2; ++bj) store8bf(base + (size_t)(ai * 128 + m * 16) * 1024 + 128 * bj, acc[ai][bj][m][0], acc[ai][bj][m][1]); }
    }
};
struct EpiGate {
    static constexpr bool SELF_SCALE = true;
    unsigned char* ws; const float* bg; int r0, crows; const float* rowscale; const float* colscale;
    __device__ __forceinline__ void operator()(const Acc& acc, const Unit& u, int wr, int wc, int fr, int fq, LAS unsigned char* lds) const {
        asm volatile("" : "+v"(fq), "+v"(fr));
        bf16_t* const ACCo = EW(bf16_t, WS_ACC);
        const int d0 = 64 * u.pn + 16 * wc + 4 * fq; const int rb = u.pm * 256 + wr * 64 + fr;
        const bf16_t* const bvp = EW(bf16_t, WS_BV) + (size_t)(rb - r0) * 1024 + d0; const size_t plane = (size_t)crows * 1024;
        const float* const rsp = rowscale + rb;
        u32x2 w[3][4]; float rs[3];
        f32x4 kc[4], bz[4];
#pragma unroll
        for (int s = 0; s < 4; ++s) { asm volatile("global_load_dwordx4 %0, %1, off" : "=v"(kc[s]) : "v"(colscale + u.scol + 128 * (s >> 1) + 32 * wc + 16 * (s & 1) + 4 * fq) : "memory");
            asm volatile("global_load_dwordx4 %0, %1, off" : "=v"(bz[s]) : "v"(bg + s * 1024 + d0) : "memory"); }
#define GATE_FETCH(q_) do { const int q = (q_), ro = (q >> 2) * 128 + (q & 3) * 16; \
            asm volatile("global_load_dword %0, %1, off" : "=v"(rs[q % 3]) : "v"(rsp + ro) : "memory"); \
            _Pragma("unroll") for (int s = 0; s < 4; ++s) asm volatile("global_load_dwordx2 %0, %1, off" : "=v"(w[q % 3][s]) : "v"(bvp + (size_t)ro * 1024 + s * plane) : "memory"); } while (0)
#define GATE_WAIT(n_, q_) asm volatile("s_waitcnt vmcnt(" #n_ ")" : "+v"(rs[(q_) % 3]), "+v"(w[(q_) % 3][0]), "+v"(w[(q_) % 3][1]), "+v"(w[(q_) % 3][2]), "+v"(w[(q_) % 3][3]) :: "memory")
        GATE_FETCH(0); GATE_FETCH(1);
#pragma unroll
        for (int p = 0; p < 8; ++p) { const int ai = p >> 2, m = p & 3;
            if (p + 2 < 8) GATE_FETCH(p + 2);
            if (p == 0) { GATE_WAIT(10, 0);
                asm volatile("" : "+v"(kc[0]), "+v"(kc[1]), "+v"(kc[2]), "+v"(kc[3]), "+v"(bz[0]), "+v"(bz[1]), "+v"(bz[2]), "+v"(bz[3]));
#pragma unroll
                for (int s = 0; s < 4; ++s) { kc[s] = kc[s] * (-LOG2E); bz[s] = bz[s] * (-LOG2E); } }
            else if (p == 1) GATE_WAIT(11, 1); else if (p == 2) GATE_WAIT(12, 2); else if (p == 3) GATE_WAIT(12, 3); else if (p == 4) GATE_WAIT(12, 4); else if (p == 5) GATE_WAIT(12, 5);
            else if (p == 6) GATE_WAIT(7, 6); else GATE_WAIT(2, 7);
            f32x4 o;
#pragma unroll
            for (int s = 0; s < 4; ++s) { const pg8::v4i32 iv = __builtin_bit_cast(pg8::v4i32, acc[ai][s >> 1][m][s & 1]);
                const u32x2 ww = w[p % 3][s]; const f32x4 bv = (f32x4){lo_bf(ww.x), hi_bf(ww.x), lo_bf(ww.y), hi_bf(ww.y)};
#pragma unroll
                for (int j = 0; j < 4; ++j) { const float sg = frcp(1.0f + fexp2(fmaf((float)iv[j] * rs[p % 3], kc[s][j], bz[s][j]))); o[j] = s == 0 ? sg * bv[j] : fmaf(sg, bv[j], o[j]); } }
            { u32x2 ow; ow.x = cvt_pk_bf16(o[0], o[1]); ow.y = cvt_pk_bf16(o[2], o[3]);
              asm volatile("global_store_dwordx2 %0, %1, off" :: "v"(ACCo + (size_t)(rb + ai * 128 + m * 16) * 1024 + d0), "v"(ow) : "memory"); } }
#undef GATE_FETCH
#undef GATE_WAIT
    }
};
struct EpiPlain {
    bf16_t* O; int ldc; int r0;
    __device__ __forceinline__ void operator()(const Acc& acc, const Unit& u, int wr, int wc, int fr, int fq, LAS unsigned char* lds) const {
        const int rb = u.pm * 256 + wr * 64 + fr - r0;
#pragma unroll
        EPI_LOOP_AM { const int r = rb + ai * 128 + m * 16;
#pragma unroll
            for (int bj = 0; bj < 2; ++bj) store8bf(O + (size_t)r * ldc + 256 * u.pn + 128 * bj + 32 * wc + 8 * fq, acc[ai][bj][m][0], acc[ai][bj][m][1]); }
    }
};

struct EpiUpConv {
    unsigned char* ws; const float* wconv; const float* bconv;
    __device__ __forceinline__ void operator()(const Acc& acc, const Unit& u, int wr, int wc, int fr, int fq, LAS unsigned char* lds) const {
        LAS float* XF = (LAS float*)(lds + RING_BYTES);
        LAS float* XL = XF + 512;
        const int c0 = 32 * wc + 8 * fq;
        const int f0 = 128 * u.pn + c0;
        bf16_t* const G = EW(bf16_t, WS_G); float* const EDGE = EW(float, WS_EDGE) + (size_t)(u.pm * 22 + u.pn) * 6 * 128;
#pragma unroll
        for (int ai = 0; ai < 2; ++ai) { const int k = 2 * ai + wr;
#pragma unroll
            for (int n = 0; n < 2; ++n) {
                if (fr == 0) *(LAS f32x4*)(XF + (k * 4 + wc) * 32 + 16 * n + 4 * fq) = acc[ai][0][0][n];
                if (fr == 15) *(LAS f32x4*)(XL + (k * 4 + wc) * 32 + 16 * n + 4 * fq) = acc[ai][0][3][n]; } }
        if (wr == 0 && fr < 2) {
#pragma unroll
            for (int n = 0; n < 2; ++n) { *(f32x4*)(EDGE + (size_t)fr * 128 + c0 + 4 * n) = acc[0][0][0][n]; if (fr == 0) *(f32x4*)(EDGE + 4 * 128 + c0 + 4 * n) = acc[0][1][0][n]; } }
        if (wr == 1 && fr >= 14) {
#pragma unroll
            for (int n = 0; n < 2; ++n) { *(f32x4*)(EDGE + (size_t)(fr - 12) * 128 + c0 + 4 * n) = acc[1][0][3][n]; if (fr == 15) *(f32x4*)(EDGE + 5 * 128 + c0 + 4 * n) = acc[1][1][3][n]; } }
        asm volatile("s_waitcnt lgkmcnt(0)" ::: "memory"); __builtin_amdgcn_s_barrier(); asm volatile("" ::: "memory");
        u32x2 stash[2][4];
#pragma unroll
        for (int n = 0; n < 2; ++n) {
            const f32x4 w0 = *(const f32x4*)(wconv + f0 + 4 * n), w1 = *(const f32x4*)(wconv + DFF + f0 + 4 * n), w2 = *(const f32x4*)(wconv + 2 * DFF + f0 + 4 * n), bb = *(const f32x4*)(bconv + f0 + 4 * n);
            const f32x4 zz = (f32x4){0.f, 0.f, 0.f, 0.f}; const f32x4 w0a = fr > 0 ? w0 : zz, w0b = fr > 0 ? zz : w0, w2a = fr < 15 ? w2 : zz, w2b = fr < 15 ? zz : w2;
#pragma unroll
            for (int ai = 0; ai < 2; ++ai) { const int k = 2 * ai + wr;
                f32x4 hp = (f32x4){0.f, 0.f, 0.f, 0.f}, hn = hp;
                if (k > 0) hp = *(const LAS f32x4*)(XL + ((k - 1) * 4 + wc) * 32 + 16 * n + 4 * fq);
                if (k < 3) hn = *(const LAS f32x4*)(XF + ((k + 1) * 4 + wc) * 32 + 16 * n + 4 * fq);
                f32x4 P[4], N[4];
#pragma unroll
                for (int m = 0; m < 4; ++m)
#pragma unroll
                    for (int j = 0; j < 4; ++j) { P[m][j] = dpp_from_prev(acc[ai][0][m][n][j]); N[m][j] = dpp_from_next(acc[ai][0][m][n][j]); }
#pragma unroll
                for (int m = 0; m < 4; ++m) { f32x4 o;
#pragma unroll
                    for (int j = 0; j < 4; ++j) {
                        const float c = bb[j] + w1[j] * acc[ai][0][m][n][j] + w0a[j] * P[m][j] + w0b[j] * (m > 0 ? P[m - 1][j] : hp[j]) + w2a[j] * N[m][j] + w2b[j] * (m < 3 ? N[m + 1][j] : hn[j]);
                        o[j] = siluf_(c) * acc[ai][1][m][n][j]; }
                    u32x2 w; w.x = cvt_pk_bf16(o[0], o[1]); w.y = cvt_pk_bf16(o[2], o[3]);
                    if (n == 0) stash[ai][m] = w;
                    else { const u32x4 ww = (u32x4){stash[ai][m].x, stash[ai][m].y, w.x, w.y}; *(u32x4*)(G + (size_t)(u.pm * 256 + 128 * ai + 64 * wr + 16 * m + fr) * DFF + f0) = ww; } } } }
        asm volatile("s_waitcnt lgkmcnt(0)" ::: "memory"); __builtin_amdgcn_s_barrier(); asm volatile("" ::: "memory");
    }
};
__device__ __forceinline__ void phase_conv_fixup(const Frame& F, int l, int t_lo, int ntile) {
    const float* EDGE = WSP(float, WS_EDGE); bf16_t* Gb = WSP(bf16_t, WS_G); const float* wc = inp(23) + (size_t)l * 3 * DFF; const float* bc = inp(24) + (size_t)l * DFF;
    const long total = (long)ntile * 2 * (DFF / 4); const long gt = (long)F.vcu * NTHR + F.tid, gs = (long)F.G * NTHR;
    for (long it = gt; it < total; it += gs) {
        const int f4 = (int)(it % (DFF / 4)); const int q = (int)(it / (DFF / 4)); const int which = q & 1, pm = t_lo + (q >> 1); const int f = 4 * f4, pn = f >> 7, c = f & 127;
        const bool seq_first = pm >= TL || (pm & 7) == 0, seq_last = pm >= TL || (pm & 7) == 7;
        const float* e = EDGE + (size_t)(pm * 22 + pn) * 768 + c;
        f32x4 ap = (f32x4){0.f, 0.f, 0.f, 0.f}, an = ap, ac, vv;
        if (which == 0) { if (!seq_first) ap = *(const f32x4*)(e - 22 * 768 + 3 * 128); ac = *(const f32x4*)e; an = *(const f32x4*)(e + 128); vv = *(const f32x4*)(e + 4 * 128); }
        else { ap = *(const f32x4*)(e + 2 * 128); ac = *(const f32x4*)(e + 3 * 128); if (!seq_last) an = *(const f32x4*)(e + 22 * 768); vv = *(const f32x4*)(e + 5 * 128); }
        const f32x4 w0 = *(const f32x4*)(wc + f), w1 = *(const f32x4*)(wc + DFF + f), w2 = *(const f32x4*)(wc + 2 * DFF + f), bb = *(const f32x4*)(bc + f);
        f32x4 o;
#pragma unroll
        for (int j = 0; j < 4; ++j) o[j] = siluf_(w0[j] * ap[j] + w1[j] * ac[j] + w2[j] * an[j] + bb[j]) * vv[j];
        store4bf(Gb + (size_t)(pm * 256 + (which ? 255 : 0)) * DFF + f, o);
    }
}

__device__ __forceinline__ int perm32(int rho) { const int n = rho >> 4, i = rho & 15; return 8 * (i >> 2) + 4 * n + (i & 3); }
__device__ __forceinline__ int permcol(int n) { return (n & ~31) + perm32(n & 31); }
struct MapIdent { __device__ int operator()(int n) const { return n; } };
struct MapIdentP { __device__ int operator()(int n) const { return permcol(n); } };
struct MapWin { __device__ int operator()(int n) const { const int t = n >> 8; const int i = t <= 5 ? permcol(n & 255) : (n & 255);
    switch (t) { case 0: return i; case 1: return 256 + i; case 2: return 544 + i; case 3: return 800 + i; case 4: return 1056 + i; case 5: return 1312 + i; case 6: return 1584 + i; case 7: return 1840 + i;
        case 9: { if (i < 32) { const int nn = i >> 4, ii = i & 15; return 512 + ((ii < 8 ? ii : 8 + ii) + 8 * nn); } if (i < 48) return 1568 + (i - 32); return -1; }
        default: return -1; } } };
struct MapUq { __device__ int operator()(int n) const { const int hh = n >> 7, w = n & 127; if (w < 64) return 96 * hh + w; if (w < 96) { const int c = w - 64, nn = c >> 4, ii = c & 15; return 96 * hh + 64 + ((ii < 8 ? ii : 8 + ii) + 8 * nn); } return -1; } };
struct MapGate { __device__ int operator()(int n) const { const int pn = n >> 8, rem = n & 255, bj = rem >> 7, wc = (rem & 127) >> 5, nn = (rem & 31) >> 4, q4 = rem & 15; const int s = 2 * bj + nn, d = 64 * pn + 16 * wc + q4; return s * 1048576 + d; } };
struct MapBranch { __device__ int operator()(int n) const { const int s = n >> 10, d = permcol(n & 1023); return s * 262144 + d; } };
struct MapUp { __device__ int operator()(int n) const { const int pn = n >> 8, i = permcol(n & 255); return i < 128 ? 128 * pn + i : 2816 + 128 * pn + (i - 128); } };

template <class Map>
__device__ __forceinline__ void conv_weight(const Frame& F, const float* W, int ldw, int K, bf16_t* Wt, int nrows, const float* ks, Map map, int skip_lo, int skip_hi, int vc, int nvc) {
    LAS float* scr = (LAS float*)(F.lds + F.wave * 8448);
    const int nblk = nrows / 32, kblk = K / 64; const int gw = vc * 8 + F.wave, ngw = nvc * 8; const int lane = F.lane;
    for (int it = gw; it < nblk * kblk; it += ngw) {
        const int nb = it % nblk, kb = it / nblk; const int n0 = 32 * nb, k0 = 64 * kb;
        if (n0 >= skip_lo && n0 < skip_hi) continue;
        const int col = map(n0 + (lane & 31));
        float v[32];
        const float* wp = W + (size_t)(k0 + (lane >> 5)) * ldw + (col >= 0 ? col : 0);
#pragma unroll
        for (int i = 0; i < 32; ++i) v[i] = wp[(size_t)(2 * i) * ldw];
        if (ks) {
#pragma unroll
            for (int i = 0; i < 32; ++i) v[i] *= ks[k0 + 2 * i + (lane >> 5)]; }
#pragma unroll
        for (int i = 0; i < 32; ++i) scr[(2 * i + (lane >> 5)) * 33 + (lane & 31)] = col >= 0 ? v[i] : 0.f;
        asm volatile("s_waitcnt lgkmcnt(0)" ::: "memory");
        const int c = lane & 7;
#pragma unroll
        for (int j = 0; j < 4; ++j) { const int n = (lane >> 3) + 8 * j; const LAS float* sp = scr + (8 * c) * 33 + n;
            u32x4 o; o.x = cvt_pk_bf16(sp[0 * 33], sp[1 * 33]); o.y = cvt_pk_bf16(sp[2 * 33], sp[3 * 33]); o.z = cvt_pk_bf16(sp[4 * 33], sp[5 * 33]); o.w = cvt_pk_bf16(sp[6 * 33], sp[7 * 33]);
            *(u32x4*)(Wt + (size_t)(n0 + n) * K + k0 + 8 * c) = o; }
        asm volatile("s_waitcnt lgkmcnt(0)" ::: "memory");
    }
}
template <class Map>
__device__ __forceinline__ void conv_weight_i8(const Frame& F, const float* W, int ldw, unsigned char* Wt, int nrows, Map map, float* colscale, int vc, int nvc, int skip_lo = 0, int skip_hi = 0) {
    LAS float* scr = (LAS float*)(F.lds + F.wave * 8448);
    LAS float* cmx = (LAS float*)(F.lds + 68 * 1024);
    const int lane = F.lane;
    for (int it = vc; it < nrows / 32; it += nvc) {
        const int n0 = 32 * it; if (n0 >= skip_lo && n0 < skip_hi) continue;
        const int col = map(n0 + (lane & 31));
        float v[2][32]; float mx = 0.f;
#pragma unroll
        for (int t = 0; t < 2; ++t) { const int k0 = 64 * (2 * F.wave + t); const float* wp = W + (size_t)(k0 + (lane >> 5)) * ldw + (col >= 0 ? col : 0);
#pragma unroll
            for (int i = 0; i < 32; ++i) { v[t][i] = col >= 0 ? wp[(size_t)(2 * i) * ldw] : 0.f; } }
#pragma unroll
        for (int t = 0; t < 2; ++t)
#pragma unroll
            for (int i = 0; i < 32; ++i) mx = fmaxf(mx, fabsf(v[t][i]));
        mx = fmaxf(mx, __shfl_xor(mx, 32));
        __syncthreads();
        if (lane < 32) cmx[F.wave * 32 + lane] = mx;
        __syncthreads();
        float cm = 0.f;
#pragma unroll
        for (int w = 0; w < 8; ++w) cm = fmaxf(cm, cmx[w * 32 + (lane & 31)]);
        const float inv = cm > 0.f ? 127.f / cm : 0.f;
        if (F.wave == 0 && lane < 32) colscale[n0 + lane] = cm * (1.f / 127.f);
#pragma unroll
        for (int t = 0; t < 2; ++t) { const int k0 = 64 * (2 * F.wave + t);
#pragma unroll
            for (int i = 0; i < 32; ++i) scr[(2 * i + (lane >> 5)) * 33 + (lane & 31)] = v[t][i] * inv;
            asm volatile("s_waitcnt lgkmcnt(0)" ::: "memory");
            const int c = lane & 7;
#pragma unroll
            for (int j = 0; j < 4; ++j) { const int n = (lane >> 3) + 8 * j; const LAS float* sp = scr + (8 * c) * 33 + n;
                u32x2 o; o.x = pack4_i8(sp[0 * 33], sp[1 * 33], sp[2 * 33], sp[3 * 33]); o.y = pack4_i8(sp[4 * 33], sp[5 * 33], sp[6 * 33], sp[7 * 33]);
                *(u32x2*)(Wt + (size_t)(n0 + n) * 1024 + k0 + 8 * c) = o; }
            asm volatile("s_waitcnt lgkmcnt(0)" ::: "memory"); }
    }
}
__device__ __forceinline__ void quant_rows_i8(const Frame& F, const float* src, unsigned char* dst, float* rscale, int nrows, int vc, int nvc) {
    LAS float* cmx = (LAS float*)(F.lds + 68 * 1024);
    for (int it = vc; it < nrows / 32; it += nvc) {
        const int row = 32 * it + (F.tid & 31), kq = F.tid >> 5;
        f32x4 v[16]; float mx = 0.f;
#pragma unroll
        for (int i = 0; i < 16; ++i) { v[i] = *(const f32x4*)(src + (size_t)row * 1024 + 64 * kq + 4 * i); mx = fmaxf(fmaxf(mx, fmaxf(fabsf(v[i][0]), fabsf(v[i][1]))), fmaxf(fabsf(v[i][2]), fabsf(v[i][3]))); }
        __syncthreads();
        cmx[kq * 32 + (F.tid & 31)] = mx;
        __syncthreads();
        float cm = 0.f;
#pragma unroll
        for (int w = 0; w < 16; ++w) cm = fmaxf(cm, cmx[w * 32 + (F.tid & 31)]);
        const float inv = cm > 0.f ? 127.f / cm : 0.f;
        if (kq == 0) rscale[row] = cm * (1.f / 127.f);
#pragma unroll
        for (int i = 0; i < 16; i += 4) { u32x4 o; o.x = pack4_i8(v[i][0] * inv, v[i][1] * inv, v[i][2] * inv, v[i][3] * inv); o.y = pack4_i8(v[i + 1][0] * inv, v[i + 1][1] * inv, v[i + 1][2] * inv, v[i + 1][3] * inv);
            o.z = pack4_i8(v[i + 2][0] * inv, v[i + 2][1] * inv, v[i + 2][2] * inv, v[i + 2][3] * inv); o.w = pack4_i8(v[i + 3][0] * inv, v[i + 3][1] * inv, v[i + 3][2] * inv, v[i + 3][3] * inv);
            *(u32x4*)(dst + (size_t)row * 1024 + 64 * kq + 4 * i) = o; }
    }
}
__device__ __forceinline__ void conv_fourier_rows(const Frame& F, const float* W, float* Ft  , bool i8, int vc, int nvc) {
    LAS float* Wl = (LAS float*)(F.lds + 68 * 1024);
    LAS float* Tc = Wl + 64 * 65;
    for (int item = vc; item < 64; item += nvc) {
        const int g = item & 3, kb = item >> 2; const int k0 = 64 * kb;
        __syncthreads();
        for (int i = F.tid; i < 4096; i += NTHR) { const int kk = i >> 6, c = i & 63; Wl[kk * 65 + c] = W[(size_t)(k0 + kk) * NIN_SRC + 2096 + g * 64 + c]; }
        if (F.tid < 64) Tc[F.tid] = cospif((float)F.tid * (1.f / 32.f));
        __syncthreads();
        const int q = F.tid & 63, kq = F.tid >> 6; const bool issin = q >= 33; const int j = issin ? q - 32 : q;
        float acc[8];
#pragma unroll
        for (int i = 0; i < 8; ++i) acc[i] = 0.f;
        for (int c = 0; c < 64; ++c) { const int mm = (j * c) & 63; const float tw = issin ? -Tc[(mm + 48) & 63] : Tc[mm];
#pragma unroll
            for (int i = 0; i < 8; ++i) acc[i] += Wl[(8 * kq + i) * 65 + c] * tw; }
        const int fc = g * 64 + q; const int qq = fc & 31; const int fq = qq >> 3, nn = (qq >> 2) & 1, jj = qq & 3; const int rho = 16 * nn + 4 * fq + jj;
        if (i8) { float* dst = Ft + (size_t)((fc & ~31) + rho) * 1024 + k0 + 8 * kq;
            *(f32x4*)dst = (f32x4){acc[0], acc[1], acc[2], acc[3]}; *(f32x4*)(dst + 4) = (f32x4){acc[4], acc[5], acc[6], acc[7]}; }
        else { bf16_t* dst = (bf16_t*)Ft + (size_t)(2048 + (fc & ~31) + rho) * 1024 + k0 + 8 * kq;
            u32x4 o0; o0.x = cvt_pk_bf16(acc[0], acc[1]); o0.y = cvt_pk_bf16(acc[2], acc[3]); o0.z = cvt_pk_bf16(acc[4], acc[5]); o0.w = cvt_pk_bf16(acc[6], acc[7]);
            *(u32x4*)dst = o0; }
    }
}
__device__ __forceinline__ void build_cs(const Frame& F, bf16_t* CS, int N) {
    const long total = (long)N * (2 * N / 8); const long gt = (long)F.vcu * NTHR + F.tid, gs = (long)F.G * NTHR; const float inv = 2.0f / (float)N;
    for (long it = gt; it < total; it += gs) {
        const int cc = (int)(it % (2 * N / 8)), k = (int)(it / (2 * N / 8)); float v[8];
#pragma unroll
        for (int i = 0; i < 8; ++i) { const int col = cc * 8 + i; const int part = col >= N, n = col - part * N; const int mm = (int)(((long)k * n) % N); const float a = (float)mm * inv; v[i] = part ? sinpif(a) : cospif(a); }
        u32x4 o; o.x = pk2(v[0], v[1]); o.y = pk2(v[2], v[3]); o.z = pk2(v[4], v[5]); o.w = pk2(v[6], v[7]);
        *(u32x4*)(CS + (size_t)k * 2 * N + cc * 8) = o;
    }
}
__device__ __forceinline__ void build_cs2(const Frame& F, bf16_t* CS) {
    const long total = 1024L * 256; const long gt = (long)F.vcu * NTHR + F.tid, gs = (long)F.G * NTHR;
    for (long it = gt; it < total; it += gs) {
        const int cc = (int)(it & 255), k = (int)(it >> 8); float v[8];
#pragma unroll
        for (int i = 0; i < 8; ++i) { const int col = cc * 8 + i; const int part = col >> 10, n = col & 1023; const int mm = (k * n) & 2047; const float a = (float)mm * (1.f / 1024.f); v[i] = part ? sinpif(a) : cospif(a); }
        u32x4 o; o.x = pk2(v[0], v[1]); o.y = pk2(v[2], v[3]); o.z = pk2(v[4], v[5]); o.w = pk2(v[6], v[7]);
        *(u32x4*)(CS + (size_t)k * 2048 + cc * 8) = o;
    }
}
__device__ __forceinline__ void mod_gemv(const Frame& F) {
    LAS float* sc = (LAS float*)F.lds;
    LAS float* red = (LAS float*)(F.lds + 17 * 1024 * 4);
    const float* c = inp(1); const float* cctx = inp(3); const float* wm = inp(4); const float* bm = inp(5); float* mod = WSP(float, WS_MOD);
    bool loaded = false;
    for (int item = F.vcu; item < DEPTH * 128; item += F.G) {
        if (!loaded) { for (int i = F.tid; i < 17 * 1024; i += NTHR) { const float x = i < 16 * 1024 ? c[i] : cctx[i - 16 * 1024]; sc[i] = siluf_(x); } __syncthreads(); loaded = true; }
        const int l = item >> 7, cb = item & 127; const int cl = F.tid % 48, kp = F.tid / 48;
        if (kp < 8) {
            float a[17];
#pragma unroll
            for (int j = 0; j < 17; ++j) a[j] = 0.f;
            const float* wp = wm + (size_t)l * 1024 * 6144 + cb * 48 + cl;
#pragma unroll 2
            for (int k = kp * 128; k < kp * 128 + 128; k += 4) { const float w0 = wp[(size_t)k * 6144], w1 = wp[(size_t)(k + 1) * 6144], w2 = wp[(size_t)(k + 2) * 6144], w3 = wp[(size_t)(k + 3) * 6144];
#pragma unroll
                for (int j = 0; j < 17; ++j) { const f32x4 s4 = *(const LAS f32x4*)(sc + j * 1024 + k); a[j] += (s4[0] * w0 + s4[1] * w1) + (s4[2] * w2 + s4[3] * w3); } }
#pragma unroll
            for (int j = 0; j < 17; ++j) red[(kp * 48 + cl) * 17 + j] = a[j];
        }
        __syncthreads();
        for (int o = F.tid; o < 48 * 17; o += NTHR) { const int cc = o / 17, j = o % 17; float sacc = 0.f;
#pragma unroll
            for (int q = 0; q < 8; ++q) sacc += red[(q * 48 + cc) * 17 + j];
            mod[((size_t)l * 17 + j) * 6144 + cb * 48 + cc] = sacc + bm[(size_t)l * 6144 + cb * 48 + cc]; }
        __syncthreads();
    }
}
__device__ __forceinline__ void build_tables(const Frame& F) {
    float* rg = WSP(float, WS_TAB); float* rm = WSP(float, WS_TAB + 8192);
    const int gt = F.vcu * NTHR + F.tid;
    if (gt < 64 * 16) { const int pos = gt >> 4, i = gt & 15; const float inv = exp2f(-(float)i * (1.f / 16.f) * 13.287712379549449f); const float a = (float)pos * inv; rg[gt * 2] = cosf(a); rg[gt * 2 + 1] = sinf(a); }
    else if (gt < 64 * 16 + 64 * 8) { const int q = gt - 64 * 16; const int pos = q >> 3, i = q & 7; const float inv = exp2f(-(float)i * (1.f / 8.f) * 13.287712379549449f); const float a = (float)pos * inv; rm[q * 2] = cosf(a); rm[q * 2 + 1] = sinf(a); }
}
__device__ __forceinline__ void copy_f32(const Frame& F, const float* src, float* dst, size_t n4) {
    const size_t gt = (size_t)F.vcu * NTHR + F.tid, gs = (size_t)F.G * NTHR;
    for (size_t i = gt; i < n4; i += gs) ((f32x4*)dst)[i] = ((const f32x4*)src)[i];
}

__device__ __forceinline__ void convert_layer_weights(const Frame& F, int l, int vc, int nvc, int parts) {
    unsigned char* wl = F.ws + WS_W + (size_t)l * W_LAYER;
  if (parts & 1) {
    if (win8(l)) {
        conv_weight_i8(F, inp(10) + (size_t)l * 1024 * NIN_SRC, NIN_SRC, wl + W_IN, NIN, MapWin(), WSP(float, WS_WSCW) + l * 2560, vc, nvc, 2048, 2304);
        conv_fourier_rows(F, inp(10) + (size_t)l * 1024 * NIN_SRC, WSP(float, WS_FTMP) + (size_t)l * 256 * 1024, true, vc, nvc);
    } else {
        conv_weight(F, inp(10) + (size_t)l * 1024 * NIN_SRC, NIN_SRC, 1024, (bf16_t*)(wl + W_IN), NIN, nullptr, MapWin(), 2048, 2304, vc, nvc);
        conv_fourier_rows(F, inp(10) + (size_t)l * 1024 * NIN_SRC, (float*)(wl + W_IN), false, vc, nvc);
    }
    conv_weight(F, inp(12) + (size_t)l * 256 * 384, 384, 256, (bf16_t*)(wl + W_UQ), 512, inp(11) + l * 256, MapUq(), 0, 0, vc, nvc);
    conv_weight(F, inp(14) + (size_t)l * 256 * 512, 512, 256, (bf16_t*)(wl + W_UKV), 512, inp(13) + l * 256, MapIdent(), 0, 0, vc, nvc);
  }
  if (parts & 2) {
    conv_weight_i8(F, inp(18) + (size_t)l * 4 * 1024 * 1024, 1024, wl + W_G, 4096, MapGate(), WSP(float, WS_WSCG) + l * 4096, vc, nvc);
    conv_weight(F, inp(20) + (size_t)l * 4 * 256 * 1024, 1024, 256, (bf16_t*)(wl + W_B), 4096, nullptr, MapBranch(), 0, 0, vc, nvc);
    conv_weight(F, inp(21) + (size_t)l * 1024 * 1024, 1024, 1024, (bf16_t*)(wl + W_OUT), 1024, nullptr, MapIdentP(), 0, 0, vc, nvc);
  }
  if (parts & 4)
    conv_weight_i8(F, inp(22) + (size_t)l * 1024 * 5632, 5632, wl + W_UP, 5632, MapUp(), WSP(float, WS_WSCU) + l * 5632, vc, nvc);
  if (parts & 8)
    conv_weight(F, inp(25) + (size_t)l * 2816 * 1024, 1024, 2816, (bf16_t*)(wl + W_DOWN), 1024, nullptr, MapIdentP(), 0, 0, vc, nvc);
}

__device__ __forceinline__ void quant_row_store(const Frame& F, const f32x4 (&o)[4], unsigned char* o8row, float* scale_out) {
    float mx = 0.f;
#pragma unroll
    for (int j = 0; j < 4; ++j) mx = fmaxf(fmaxf(mx, fmaxf(fabsf(o[j][0]), fabsf(o[j][1]))), fmaxf(fabsf(o[j][2]), fabsf(o[j][3])));
#pragma unroll
    for (int d = 1; d < 64; d <<= 1) mx = fmaxf(mx, __shfl_xor(mx, d));
    const float inv = mx > 0.f ? 127.f / mx : 0.f;
#pragma unroll
    for (int j = 0; j < 4; ++j) *(unsigned*)(o8row + 4 * (F.lane + 64 * j)) = pack4_i8(o[j][0] * inv, o[j][1] * inv, o[j][2] * inv, o[j][3] * inv);
    if (F.lane == 0) *scale_out = mx * (1.f / 127.f);
}
__device__ __forceinline__ void norm_mod_row(const Frame& F, const float* xr, const float* gain, const float* sh, const float* sc, bf16_t* orow  , unsigned char* o8row, float* scale_out) {
    f32x4 v[4]; float s = 0.f;
#pragma unroll
    for (int j = 0; j < 4; ++j) { v[j] = ((const f32x4*)xr)[F.lane + 64 * j]; s += (v[j][0] * v[j][0] + v[j][1] * v[j][1]) + (v[j][2] * v[j][2] + v[j][3] * v[j][3]); }
    const float rstd = rsqrtf(wave_sum(s) * (1.f / D) + EPS);
    f32x4 o[4];
#pragma unroll
    for (int j = 0; j < 4; ++j) { const int c4 = F.lane + 64 * j; const f32x4 g = ((const f32x4*)gain)[c4], a = ((const f32x4*)sc)[c4], b = ((const f32x4*)sh)[c4];
#pragma unroll
        for (int e = 0; e < 4; ++e) o[j][e] = v[j][e] * rstd * g[e] * (1.f + a[e]) + b[e];
        if (orow) store4bf(orow + 4 * c4, o[j]);
    }
    quant_row_store(F, o, o8row, scale_out);
}
__device__ __forceinline__ void phase_norm1_in(const Frame& F) {
    const float* mod = WSP(float, WS_MOD); const float* gain = inp(6); const float* xin = inp(0); const float* cin = inp(2);
    const int gw = F.vcu * 8 + F.wave, ngw = F.G * 8;
    for (int r = gw; r < R; r += ngw) { const float* mr = mod + (size_t)modrow_of(r) * 6144; const float* xr = r < RL ? xin + (size_t)r * D : cin + (size_t)(r - RL) * D;
        if (win8(0)) norm_mod_row(F, xr, gain, mr, mr + 1024, nullptr, WSP(unsigned char, WS_H) + (size_t)r * D, WSP(float, WS_HS) + r);
        else norm_mod_row(F, xr, gain, mr, mr + 1024, WSP(bf16_t, WS_H) + (size_t)r * D, WSP(unsigned char, WS_H8A) + (size_t)r * D, WSP(float, WS_HS) + r);
    }
}
__device__ __forceinline__ void phase_post(const Frame& F, int l, const bf16_t* Yin, int nrows, bool second, bool from_input) {
    const float* mod = WSP(float, WS_MOD) + (size_t)l * 17 * 6144;
    const float* gpost = inp(second ? 9 : 7) + (size_t)l * D;
    const bool donorm = !second || l + 1 < DEPTH; const int ln = second ? l + 1 : l;
    const float* gpre = inp(second ? 6 : 8) + (size_t)ln * D; const float* modn = WSP(float, WS_MOD) + (size_t)ln * 17 * 6144;
    const float* xin0 = inp(0); const float* cin0 = inp(2);
    const int gw = F.vcu * 8 + F.wave, ngw = F.G * 8; const int per = (nrows + ngw - 1) / ngw;
    f32x4 vgpost[4], vgpre[4], vgate[4], vsc[4], vsh[4];
#pragma unroll
    for (int j = 0; j < 4; ++j) { const int c4 = F.lane + 64 * j; vgpost[j] = ((const f32x4*)gpost)[c4]; vgpre[j] = ((const f32x4*)gpre)[c4]; vgate[j] = vsc[j] = vsh[j] = (f32x4){0.f, 0.f, 0.f, 0.f}; }
    int cur = -1;
    for (int i = 0; i < per; ++i) { const int r = gw * per + i; if (r >= nrows) break;
        const int mrow = modrow_of(r);
        if (mrow != cur) { cur = mrow; const float* gate = mod + (size_t)mrow * 6144 + (second ? 5 * 1024 : 2 * 1024); const float* mn = modn + (size_t)mrow * 6144;
            const float* shn = mn + (second ? 0 : 3 * 1024); const float* scn = mn + (second ? 1024 : 4 * 1024);
#pragma unroll
            for (int j = 0; j < 4; ++j) { const int c4 = F.lane + 64 * j; vgate[j] = ((const f32x4*)gate)[c4]; vsc[j] = ((const f32x4*)scn)[c4]; vsh[j] = ((const f32x4*)shn)[c4]; } }
        float* xo = (float*)xrow_ptr(F, r); const float* xi = from_input ? (r < RL ? xin0 + (size_t)r * D : cin0 + (size_t)(r - RL) * D) : xo; const bf16_t* yr = Yin + (size_t)r * D;
        f32x4 y[4], xv[4]; float s = 0.f;
#pragma unroll
        for (int j = 0; j < 4; ++j) { const u32x2 w = ((const u32x2*)yr)[F.lane + 64 * j]; y[j] = (f32x4){lo_bf(w.x), hi_bf(w.x), lo_bf(w.y), hi_bf(w.y)}; xv[j] = ((const f32x4*)xi)[F.lane + 64 * j];
            s += (y[j][0] * y[j][0] + y[j][1] * y[j][1]) + (y[j][2] * y[j][2] + y[j][3] * y[j][3]); }
        const float rstd = rsqrtf(wave_sum(s) * (1.f / D) + EPS);
        f32x4 xn[4]; float s2 = 0.f;
#pragma unroll
        for (int j = 0; j < 4; ++j) { const int c4 = F.lane + 64 * j;
#pragma unroll
            for (int e = 0; e < 4; ++e) xn[j][e] = xv[j][e] + vgate[j][e] * (y[j][e] * rstd * vgpost[j][e]);
            ((f32x4*)xo)[c4] = xn[j]; s2 += (xn[j][0] * xn[j][0] + xn[j][1] * xn[j][1]) + (xn[j][2] * xn[j][2] + xn[j][3] * xn[j][3]); }
        if (donorm) {
            const float rstd2 = rsqrtf(wave_sum(s2) * (1.f / D) + EPS);
            f32x4 o[4];
#pragma unroll
            for (int j = 0; j < 4; ++j) { const int c4 = F.lane + 64 * j;
#pragma unroll
                for (int e = 0; e < 4; ++e) o[j][e] = xn[j][e] * rstd2 * vgpre[j][e] * (1.f + vsc[j][e]) + vsh[j][e];
                if (second && !win8(ln)) store4bf(WSP(bf16_t, WS_H) + (size_t)r * D + 4 * c4, o[j]);
            }
            if (!second) quant_row_store(F, o, WSP(unsigned char, WS_H2) + (size_t)r * D, WSP(float, WS_H2S) + r);
            else if (win8(ln)) quant_row_store(F, o, WSP(unsigned char, WS_H) + (size_t)r * D, WSP(float, WS_HS) + r);
            else if (r < RL) quant_row_store(F, o, WSP(unsigned char, WS_H8B) + (size_t)r * D, WSP(float, WS_HS) + r);
        }
    }
}
__device__ __forceinline__ void phase_fab_transpose(const Frame& F, int row0, int N, int nb, bf16_t* FT) {
    const bf16_t* FAB = WSP(bf16_t, WS_FAB);
    const long total = (long)nb * 2 * (N / 8) * 256; const long gt = (long)F.vcu * NTHR + F.tid, gs = (long)F.G * NTHR;
    for (long it = gt; it < total; it += gs) {
        const int col = (int)(it & 255); long q = it >> 8; const int nc = (int)(q % (N / 8)); q /= (N / 8); const int part = (int)(q & 1), b = (int)(q >> 1);
        const int g = col >> 6, j = col & 63; const int jj = j <= 32 ? j : 64 - j;
        const bool zer = part == 1 && (j == 0 || j == 32); const unsigned short flip = (part == 1 && j > 32) ? 0x8000u : 0u;
        const int slot = part == 0 ? jj : 32 + jj;
        unsigned short v[8];
#pragma unroll
        for (int i = 0; i < 8; ++i) v[i] = zer ? (unsigned short)0 : (unsigned short)(FAB[(size_t)(row0 + b * N + nc * 8 + i) * 256 + g * 64 + slot] ^ flip);
        u32x4 o; o.x = v[0] | ((unsigned)v[1] << 16); o.y = v[2] | ((unsigned)v[3] << 16); o.z = v[4] | ((unsigned)v[5] << 16); o.w = v[6] | ((unsigned)v[7] << 16);
        *(u32x4*)(FT + ((size_t)(b * 256 + col) * 2 * N + part * N + nc * 8)) = o;
    }
}
__device__ __forceinline__ void fold_unit(const Frame& F, int b, int g, int blk) {
    const bf16_t* FAB = WSP(bf16_t, WS_FAB); bf16_t* FT = WSP(bf16_t, WS_FABT); float* ALT = WSP(float, WS_TAB + 65536); float* A1024 = WSP(float, WS_TAB + 81920);
    LAS bf16_t* T = (LAS bf16_t*)F.lds;
    LAS float* red = (LAS float*)(F.lds + 131072);
    __syncthreads();
#pragma unroll 4
    for (int it = 0; it < 16; ++it) { const int n = it * 128 + (F.tid >> 2), ch = F.tid & 3;
        *(LAS u32x4*)(T + n * 32 + ch * 8) = *(const u32x4*)(FAB + (size_t)(b * SEQ + n) * 256 + g * 64 + blk * 32 + ch * 8); }
    __syncthreads();
    const int c = F.tid & 31; const bool cosrc = blk == 0 || c == 0;
    const int j1 = blk == 0 ? c : (c == 0 ? 32 : c); const int j2 = (c == 0) ? -1 : 64 - c;
    bf16_t* const d1 = FT + ((size_t)(b * 512 + g * 64 + j1)) * 2048 + (cosrc ? 0 : 1024);
    bf16_t* const d2 = FT + ((size_t)(b * 512 + g * 64 + (j2 < 0 ? 0 : j2))) * 2048 + (cosrc ? 0 : 1024);
#pragma unroll 2
    for (int it = 0; it < 8; ++it) { const int n0 = (it * 16 + (F.tid >> 5)) * 8; float v[8];
#pragma unroll
        for (int i = 0; i < 8; ++i) { const int n = n0 + i; const float x = bf2f(T[n * 32 + c]); const float y = n > 0 ? bf2f(T[(2048 - n) * 32 + c]) : 0.f; v[i] = cosrc ? x + y : (n > 0 ? x - y : 0.f); }
        u32x4 o; o.x = cvt_pk_bf16(v[0], v[1]); o.y = cvt_pk_bf16(v[2], v[3]); o.z = cvt_pk_bf16(v[4], v[5]); o.w = cvt_pk_bf16(v[6], v[7]);
        u32x4 on = o; on.x ^= 0x80008000u; on.y ^= 0x80008000u; on.z ^= 0x80008000u; on.w ^= 0x80008000u;
        if (cosrc) { *(u32x4*)(d1 + n0) = o; *(u32x4*)(d1 + (size_t)256 * 2048 + n0) = o; if (j2 >= 0) { *(u32x4*)(d2 + n0) = o; *(u32x4*)(d2 + (size_t)256 * 2048 + n0) = o; } }
        else { *(u32x4*)(d1 + n0) = o; *(u32x4*)(d1 + (size_t)256 * 2048 + n0) = on; *(u32x4*)(d2 + n0) = on; *(u32x4*)(d2 + (size_t)256 * 2048 + n0) = o; }
        if (blk == 1 && c == 0) {
            const u32x4 z = (u32x4){0u, 0u, 0u, 0u}; bf16_t* z0 = FT + ((size_t)(b * 512 + g * 64)) * 2048 + 1024 + n0; bf16_t* z1 = z0 + (size_t)32 * 2048;
            *(u32x4*)z0 = z; *(u32x4*)(z0 + (size_t)256 * 2048) = z; *(u32x4*)z1 = z; *(u32x4*)(z1 + (size_t)256 * 2048) = z; } }
    { const int q = F.tid >> 5; float sacc = 0.f;
      for (int n = q * 128; n < q * 128 + 128; n += 2) sacc += bf2f(T[n * 32 + c]) - bf2f(T[(n + 1) * 32 + c]);
      red[q * 32 + c] = sacc; __syncthreads();
      if (F.tid < 32 && (blk == 0 || F.tid == 0)) { float t = 0.f;
#pragma unroll
          for (int qq = 0; qq < 16; ++qq) t += red[qq * 32 + F.tid];
          const float a1024 = bf2f(T[1024 * 32 + F.tid]);
          ALT[b * 256 + g * 64 + j1] = t; A1024[b * 256 + g * 64 + j1] = a1024;
          if (j2 >= 0) { ALT[b * 256 + g * 64 + j2] = t; A1024[b * 256 + g * 64 + j2] = a1024; } } }
}
struct SchedDft2 {
    int G, c; const char* CS; const char* FT;
    __device__ __forceinline__ bool next(int i, Unit& u) const {
        const long L = (long)i * G + c; if (L >= 128) return false;
        const int b = (int)(L >> 3), pm = (int)((L >> 1) & 3), v = (int)(L & 1);
        u.pm = pm; u.pn = b * 2 + v; u.a = CS + (size_t)pm * 256 * 2048 * 2; u.b = FT + (size_t)(b * 512 + v * 256) * 2048 * 2; return true;
    }
};
struct EpiDft2 {
    unsigned char* ws;
    __device__ __forceinline__ void operator()(const Acc& acc, const Unit& u, int wr, int wc, int fr, int fq, LAS unsigned char* lds) const {
        bf16_t* const Y = EW(bf16_t, WS_Y); const float* const ALT = EW(float, WS_TAB + 65536); const float* const A1024 = EW(float, WS_TAB + 81920);
        const int b = u.pn >> 1, v = u.pn & 1; const float scale = 0.0027621358640099515f; const float sg = (fr & 1) ? -1.f : 1.f;
#pragma unroll
        EPI_LOOP_BN { const int col = 128 * bj + 32 * wc + 16 * n + 4 * fq; const f32x4 a4 = *(const f32x4*)(A1024 + b * 256 + col) * sg;
#pragma unroll
            EPI_LOOP_AM { const int k = 256 * u.pm + 128 * ai + 64 * wr + 16 * m + fr;
                f32x4 o = (acc[ai][bj][m][n] + a4) * scale; int row = v ? 2048 - k : k;
                if (v && k == 0) { row = 1024; o = *(const f32x4*)(ALT + b * 256 + col) * scale; }
                store4bf(Y + (size_t)(b * SEQ + row) * 1024 + 768 + col, o); } }
    }
};

template <int DQK, bool WIN>
__device__ __forceinline__ void attn_unit(LAS unsigned char* lds, const int tid,
        const bf16_t* qptr, const int ldq, const bf16_t* Kc, const bf16_t* Kl, const int ldk, const bf16_t* VT,
        const int nctx, const int lt0, const int lt1, const int qpos, const float m_init, const float l_init, bf16_t* optr) {
    constexpr int NS = DQK / 32, KB = 64 * DQK * 2, VB = 64 * 144, BUFB = KB + VB, KCH = DQK / 8;
    const int lane = tid & 63, quad = lane >> 4, l15 = lane & 15;
    const int nt = nctx + (lt1 - lt0);
    bf16x8 Qf[2][NS];
#pragma unroll
    for (int qt = 0; qt < 2; ++qt)
#pragma unroll
        for (int sx = 0; sx < NS; ++sx) Qf[qt][sx] = *(const bf16x8*)(qptr + (size_t)qt * 16 * ldq + 32 * sx);
    f32x4 O[4][2];
#pragma unroll
    for (int a = 0; a < 4; ++a) { O[a][0] = (f32x4){0.f, 0.f, 0.f, 0.f}; O[a][1] = (f32x4){0.f, 0.f, 0.f, 0.f}; }
    float mrun[2] = {m_init, m_init}, lrun[2] = {l_init, l_init};
    const int kkey0 = tid / KCH, kcc0 = tid % KCH, kkey1 = (tid + 512) / KCH, kcc1 = (tid + 512) % KCH;
    const bool k1on = (tid + 512) < 64 * KCH;
    int ko0, ko1;
    { int ob = (kkey0 & 15) * 64 + (kcc0 & 3) * 16; ob ^= ((ob >> 9) & 1) << 5; ko0 = ((kkey0 >> 4) * NS + (kcc0 >> 2)) * 1024 + ob; }
    { int ob = (kkey1 & 15) * 64 + (kcc1 & 3) * 16; ob ^= ((ob >> 9) & 1) << 5; ko1 = ((kkey1 >> 4) * NS + (kcc1 >> 2)) * 1024 + ob; }
    const int vdv = tid >> 3, vkc = tid & 7;
    int kfo; { int ob = l15 * 64 + quad * 16; ob ^= ((ob >> 9) & 1) << 5; kfo = ob; }
    const int vfo = l15 * 144 + quad * 8;
    u32x4 kr0, kr1, vr0, nk0, nk1, nv0;
    kr1 = (u32x4){0u, 0u, 0u, 0u}; nk1 = kr1;
#define ATT_LOAD(ti_, K0, K1, V0) do { const int ti__ = (ti_); const bool isc = ti__ < nctx; const int lt = lt0 + ti__ - nctx; \
        const bf16_t* kb = isc ? Kc + (size_t)ti__ * 64 * ldk : Kl + (size_t)lt * 64 * ldk; const int vcol = isc ? 64 * ti__ : 256 + 64 * lt; \
        K0 = *(const u32x4*)(kb + (size_t)kkey0 * ldk + 8 * kcc0); if (k1on) K1 = *(const u32x4*)(kb + (size_t)kkey1 * ldk + 8 * kcc1); \
        V0 = *(const u32x4*)(VT + (size_t)vdv * 2304 + vcol + 8 * vkc); } while (0)
#define ATT_WRITE(buf_, K0, K1, V0) do { LAS unsigned char* bp_ = lds + (buf_) * BUFB; *(LAS u32x4*)(bp_ + ko0) = K0; if (k1on) *(LAS u32x4*)(bp_ + ko1) = K1; *(LAS u32x4*)(bp_ + KB + vdv * 144 + vkc * 16) = V0; } while (0)
#define ATT_BAR() do { asm volatile("s_waitcnt lgkmcnt(0)" ::: "memory"); __builtin_amdgcn_s_barrier(); asm volatile("" ::: "memory"); } while (0)
    __syncthreads();
    ATT_LOAD(0, kr0, kr1, vr0); ATT_WRITE(0, kr0, kr1, vr0);
    if (nt > 1) ATT_LOAD(1, kr0, kr1, vr0);
    ATT_BAR();
#pragma unroll 1
    for (int ti = 0; ti < nt; ++ti) {
        if (ti + 2 < nt) ATT_LOAD(ti + 2, nk0, nk1, nv0);
        const LAS unsigned char* bp = lds + (ti & 1) * BUFB;
        f32x4 S[4][2];
        bf16x8 kfr[4][NS];
#pragma unroll
        for (int kt = 0; kt < 4; ++kt)
#pragma unroll
            for (int sx = 0; sx < NS; ++sx) kfr[kt][sx] = *(const LAS bf16x8*)(bp + (kt * NS + sx) * 1024 + kfo);
        __builtin_amdgcn_sched_barrier(0);
        __builtin_amdgcn_s_setprio(1);
#pragma unroll
        for (int kt = 0; kt < 4; ++kt) { S[kt][0] = (f32x4){-mrun[0], -mrun[0], -mrun[0], -mrun[0]}; S[kt][1] = (f32x4){-mrun[1], -mrun[1], -mrun[1], -mrun[1]}; }
#pragma unroll
        for (int sx = 0; sx < NS; ++sx)
#pragma unroll
            for (int kt = 0; kt < 4; ++kt) {
                S[kt][0] = __builtin_amdgcn_mfma_f32_16x16x32_bf16(kfr[kt][sx], Qf[0][sx], S[kt][0], 0, 0, 0);
                S[kt][1] = __builtin_amdgcn_mfma_f32_16x16x32_bf16(kfr[kt][sx], Qf[1][sx], S[kt][1], 0, 0, 0); }
        __builtin_amdgcn_s_setprio(0);
        u32x2 vfr[2][4][2];
#pragma unroll
        for (int ks = 0; ks < 2; ++ks)
#pragma unroll
            for (int a = 0; a < 4; ++a) { vfr[ks][a][0] = *(const LAS u32x2*)(bp + KB + a * 16 * 144 + ks * 64 + vfo); vfr[ks][a][1] = *(const LAS u32x2*)(bp + KB + a * 16 * 144 + ks * 64 + 32 + vfo); }
        __builtin_amdgcn_sched_barrier(0);
        if (WIN && ti >= nctx) { const int kp0 = 64 * (lt0 + ti - nctx) + 4 * quad;
#pragma unroll
            for (int qt = 0; qt < 2; ++qt) { const int qp = qpos + 16 * qt;
#pragma unroll
                for (int kt = 0; kt < 4; ++kt)
#pragma unroll
                    for (int j = 0; j < 4; ++j) { const int dl = kp0 + 16 * kt + j - qp; if (dl > 128 || dl < -128) S[kt][qt][j] = -1e30f; } } }
        unsigned Pw[2][2][4];
        float ps[2];
#define ATT_EXP() do { _Pragma("unroll") for (int qt = 0; qt < 2; ++qt) { float acc_ = 0.f; \
            _Pragma("unroll") for (int kt = 0; kt < 4; ++kt) { const float p0 = fexp2(S[kt][qt][0]), p1 = fexp2(S[kt][qt][1]), p2 = fexp2(S[kt][qt][2]), p3 = fexp2(S[kt][qt][3]); \
                acc_ += (p0 + p1) + (p2 + p3); Pw[qt][kt >> 1][(kt & 1) * 2] = cvt_pk_bf16(p0, p1); Pw[qt][kt >> 1][(kt & 1) * 2 + 1] = cvt_pk_bf16(p2, p3); } ps[qt] = acc_; } } while (0)
        ATT_EXP();
        if (ti == 0 || __any(!(ps[0] < 1.0e18f) || !(ps[1] < 1.0e18f))) {
#pragma unroll
            for (int qt = 0; qt < 2; ++qt) {
                float mx = fmaxf(fmaxf(S[0][qt][0], S[0][qt][1]), fmaxf(S[0][qt][2], S[0][qt][3]));
#pragma unroll
                for (int kt = 1; kt < 4; ++kt) mx = fmaxf(mx, fmaxf(fmaxf(S[kt][qt][0], S[kt][qt][1]), fmaxf(S[kt][qt][2], S[kt][qt][3])));
                mx = fmaxf(mx, __shfl_xor(mx, 16)); mx = fmaxf(mx, __shfl_xor(mx, 32));
                const float d = (ti == 0 && !WIN) ? mx : fmaxf(mx, 0.f);
                const float al = (ti == 0 && !WIN) ? 0.f : fexp2(-d); mrun[qt] += d; lrun[qt] *= al;
#pragma unroll
                for (int a = 0; a < 4; ++a) O[a][qt] = O[a][qt] * al;
#pragma unroll
                for (int kt = 0; kt < 4; ++kt) S[kt][qt] = S[kt][qt] - d; }
            ATT_EXP();
        }
#undef ATT_EXP
        lrun[0] += ps[0]; lrun[1] += ps[1];
        __builtin_amdgcn_s_setprio(1);
#pragma unroll
        for (int ks = 0; ks < 2; ++ks) {
            bf16x8 pf0, pf1;
            { u32x4 t0 = (u32x4){Pw[0][ks][0], Pw[0][ks][1], Pw[0][ks][2], Pw[0][ks][3]}, t1 = (u32x4){Pw[1][ks][0], Pw[1][ks][1], Pw[1][ks][2], Pw[1][ks][3]};
              pf0 = __builtin_bit_cast(bf16x8, t0); pf1 = __builtin_bit_cast(bf16x8, t1); }
#pragma unroll
            for (int a = 0; a < 4; ++a) {
                const u32x4 vv = (u32x4){vfr[ks][a][0].x, vfr[ks][a][0].y, vfr[ks][a][1].x, vfr[ks][a][1].y}; const bf16x8 vf = __builtin_bit_cast(bf16x8, vv);
                O[a][0] = __builtin_amdgcn_mfma_f32_16x16x32_bf16(vf, pf0, O[a][0], 0, 0, 0);
                O[a][1] = __builtin_amdgcn_mfma_f32_16x16x32_bf16(vf, pf1, O[a][1], 0, 0, 0); }
        }
        __builtin_amdgcn_s_setprio(0);
        if (ti + 1 < nt) ATT_WRITE((ti + 1) & 1, kr0, kr1, vr0);
        ATT_BAR();
        kr0 = nk0; kr1 = nk1; vr0 = nv0;
    }
#undef ATT_LOAD
#undef ATT_WRITE
#pragma unroll
    for (int qt = 0; qt < 2; ++qt) { float l = lrun[qt]; l += __shfl_xor(l, 16); l += __shfl_xor(l, 32); const float inv = frcp(l);
#pragma unroll
        for (int a = 0; a < 4; ++a) { const f32x4 o = O[a][qt] * inv; u32x2 w; w.x = cvt_pk_bf16(o[0], o[1]); w.y = cvt_pk_bf16(o[2], o[3]); *(u32x2*)(optr + (size_t)qt * 16 * 1024 + 16 * a) = w; } }
}
__device__ __forceinline__ void mla_unit(const Frame& F, int b, int h, int q0, bool ctxq) {
    const bf16_t* Q96 = WSP(bf16_t, WS_Q96); const bf16_t* K96 = WSP(bf16_t, WS_K96); const bf16_t* VT = WSP(bf16_t, WS_V); bf16_t* Y = WSP(bf16_t, WS_Y);
    const int quad = F.lane >> 4, l15 = F.lane & 15; const int qrow = (ctxq ? RL + b * CTX : b * SEQ + q0) + 32 * F.wave + l15;
    attn_unit<96, false>(F.lds, F.tid, Q96 + (size_t)qrow * 384 + h * 96 + 8 * quad, 384, K96 + (size_t)(RL + b * CTX) * 384 + h * 96, K96 + (size_t)(b * SEQ) * 384 + h * 96, 384,
                         VT + (size_t)((b * 4 + h) * 64) * 2304, 4, 0, ctxq ? 0 : 32, 0, 0.f, 0.f, Y + (size_t)qrow * 1024 + h * 64 + 4 * quad);
}
__device__ __forceinline__ void gqa_unit(const Frame& F, int l, int b, int kvh, int p0, bool ctxq) {
    const bf16_t* GQ = WSP(bf16_t, WS_GQ); const bf16_t* GK = WSP(bf16_t, WS_GK); const bf16_t* GVT = WSP(bf16_t, WS_GV); bf16_t* Y = WSP(bf16_t, WS_Y);
    const int quad = F.lane >> 4, l15 = F.lane & 15; const int hq = 2 * kvh + (F.wave >> 2); const int pos = p0 + 32 * (F.wave & 3) + l15;
    const int qrow = (ctxq ? RL + b * CTX : b * SEQ) + pos; const float sink = inp(17)[l * 4 + hq] * LOG2E;
    const int lt0 = ctxq ? 0 : max(0, p0 - 128) / 64, lt1 = ctxq ? 0 : min(SEQ, p0 + 256) / 64;
    attn_unit<64, true>(F.lds, F.tid, GQ + (size_t)qrow * 256 + hq * 64 + 8 * quad, 256, GK + (size_t)(RL + b * CTX) * 128 + kvh * 64, GK + (size_t)(b * SEQ) * 128 + kvh * 64, 128,
                        GVT + (size_t)((b * 2 + kvh) * 64) * 2304, 4, lt0, lt1, pos, sink, quad == 0 ? 1.f : 0.f, Y + (size_t)qrow * 1024 + 512 + hq * 64 + 4 * quad);
}
__device__ __forceinline__ float logsigmoidf_(float x) { return fminf(x, 0.f) - log1pf(__expf(-fabsf(x))); }
__device__ __forceinline__ void mlstm_naive_unit(const Frame& F, int l, int b, int h, bool ctx_out) {
    const bf16_t* MQK = WSP(bf16_t, WS_MQK); const bf16_t* MV = WSP(bf16_t, WS_MV); const bf16_t* MO = WSP(bf16_t, WS_MO); const float* MG = WSP(float, WS_MG);
    float* HF = WSP(float, WS_HF); bf16_t* Y = WSP(bf16_t, WS_Y);
    const float* wcv = inp(15) + (size_t)l * 3 * 512; const float* bgate = inp(16) + (size_t)l * 16;
    LAS float* qs = (LAS float*)F.lds; LAS float* ks = qs + 8192; LAS float* vs = ks + 8192; LAS float* Cs = vs + 8192; LAS float* ns = Cs + 4096;
    LAS float* gs = ns + 64; LAS float* Ms = gs + 128; LAS float* cums = Ms + 128; LAS float* lis = cums + 128; LAS float* lfs = lis + 128; LAS float* mst = lfs + 128;
    const int tid = F.tid;
    for (int dir = 0; dir < 2; ++dir) {
        __syncthreads();
        for (int i = tid; i < 4096; i += NTHR) Cs[i] = 0.f;
        if (tid < 64) ns[tid] = 0.f;
        if (tid == 0) mst[0] = 0.f;
        __syncthreads();
        for (int j = 0; j < 18; ++j) {
            const bool isctx = j < 2; const int nseq = isctx ? CTX : SEQ; const int cj = isctx ? j : j - 2; const int base = isctx ? RL + b * CTX : b * SEQ;
            for (int i = tid; i < 128 * 64; i += NTHR) { const int p = i >> 6, d = i & 63; const int sp = cj * 128 + p; const int t = dir ? nseq - 1 - sp : sp; const size_t r = (size_t)(base + t);
                const int cq = h * 64 + d, ck = 256 + h * 64 + d;
                float aq = wcv[512 + cq] * bf2f(MQK[r * 512 + cq]), ak = wcv[512 + ck] * bf2f(MQK[r * 512 + ck]);
                if (t > 0) { aq += wcv[cq] * bf2f(MQK[(r - 1) * 512 + cq]); ak += wcv[ck] * bf2f(MQK[(r - 1) * 512 + ck]); }
                if (t < nseq - 1) { aq += wcv[1024 + cq] * bf2f(MQK[(r + 1) * 512 + cq]); ak += wcv[1024 + ck] * bf2f(MQK[(r + 1) * 512 + ck]); }
                qs[i] = siluf_(aq); ks[i] = siluf_(ak) * 0.125f; vs[i] = bf2f(MV[r * 256 + h * 64 + d]); }
            if (tid < 128) { const int sp = cj * 128 + tid; const int t = dir ? nseq - 1 - sp : sp; const size_t r = (size_t)(base + t);
                lis[tid] = MG[r * 16 + 8 * dir + h] + bgate[8 * dir + h]; lfs[tid] = logsigmoidf_(MG[r * 16 + 8 * dir + 4 + h] + bgate[8 * dir + 4 + h]); }
            __syncthreads();
            if (tid == 0) { float cum = 0.f, pm = -INFINITY; const float m0 = mst[0];
                for (int p = 0; p < 128; ++p) { cum += lfs[p]; const float g = lis[p] - cum; pm = fmaxf(pm, g); cums[p] = cum; gs[p] = g; Ms[p] = fmaxf(m0, pm); } }
            __syncthreads();
            const float m0 = mst[0];
            { const int p = tid >> 2, eg = tid & 3; float q[16], num[16]; float den = 0.f; const float Mp = Ms[p];
#pragma unroll
              for (int d = 0; d < 16; d += 4) { const f32x4 t4 = *(const LAS f32x4*)(qs + p * 64 + 16 * eg + d); q[d] = t4[0]; q[d + 1] = t4[1]; q[d + 2] = t4[2]; q[d + 3] = t4[3]; }
#pragma unroll
              for (int e = 0; e < 16; ++e) num[e] = 0.f;
              const int pmax = (p | 15);
              for (int s = 0; s <= pmax; ++s) { float dot = 0.f;
#pragma unroll
                  for (int d = 0; d < 16; d += 4) { const f32x4 kv = *(const LAS f32x4*)(ks + s * 64 + 16 * eg + d); dot += q[d] * kv[0] + q[d + 1] * kv[1] + q[d + 2] * kv[2] + q[d + 3] * kv[3]; }
                  dot += __shfl_xor(dot, 1); dot += __shfl_xor(dot, 2);
                  const float S = s <= p ? dot * __expf(gs[s] - Mp) : 0.f; den += S;
#pragma unroll
                  for (int e = 0; e < 16; e += 4) { const f32x4 vv = *(const LAS f32x4*)(vs + s * 64 + 16 * eg + e); num[e] += S * vv[0]; num[e + 1] += S * vv[1]; num[e + 2] += S * vv[2]; num[e + 3] += S * vv[3]; } }
              const float wint = __expf(m0 - Mp); float qn = 0.f;
              for (int d = 0; d < 64; ++d) { const float qd = qs[p * 64 + d]; qn += qd * ns[d]; const float wq = wint * qd;
#pragma unroll
                  for (int e = 0; e < 16; e += 4) { const f32x4 cv = *(const LAS f32x4*)(Cs + d * 64 + 16 * eg + e); num[e] += wq * cv[0]; num[e + 1] += wq * cv[1]; num[e + 2] += wq * cv[2]; num[e + 3] += wq * cv[3]; } }
              den += wint * qn; const float dn = fmaxf(fabsf(den), __expf(-(cums[p] + Mp))); const float inv = 1.f / dn;
              const int sp = cj * 128 + p; const int t = dir ? nseq - 1 - sp : sp; const size_t r = (size_t)(base + t);
              if (!isctx || ctx_out) {
                  if (dir == 0) {
#pragma unroll
                      for (int e = 0; e < 16; e += 4) *(f32x4*)(HF + r * 256 + h * 64 + 16 * eg + e) = (f32x4){num[e] * inv, num[e + 1] * inv, num[e + 2] * inv, num[e + 3] * inv};
                  } else {
#pragma unroll
                      for (int e = 0; e < 16; e += 4) { const f32x4 hf = *(const f32x4*)(HF + r * 256 + h * 64 + 16 * eg + e); const u32x2 ow = *(const u32x2*)(MO + r * 256 + h * 64 + 16 * eg + e);
                          f32x4 o; o[0] = lo_bf(ow.x) * (hf[0] + num[e] * inv); o[1] = hi_bf(ow.x) * (hf[1] + num[e + 1] * inv); o[2] = lo_bf(ow.y) * (hf[2] + num[e + 2] * inv); o[3] = hi_bf(ow.y) * (hf[3] + num[e + 3] * inv);
                          store4bf(Y + r * 1024 + 256 + h * 64 + 16 * eg + e, o); }
                  }
              }
            }
            __syncthreads();
            { const int d = tid >> 3, e0 = (tid & 7) * 8; const float M127 = Ms[127]; const float decay = __expf(m0 - M127);
              float a[8]; float an = 0.f;
#pragma unroll
              for (int e = 0; e < 8; ++e) a[e] = 0.f;
              for (int s = 0; s < 128; ++s) { const float wk = __expf(gs[s] - M127) * ks[s * 64 + d]; an += wk;
                  const f32x4 v0 = *(const LAS f32x4*)(vs + s * 64 + e0), v1 = *(const LAS f32x4*)(vs + s * 64 + e0 + 4);
                  a[0] += wk * v0[0]; a[1] += wk * v0[1]; a[2] += wk * v0[2]; a[3] += wk * v0[3]; a[4] += wk * v1[0]; a[5] += wk * v1[1]; a[6] += wk * v1[2]; a[7] += wk * v1[3]; }
#pragma unroll
              for (int e = 0; e < 8; ++e) Cs[d * 64 + e0 + e] = decay * Cs[d * 64 + e0 + e] + a[e];
              if ((tid & 7) == 0) ns[d] = decay * ns[d] + an;
              __syncthreads();
              if (tid == 0) mst[0] = cums[127] + M127;
            }
            __syncthreads();
        }
    }
}
__device__ __forceinline__ int swz16(int row16, int byte_in_row) { const int ob = row16 * 64 + byte_in_row; return ob ^ (((ob >> 9) & 1) << 5); }
__device__ __forceinline__ void conv_silu8(const bf16_t* MQK, const float* EDQ, const float* wcv, size_t r, int t, int nseq, int col0, float scale, float (&o)[8]) {
    const int rr = (int)(r & 255);
    if (rr != 0 && rr != 255) {
        const u32x4 x = *(const u32x4*)(MQK + r * 512 + col0);
        o[0] = lo_bf(x.x); o[1] = hi_bf(x.x); o[2] = lo_bf(x.y); o[3] = hi_bf(x.y); o[4] = lo_bf(x.z); o[5] = hi_bf(x.z); o[6] = lo_bf(x.w); o[7] = hi_bf(x.w);
    } else {
        const int pm = (int)(r >> 8), tq = col0 >> 8, cc = col0 & 255; const float* e = EDQ + (size_t)(pm * 2 + tq) * 1024 + cc;
        f32x4 p0 = (f32x4){0.f, 0.f, 0.f, 0.f}, p1 = p0, n0 = p0, n1 = p0, c0v, c1v;
        if (rr == 0) { if (t > 0) { p0 = *(const f32x4*)(e - 2048 + 768); p1 = *(const f32x4*)(e - 2048 + 768 + 4); } c0v = *(const f32x4*)e; c1v = *(const f32x4*)(e + 4); n0 = *(const f32x4*)(e + 256); n1 = *(const f32x4*)(e + 256 + 4); }
        else { p0 = *(const f32x4*)(e + 512); p1 = *(const f32x4*)(e + 512 + 4); c0v = *(const f32x4*)(e + 768); c1v = *(const f32x4*)(e + 768 + 4); if (t < nseq - 1) { n0 = *(const f32x4*)(e + 2048); n1 = *(const f32x4*)(e + 2048 + 4); } }
        const f32x4 wa0 = *(const f32x4*)(wcv + col0), wa1 = *(const f32x4*)(wcv + col0 + 4), wb0 = *(const f32x4*)(wcv + 512 + col0), wb1 = *(const f32x4*)(wcv + 512 + col0 + 4), wc0 = *(const f32x4*)(wcv + 1024 + col0), wc1 = *(const f32x4*)(wcv + 1024 + col0 + 4);
#pragma unroll
        for (int i = 0; i < 4; ++i) { o[i] = siluf_(wa0[i] * p0[i] + wb0[i] * c0v[i] + wc0[i] * n0[i]) * scale; o[4 + i] = siluf_(wa1[i] * p1[i] + wb1[i] * c1v[i] + wc1[i] * n1[i]) * scale; }
    }
}
__device__ __forceinline__ void mlstm_gate_load(int tid, const float* MG, size_t r0, int h, float (&gv)[4]) {
    gv[0] = gv[1] = gv[2] = gv[3] = 0.f;
    if (tid < 128) { const int dir = tid >> 6, l = tid & 63; const int t0 = dir ? 127 - 2 * l : 2 * l, t1 = dir ? 126 - 2 * l : 2 * l + 1;
        gv[0] = MG[(r0 + t0) * 16 + 8 * dir + h]; gv[1] = MG[(r0 + t1) * 16 + 8 * dir + h]; gv[2] = MG[(r0 + t0) * 16 + 8 * dir + 4 + h]; gv[3] = MG[(r0 + t1) * 16 + 8 * dir + 4 + h]; }
}
__device__ __forceinline__ void mlstm_gate_scan(int tid, const float (&gv)[4], const float* bgate, int h, LAS float* gF, LAS float* gB, LAS float* cF, LAS float* cB, LAS float* pF, LAS float* pB) {
    if (tid < 128) {
        const int dir = tid >> 6, l = tid & 63; const int t0 = dir ? 127 - 2 * l : 2 * l, t1 = dir ? 126 - 2 * l : 2 * l + 1;
        const float bi = bgate[8 * dir + h], bfg = bgate[8 * dir + 4 + h];
        const float li0 = gv[0] + bi, li1 = gv[1] + bi; const float lf0 = logsigmoidf_(gv[2] + bfg), lf1 = logsigmoidf_(gv[3] + bfg);
        float sc = lf0 + lf1;
#pragma unroll
        for (int d = 1; d < 64; d <<= 1) { const float t = __shfl_up(sc, d); if (l >= d) sc += t; }
        const float c1 = sc, c0 = sc - lf1; const float g0 = li0 - c0, g1 = li1 - c1;
        float mx = fmaxf(g0, g1);
#pragma unroll
        for (int d = 1; d < 64; d <<= 1) { const float t = __shfl_up(mx, d); if (l >= d) mx = fmaxf(mx, t); }
        float mprev = __shfl_up(mx, 1); if (l == 0) mprev = -INFINITY;
        const float p0 = fmaxf(mprev, g0), p1 = mx;
        LAS float* g = dir ? gB : gF; LAS float* c = dir ? cB : cF; LAS float* p = dir ? pB : pF;
        g[t0] = g0; g[t1] = g1; c[t0] = c0; c[t1] = c1; p[t0] = p0; p[t1] = p1;
    }
    __syncthreads();
}
__device__ __forceinline__ void mlstm_passA_unit(const Frame& F, int l, int b, int h, int jj) {
    const bf16_t* MQK = WSP(bf16_t, WS_MQK); const bf16_t* MV = WSP(bf16_t, WS_MV); const float* MG = WSP(float, WS_MG);
    const float* wcv = inp(15) + (size_t)l * 3 * 512; const float* bgate = inp(16) + (size_t)l * 16;
    const bool isctx = jj < 2; const int nseq = isctx ? CTX : SEQ; const int c = isctx ? jj : jj - 2; const size_t r0 = (size_t)(isctx ? RL + b * CTX : b * SEQ) + 128 * c;
    LAS unsigned char* Vt = F.lds;
    LAS unsigned char* Kw = F.lds + 16384;
    LAS float* gF = (LAS float*)(F.lds + 49152); LAS float* gB = gF + 128; LAS float* cF = gB + 128; LAS float* cB = cF + 128; LAS float* pF = cB + 128; LAS float* pB = pF + 128;
    const int tid = F.tid;
    float gv[4]; mlstm_gate_load(tid, MG, r0, h, gv);
    const int sx = tid >> 2, part = tid & 3; const size_t r = r0 + sx; const int t = 128 * c + sx;
    float kv[2][8]; u32x4 vv2[2];
#pragma unroll
    for (int hh = 0; hh < 2; ++hh) { const int d0 = 16 * part + 8 * hh; conv_silu8(MQK, WSP(float, WS_EDQ), wcv, r, t, nseq, 256 + h * 64 + d0, 0.125f, kv[hh]); vv2[hh] = *(const u32x4*)(MV + r * 256 + h * 64 + d0); }
    __syncthreads();
    mlstm_gate_scan(tid, gv, bgate, h, gF, gB, cF, cB, pF, pB);
    const float pmF = pF[127], pmB = pB[0];
    { const float wF = fexp(gF[sx] - pmF), wB = fexp(gB[sx] - pmB);
#pragma unroll
      for (int hh = 0; hh < 2; ++hh) { const int d0 = 16 * part + 8 * hh;
#pragma unroll
          for (int i = 0; i < 8; ++i) { const int d = d0 + i; const int off = ((d >> 4) * 4 + (sx >> 5)) * 1024 + swz16(d & 15, (sx & 31) * 2);
              *(LAS bf16_t*)(Kw + off) = (bf16_t)f2bf(kv[hh][i] * wF); *(LAS bf16_t*)(Kw + 16384 + off) = (bf16_t)f2bf(kv[hh][i] * wB); }
          const unsigned vw[4] = {vv2[hh].x, vv2[hh].y, vv2[hh].z, vv2[hh].w};
#pragma unroll
          for (int i = 0; i < 8; ++i) { const int e = d0 + i; const int off = ((e >> 4) * 4 + (sx >> 5)) * 1024 + swz16(e & 15, (sx & 31) * 2);
              *(LAS bf16_t*)(Vt + off) = (bf16_t)((i & 1) ? (vw[i >> 1] >> 16) : (vw[i >> 1] & 0xffffu)); } } }
    __syncthreads();
    const int dir = F.wave >> 2, et = F.wave & 3, quad = F.lane >> 4, l15 = F.lane & 15; const int kfo = swz16(l15, quad * 16);
    const int chain = (b * 4 + h) * 2 + dir; const int j = dir == 0 ? jj : (isctx ? 1 - c : 17 - c);
    f32x4 acc[4];
#pragma unroll
    for (int dt = 0; dt < 4; ++dt) acc[dt] = (f32x4){0.f, 0.f, 0.f, 0.f};
#pragma unroll
    for (int ks = 0; ks < 4; ++ks) { const bf16x8 af = *(const LAS bf16x8*)(Vt + (et * 4 + ks) * 1024 + kfo);
#pragma unroll
        for (int dt = 0; dt < 4; ++dt) { const bf16x8 bf = *(const LAS bf16x8*)(Kw + dir * 16384 + (dt * 4 + ks) * 1024 + kfo); acc[dt] = __builtin_amdgcn_mfma_f32_16x16x32_bf16(af, bf, acc[dt], 0, 0, 0); } }
    bf16_t* KVL = WSP(bf16_t, WS_KVL) + ((size_t)chain * 18 + j) * 4096;
#pragma unroll
    for (int dt = 0; dt < 4; ++dt)
#pragma unroll
        for (int i = 0; i < 4; ++i) KVL[(16 * et + 4 * quad + i) * 64 + 16 * dt + l15] = (bf16_t)f2bf(acc[dt][i]);
    if (tid < 128) { const int dr = tid >> 6, d = tid & 63; float sacc = 0.f;
        for (int sx = 0; sx < 128; ++sx) sacc += bf2f(*(const LAS bf16_t*)(Kw + dr * 16384 + ((d >> 4) * 4 + (sx >> 5)) * 1024 + swz16(d & 15, (sx & 31) * 2)));
        const int ch2 = (b * 4 + h) * 2 + dr; const int j2 = dr == 0 ? jj : (isctx ? 1 - c : 17 - c);
        WSP(float, WS_NL)[((size_t)ch2 * 18 + j2) * 64 + d] = sacc;
        if (d == 0) { float* scl = WSP(float, WS_SCL) + ((size_t)ch2 * 18 + j2) * 2; scl[0] = dr == 0 ? cF[127] : cB[0]; scl[1] = dr == 0 ? pmF : pmB; } }
}
__device__ __forceinline__ void mlstm_passB_unit(const Frame& F, int chain, int half) {
    const bf16_t* KVL = WSP(bf16_t, WS_KVL) + (size_t)chain * 18 * 4096; bf16_t* CT = WSP(bf16_t, WS_CT) + (size_t)chain * 18 * 4096;
    const float* NL = WSP(float, WS_NL) + (size_t)chain * 18 * 64; float* NS = WSP(float, WS_NS) + (size_t)chain * 18 * 64; const float* SCL = WSP(float, WS_SCL) + (size_t)chain * 18 * 2; float* MS = WSP(float, WS_MS) + (size_t)chain * 18;
    const int idx = half * 2048 + F.tid * 4; const bool nthr = half == 0 && F.tid < 64;
    f32x4 C = (f32x4){0.f, 0.f, 0.f, 0.f}; float nst = 0.f, mst = 0.f;
    u32x2 kv[18]; float nl[18]; f32x2 sc[18];
#pragma unroll
    for (int j = 0; j < 18; ++j) { kv[j] = *(const u32x2*)(KVL + (size_t)j * 4096 + idx); nl[j] = nthr ? NL[j * 64 + F.tid] : 0.f; sc[j] = *(const f32x2*)(SCL + j * 2); }
#pragma unroll
    for (int j = 0; j < 18; ++j) {
        u32x2 cw; cw.x = cvt_pk_bf16(C[0], C[1]); cw.y = cvt_pk_bf16(C[2], C[3]); *(u32x2*)(CT + (size_t)j * 4096 + idx) = cw;
        if (nthr) NS[j * 64 + F.tid] = nst;
        if (half == 0 && F.tid == 0) MS[j] = mst;
        const float Mx = fmaxf(mst, sc[j][1]), decay = fexp(mst - Mx), sl = fexp(sc[j][1] - Mx);
        C[0] = decay * C[0] + sl * lo_bf(kv[j].x); C[1] = decay * C[1] + sl * hi_bf(kv[j].x); C[2] = decay * C[2] + sl * lo_bf(kv[j].y); C[3] = decay * C[3] + sl * hi_bf(kv[j].y);
        nst = decay * nst + sl * nl[j]; mst = sc[j][0] + Mx;
    }
}
__device__ __forceinline__ void mlstm_passC_unit(const Frame& F, int l, int b, int h, int jj) {
    const bf16_t* MQK = WSP(bf16_t, WS_MQK); const bf16_t* MV = WSP(bf16_t, WS_MV); const bf16_t* MO = WSP(bf16_t, WS_MO); const float* MG = WSP(float, WS_MG); bf16_t* Y = WSP(bf16_t, WS_Y);
    const float* wcv = inp(15) + (size_t)l * 3 * 512; const float* bgate = inp(16) + (size_t)l * 16;
    const bool isctx = jj < 2; const int nseq = isctx ? CTX : SEQ; const int c = isctx ? jj : jj - 2; const size_t r0 = (size_t)(isctx ? RL + b * CTX : b * SEQ) + 128 * c;
    const int chF = (b * 4 + h) * 2, chB = chF + 1; const int jF = jj, jB = isctx ? 1 - c : 17 - c;
    LAS unsigned char* Qs = F.lds;
    LAS unsigned char* Ks = F.lds + 16384;
    LAS unsigned char* Vt = F.lds + 32768;
    LAS unsigned char* CF = F.lds + 50176;
    LAS unsigned char* CB = F.lds + 58368;
    LAS float* gF = (LAS float*)(F.lds + 66560); LAS float* gB = gF + 128; LAS float* cF = gB + 128; LAS float* cB = cF + 128; LAS float* pF = cB + 128; LAS float* pB = pF + 128; LAS float* nF = pB + 128; LAS float* nB = nF + 64;
    const int tid = F.tid;
    float gv[4]; mlstm_gate_load(tid, MG, r0, h, gv);
    __syncthreads();
    { const int sx = tid >> 2, cg = tid & 3; const size_t r = r0 + sx; const int t = 128 * c + sx;
      const bool isk = cg >= 2; const int dbase = 32 * (cg & 1); LAS unsigned char* dst = isk ? Ks : Qs;
#pragma unroll
      for (int q4 = 0; q4 < 4; ++q4) { const int d0 = dbase + 8 * q4; float o[8]; conv_silu8(MQK, WSP(float, WS_EDQ), wcv, r, t, nseq, (isk ? 256 : 0) + h * 64 + d0, isk ? 0.125f : 1.f, o);
          u32x4 w; w.x = cvt_pk_bf16(o[0], o[1]); w.y = cvt_pk_bf16(o[2], o[3]); w.z = cvt_pk_bf16(o[4], o[5]); w.w = cvt_pk_bf16(o[6], o[7]);
          *(LAS u32x4*)(dst + ((sx >> 4) * 2 + (d0 >> 5)) * 1024 + swz16(sx & 15, (d0 & 31) * 2)) = w; }
#pragma unroll
      for (int hh = 0; hh < 2; ++hh) { const int e0 = 16 * cg + 8 * hh; const u32x4 vv = *(const u32x4*)(MV + r * 256 + h * 64 + e0); const unsigned vw[4] = {vv.x, vv.y, vv.z, vv.w};
#pragma unroll
          for (int i = 0; i < 8; ++i) *(LAS bf16_t*)(Vt + (e0 + i) * 272 + sx * 2) = (bf16_t)((i & 1) ? (vw[i >> 1] >> 16) : (vw[i >> 1] & 0xffffu)); }
      { const int e = tid >> 3, dc = tid & 7; const int off = ((e >> 4) * 2 + (dc >> 2)) * 1024 + swz16(e & 15, (dc & 3) * 16);
        *(LAS u32x4*)(CF + off) = *(const u32x4*)(WSP(bf16_t, WS_CT) + ((size_t)chF * 18 + jF) * 4096 + e * 64 + dc * 8);
        *(LAS u32x4*)(CB + off) = *(const u32x4*)(WSP(bf16_t, WS_CT) + ((size_t)chB * 18 + jB) * 4096 + e * 64 + dc * 8); }
      if (tid < 64) nF[tid] = WSP(float, WS_NS)[((size_t)chF * 18 + jF) * 64 + tid]; else if (tid < 128) nB[tid - 64] = WSP(float, WS_NS)[((size_t)chB * 18 + jB) * 64 + tid - 64];
    }
    const float mF = WSP(float, WS_MS)[chF * 18 + jF], mB = WSP(float, WS_MS)[chB * 18 + jB];
    mlstm_gate_scan(tid, gv, bgate, h, gF, gB, cF, cB, pF, pB);
    const int w = F.wave, quad = F.lane >> 4, l15 = F.lane & 15; const int kfo = swz16(l15, quad * 16); const int p = 16 * w + l15;
    u32x2 mo[4];
#pragma unroll
    for (int et = 0; et < 4; ++et) mo[et] = *(const u32x2*)(MO + (r0 + p) * 256 + h * 64 + 16 * et + 4 * quad);
    bf16x8 Qf[2];
#pragma unroll
    for (int sx = 0; sx < 2; ++sx) Qf[sx] = *(const LAS bf16x8*)(Qs + (w * 2 + sx) * 1024 + kfo);
    f32x4 S[8];
#pragma unroll
    for (int st = 0; st < 8; ++st) { S[st] = (f32x4){0.f, 0.f, 0.f, 0.f};
#pragma unroll
        for (int sx = 0; sx < 2; ++sx) { const bf16x8 kf = *(const LAS bf16x8*)(Ks + (st * 2 + sx) * 1024 + kfo); S[st] = __builtin_amdgcn_mfma_f32_16x16x32_bf16(kf, Qf[sx], S[st], 0, 0, 0); } }
    const float MFp = fmaxf(mF, pF[p]), MBp = fmaxf(mB, pB[p]);
    __builtin_amdgcn_sched_barrier(0);
    float sF = 0.f, sB = 0.f;
#pragma unroll
    for (int st = 0; st < 8; ++st) { const f32x4 g4 = *(const LAS f32x4*)(gF + 16 * st + 4 * quad), h4 = *(const LAS f32x4*)(gB + 16 * st + 4 * quad);
#pragma unroll
        for (int i = 0; i < 4; ++i) { const int sx = 16 * st + 4 * quad + i;
            float eF = fexp(g4[i] - MFp), eB = fexp(h4[i] - MBp); eF = sx <= p ? eF : 0.f; eB = sx >= p ? eB : 0.f;
            sF += S[st][i] * eF; sB += S[st][i] * eB; } }
    __builtin_amdgcn_sched_barrier(0);
    sF += __shfl_xor(sF, 16); sF += __shfl_xor(sF, 32); sB += __shfl_xor(sB, 16); sB += __shfl_xor(sB, 32);
    float qnF = 0.f, qnB = 0.f; float qv[2][8];
#pragma unroll
    for (int sx = 0; sx < 2; ++sx) { const u32x4 qw = __builtin_bit_cast(u32x4, Qf[sx]); const unsigned qq[4] = {qw.x, qw.y, qw.z, qw.w};
        const f32x4 nf0 = *(const LAS f32x4*)(nF + 32 * sx + 8 * quad), nf1 = *(const LAS f32x4*)(nF + 32 * sx + 8 * quad + 4), nb0 = *(const LAS f32x4*)(nB + 32 * sx + 8 * quad), nb1 = *(const LAS f32x4*)(nB + 32 * sx + 8 * quad + 4);
#pragma unroll
        for (int i = 0; i < 8; ++i) { const float qf = (i & 1) ? hi_bf(qq[i >> 1]) : lo_bf(qq[i >> 1]); qv[sx][i] = qf; qnF += qf * (i < 4 ? nf0[i & 3] : nf1[i & 3]); qnB += qf * (i < 4 ? nb0[i & 3] : nb1[i & 3]); } }
    qnF += __shfl_xor(qnF, 16); qnF += __shfl_xor(qnF, 32); qnB += __shfl_xor(qnB, 16); qnB += __shfl_xor(qnB, 32);
    const float wiF = fexp(mF - MFp), wiB = fexp(mB - MBp);
    const float rF = frcp(fmaxf(fabsf(sF + wiF * qnF), fexp(-(cF[p] + MFp)))), rB = frcp(fmaxf(fabsf(sB + wiB * qnB), fexp(-(cB[p] + MBp))));
    const float qsF = wiF * rF, qsB = wiB * rB;
    __builtin_amdgcn_sched_barrier(0);
    f32x4 O[4];
#pragma unroll
    for (int et = 0; et < 4; ++et) O[et] = (f32x4){0.f, 0.f, 0.f, 0.f};
#pragma unroll
    for (int sx = 0; sx < 2; ++sx) { u32x4 a, bq;
        a.x = cvt_pk_bf16(qv[sx][0] * qsF, qv[sx][1] * qsF); a.y = cvt_pk_bf16(qv[sx][2] * qsF, qv[sx][3] * qsF); a.z = cvt_pk_bf16(qv[sx][4] * qsF, qv[sx][5] * qsF); a.w = cvt_pk_bf16(qv[sx][6] * qsF, qv[sx][7] * qsF);
        bq.x = cvt_pk_bf16(qv[sx][0] * qsB, qv[sx][1] * qsB); bq.y = cvt_pk_bf16(qv[sx][2] * qsB, qv[sx][3] * qsB); bq.z = cvt_pk_bf16(qv[sx][4] * qsB, qv[sx][5] * qsB); bq.w = cvt_pk_bf16(qv[sx][6] * qsB, qv[sx][7] * qsB);
        const bf16x8 qF8 = __builtin_bit_cast(bf16x8, a), qB8 = __builtin_bit_cast(bf16x8, bq);
#pragma unroll
        for (int et = 0; et < 4; ++et) { const bf16x8 cf = *(const LAS bf16x8*)(CF + (et * 2 + sx) * 1024 + kfo), cb = *(const LAS bf16x8*)(CB + (et * 2 + sx) * 1024 + kfo);
            O[et] = __builtin_amdgcn_mfma_f32_16x16x32_bf16(cf, qF8, O[et], 0, 0, 0); O[et] = __builtin_amdgcn_mfma_f32_16x16x32_bf16(cb, qB8, O[et], 0, 0, 0); } }
    __builtin_amdgcn_sched_barrier(0);
#pragma unroll
    for (int ks = 0; ks < 4; ++ks) { __builtin_amdgcn_sched_barrier(0); u32x4 pw; float pv[8];
#pragma unroll
        for (int hh = 0; hh < 2; ++hh) { const int st = 2 * ks + hh; const f32x4 g4 = *(const LAS f32x4*)(gF + 16 * st + 4 * quad), h4 = *(const LAS f32x4*)(gB + 16 * st + 4 * quad);
#pragma unroll
            for (int i = 0; i < 4; ++i) { const int sx = 16 * st + 4 * quad + i;
                float eF = fexp(g4[i] - MFp) * rF, eB = fexp(h4[i] - MBp) * rB; eF = sx <= p ? eF : 0.f; eB = sx >= p ? eB : 0.f; pv[4 * hh + i] = S[st][i] * (eF + eB); } }
        pw.x = cvt_pk_bf16(pv[0], pv[1]); pw.y = cvt_pk_bf16(pv[2], pv[3]); pw.z = cvt_pk_bf16(pv[4], pv[5]); pw.w = cvt_pk_bf16(pv[6], pv[7]);
        const bf16x8 pf = __builtin_bit_cast(bf16x8, pw);
#pragma unroll
        for (int et = 0; et < 4; ++et) { const LAS unsigned char* vp = Vt + (16 * et + l15) * 272 + ks * 64 + quad * 8; const u32x2 v0 = *(const LAS u32x2*)vp, v1 = *(const LAS u32x2*)(vp + 32);
            const u32x4 vv = (u32x4){v0.x, v0.y, v1.x, v1.y}; O[et] = __builtin_amdgcn_mfma_f32_16x16x32_bf16(__builtin_bit_cast(bf16x8, vv), pf, O[et], 0, 0, 0); } }
    { const size_t r = r0 + p;
#pragma unroll
      for (int et = 0; et < 4; ++et) { const int e = 16 * et + 4 * quad; const u32x2 ow = mo[et];
          f32x4 o; o[0] = lo_bf(ow.x) * O[et][0]; o[1] = hi_bf(ow.x) * O[et][1]; o[2] = lo_bf(ow.y) * O[et][2]; o[3] = hi_bf(ow.y) * O[et][3];
          store4bf(Y + r * 1024 + 256 + h * 64 + e, o); } }
}
__device__ __forceinline__ void phase_mlstm_A(const Frame& F, int l, int rot) { for (int u = rotc(F, rot); u < 64 * 18; u += F.G) mlstm_passA_unit(F, l, u / 72, (u / 18) & 3, u % 18); }
__device__ __forceinline__ void phase_mlstm_B(const Frame& F, int rot) { for (int u = rotc(F, rot); u < 256; u += F.G) mlstm_passB_unit(F, u >> 1, u & 1); }
__device__ __forceinline__ void phase_mlstm_C(const Frame& F, int l, bool ctx_out, int rot) {
    const int per = ctx_out ? 18 : 16, j0 = ctx_out ? 0 : 2;
    for (int u = rotc(F, rot); u < 64 * per; u += F.G) mlstm_passC_unit(F, l, u / (4 * per), (u / per) & 3, j0 + u % per);
}
__device__ __forceinline__ void phase_fold(const Frame& F, int rot) { for (int u = rotc(F, rot); u < 128; u += F.G) fold_unit(F, u >> 3, (u >> 1) & 3, u & 1); }
__device__ __forceinline__ int queue_next(const Frame& F, unsigned* head) {
    volatile LAS unsigned* MISC = (volatile LAS unsigned*)(F.lds + MISC_OFF);
    __syncthreads();
    if (F.tid == 0) MISC[16] = __hip_atomic_fetch_add(head, 1u, __ATOMIC_RELAXED, __HIP_MEMORY_SCOPE_AGENT);
    __syncthreads();
    return (int)MISC[16];
}
__device__ __forceinline__ void phase_fold_A_queue(const Frame& F, int l) {
    unsigned* head = (unsigned*)(F.ws + WS_CTL) + CW_QUEUE + 64 * (2 * l);
    for (;;) { const int u = queue_next(F, head); if (u >= 128 + 64 * 18) break;
        if (u < 128) fold_unit(F, u >> 3, (u >> 1) & 3, u & 1);
        else { const int v = u - 128; mlstm_passA_unit(F, l, v / 72, (v / 18) & 3, v % 18); } }
}
__device__ __forceinline__ void phase_mla(const Frame& F, bool ctx_out) {
    const int nm = 512 + (ctx_out ? 64 : 0);
    for (int q = F.vcu; q < nm; q += F.G) { const bool cq = q >= 512; const int qq = q - 512;
        mla_unit(F, cq ? qq >> 2 : q >> 5, cq ? qq & 3 : (q >> 3) & 3, cq ? 0 : (q & 7) * 256, cq); }
}
__device__ __forceinline__ void phase_gqa(const Frame& F, int l, bool ctx_out) {
    const int nm = 512 + (ctx_out ? 64 : 0);
    if (true) {
        unsigned* head = (unsigned*)(F.ws + WS_CTL) + CW_QUEUE + 64 * (2 * l + 1);
        for (;;) { const int q = queue_next(F, head); if (q >= nm) break; const bool cq = q >= 512; const int qq = q - 512;
            gqa_unit(F, l, cq ? qq >> 2 : q >> 5, cq ? (qq >> 1) & 1 : (q >> 4) & 1, cq ? (qq & 1) * 128 : (q & 15) * 128, cq); }
    } else if (F.G == 256) {
        const int v = F.vcu; int q0, qs, nq;
        if (v < 128) { q0 = v; qs = 128; nq = 3; } else { q0 = 384 + (v - 128); qs = 128; nq = (q0 + 128 < nm) ? 2 : 1; }
        for (int i = 0; i < nq; ++i) { const int q = q0 + i * qs; const bool cq = q >= 512; const int qq = q - 512;
            gqa_unit(F, l, cq ? qq >> 2 : q >> 5, cq ? (qq >> 1) & 1 : (q >> 4) & 1, cq ? (qq & 1) * 128 : (q & 15) * 128, cq); }
    } else {
        for (int q = F.vcu; q < nm; q += F.G) { const bool cq = q >= 512; const int qq = q - 512;
            gqa_unit(F, l, cq ? qq >> 2 : q >> 5, cq ? (qq >> 1) & 1 : (q >> 4) & 1, cq ? (qq & 1) * 128 : (q & 15) * 128, cq); }
    }
}

struct Params { const float* in[26]; float* out; unsigned char* ws; int ph_lo, ph_hi, li, pad; };

__global__ void __launch_bounds__(NTHR, 2) mk_fwd(Params P) {
    extern __shared__ __attribute__((aligned(16))) unsigned char lds_raw[];
    volatile LAS unsigned* MISC = (volatile LAS unsigned*)((LAS unsigned char*)lds_raw + MISC_OFF);
    if (threadIdx.x < 64) MISC[threadIdx.x] = 0u;
    __syncthreads();
    XcdBarrier bar = xcd_barrier_post((unsigned*)(P.ws + WS_CTL) + CW_BAR + P.li * XCD_BAR_WORDS, MISC + 8);
    const int lo = P.ph_lo, hi = P.ph_hi; int ph = 0;
#define MAKE_FRAME Frame F; { int t_ = threadIdx.x, b_ = blockIdx.x; asm volatile("" : "+v"(t_)); asm volatile("" : "+s"(b_)); F.lds = (LAS unsigned char*)lds_raw; F.tid = t_; F.lane = t_ & 63; \
        F.wave = __builtin_amdgcn_readfirstlane(t_ >> 6); F.G = gridDim.x; F.vcu = (F.G % 8 == 0) ? (b_ % 8) * (F.G / 8) + b_ / 8 : b_; F.xl = P.out; F.ws = P.ws; }
#ifndef SITE_MASK
#define SITE_MASK 0x1FFFFFF
#endif
#ifndef REP_MASK
#define REP_MASK 0
#endif
#define SITE(k) if (SITE_MASK & (1 << (k))) for (int rep_ = 0; rep_ <= ((REP_MASK >> (k)) & 1); ++rep_)
#define PHASE_BEGIN if (ph >= lo && ph < hi) {
#define PHASE_END   if (ph + 1 < hi) xcd_barrier(bar); } ++ph;

    PHASE_BEGIN SITE(0) { MAKE_FRAME
        mod_gemv(F);
        __syncthreads();
        convert_layer_weights(F, 0, F.vcu, F.G, F.G == 256 ? 1 : 15);
        build_cs2(F, WSP(bf16_t, WS_CS));
        build_cs(F, WSP(bf16_t, WS_CSC), CTX);
        build_tables(F);
    } PHASE_END
    PHASE_BEGIN SITE(1) { MAKE_FRAME
        phase_norm1_in(F);
        if (win8(0)) { __syncthreads();
        quant_rows_i8(F, WSP(float, WS_FTMP), F.ws + WS_W + W_IN + (size_t)2048 * 1024, WSP(float, WS_WSCW) + 2048, 256, F.vcu, F.G); }
    } PHASE_END

    for (int l = 0; l < DEPTH; ++l) {
        const bool ctx_out = l < DEPTH - 1;
        const unsigned char* wl = P.ws + WS_W + (size_t)l * W_LAYER;
        const int mrows = ctx_out ? R : RL;
        const int mtiles = ctx_out ? TR : TL;

        PHASE_BEGIN SITE(2) { MAKE_FRAME
            if (!win8(l)) {
                SchedWin S{ctx_out ? TR : TL, ctx_out ? 0 : TC, 5, F.G, F.vcu, (const char*)WSP(unsigned char, WS_H), (const char*)(wl + W_IN), 2048};
                EpiWin E{F.ws, l};
                pg8::gemm_phase(F.lds, 1024, 1024, 1024, S, E); }
        }
        SITE(24) { MAKE_FRAME
            if (win8(l)) {
                SchedWin S{ctx_out ? TR : TL, ctx_out ? 0 : TC, 5, F.G, F.vcu, (const char*)WSP(unsigned char, WS_H), (const char*)(wl + W_IN), 1024};
                EpiWin E{F.ws, l};
                pg8::gemm_phase<EpiWin, SchedWin, 1>(F.lds, 512, 512, 512, S, E, WSP(float, WS_HS), WSP(float, WS_WSCW) + l * 2560); }
        }
        SITE(21) { MAKE_FRAME
            if (l == 0 && F.G == 256 && F.vcu >= 160) { __syncthreads(); convert_layer_weights(F, 0, F.vcu - 160, 96, 2); }
        } PHASE_END

        PHASE_BEGIN
          SITE(3) { MAKE_FRAME
            { SchedMN S{0, ctx_out ? TR : TL, 2, F.G, rotc(F, 192)  , (const char*)WSP(bf16_t, WS_CQ), (const char*)(wl + W_UQ), (size_t)256 * 256 * 2, (size_t)256 * 256 * 2, 0};
              EpiUq E{F.ws};
              pg8::gemm_phase(F.lds, 256, 256, 256, S, E); }
            { SchedMN S{0, TR, 2, F.G, rotc(F, 160)  , (const char*)WSP(bf16_t, WS_CKV), (const char*)(wl + W_UKV), (size_t)256 * 256 * 2, (size_t)256 * 256 * 2, 0};
              EpiUkv E{F.ws};
              pg8::gemm_phase(F.lds, 256, 256, 256, S, E); }
            if (ctx_out) phase_fab_transpose(F, RL, CTX, NB, WSP(bf16_t, WS_FABT + 32 * MiB));
          }
          SITE(19) { MAKE_FRAME
          }
          SITE(4) { MAKE_FRAME
            phase_fold_A_queue(F, l);
          }
        PHASE_END

        PHASE_BEGIN
          SITE(17) { MAKE_FRAME
            phase_mlstm_B(F, 0);
          }
          SITE(14) { MAKE_FRAME
            __syncthreads();
            SchedDft2 S{F.G, rotc(F, 128), (const char*)WSP(bf16_t, WS_CS), (const char*)WSP(bf16_t, WS_FABT)};
            EpiDft2 E{F.ws};
            pg8::gemm_phase(F.lds, 2048, 2048, 2048, S, E);
          }
          SITE(13) { MAKE_FRAME
            if (ctx_out) { __syncthreads(); SchedDft S{NB, 1, F.G, rotc(F, 192), (const char*)WSP(bf16_t, WS_CSC), (const char*)WSP(bf16_t, WS_FABT + 32 * MiB), (size_t)256 * 512 * 2, (size_t)256 * 512 * 2};
              EpiDft E{F.ws, RL, CTX, 0.0078125f};
              pg8::gemm_phase(F.lds, 512, 512, 512, S, E); }
          }
          SITE(16) { MAKE_FRAME
            __syncthreads();
            phase_gqa(F, l, ctx_out);
          }
        PHASE_END

        PHASE_BEGIN
          SITE(18) { MAKE_FRAME
            phase_mlstm_C(F, l, ctx_out, 128);
          }
          SITE(15) { MAKE_FRAME
            __syncthreads();
            phase_mla(F, ctx_out);
          }
        PHASE_END

        { const int nch = ctx_out ? 3 : 2, cht = ctx_out ? 48 : 64;
          for (int ch = 0; ch < nch; ++ch) {
            PHASE_BEGIN SITE(5) { MAKE_FRAME
                SchedBranch S{ch * cht, cht, F.G, F.vcu, (const char*)WSP(bf16_t, WS_Y), (const char*)(wl + W_B)};
                EpiBranch E{F.ws, ch * cht * 256, cht * 256};
                pg8::gemm_phase(F.lds, 256, 1024, 256, S, E);
            } PHASE_END
            PHASE_BEGIN SITE(6) { MAKE_FRAME
                SchedMN S{ch * cht, cht, 16, F.G, F.vcu, (const char*)(F.ws + (win8(l) ? WS_H : (l == 0 ? WS_H8A : WS_H8B))), (const char*)(wl + W_G), (size_t)256 * 1024, (size_t)256 * 1024, 0};
                EpiGate E{F.ws, inp(19) + (size_t)l * 4 * 1024, ch * cht * 256, cht * 256, WSP(float, WS_HS), WSP(float, WS_WSCG) + l * 4096};
                pg8::gemm_phase<EpiGate, SchedMN, 1>(F.lds, 512, 512, 512, S, E, WSP(float, WS_HS), WSP(float, WS_WSCG) + l * 4096);
            } PHASE_END
          } }

        PHASE_BEGIN SITE(7) { MAKE_FRAME
            SchedMN S{0, mtiles, 4, F.G, F.vcu, (const char*)WSP(bf16_t, WS_ACC), (const char*)(wl + W_OUT), (size_t)256 * 1024 * 2, (size_t)256 * 1024 * 2, 0};
            EpiPlain E{WSP(bf16_t, WS_YO), 1024, 0};
            pg8::gemm_phase(F.lds, 1024, 1024, 1024, S, E);
        }
        SITE(22) { MAKE_FRAME
            if (l == 0 && F.G == 256 && F.vcu >= 64) { __syncthreads(); convert_layer_weights(F, 0, F.vcu - 64, 192, 12); }
        } PHASE_END

        PHASE_BEGIN SITE(8) { MAKE_FRAME
            phase_post(F, l, WSP(bf16_t, WS_YO), mrows, false, l == 0);
        } PHASE_END

        PHASE_BEGIN SITE(9) { MAKE_FRAME
            SchedMN S{0, mtiles, 22, F.G, F.vcu, (const char*)WSP(unsigned char, WS_H2), (const char*)(wl + W_UP), (size_t)256 * 1024, (size_t)256 * 1024, 0};
            EpiUpConv E{F.ws, inp(23) + (size_t)l * 3 * DFF, inp(24) + (size_t)l * DFF};
            pg8::gemm_phase<EpiUpConv, SchedMN, 1>(F.lds, 512, 512, 512, S, E, WSP(float, WS_H2S), WSP(float, WS_WSCU) + l * 5632);
        } PHASE_END
        PHASE_BEGIN SITE(10) { MAKE_FRAME
            phase_conv_fixup(F, l, 0, mtiles);
        } PHASE_END

        PHASE_BEGIN SITE(11) { MAKE_FRAME
            SchedMN S{0, mtiles, 4, F.G, F.vcu, (const char*)WSP(bf16_t, WS_G), (const char*)(wl + W_DOWN), (size_t)256 * 2816 * 2, (size_t)256 * 2816 * 2, 0};
            EpiPlain E{WSP(bf16_t, WS_F), 1024, 0};
            pg8::gemm_phase(F.lds, 2816, 2816, 2816, S, E);
        }
        SITE(20) { MAKE_FRAME
            if (l + 1 < DEPTH && F.G == 256 && F.vcu >= 64) { __syncthreads(); convert_layer_weights(F, l + 1, F.vcu - 64, F.G - 64, 15); }
            else if (l + 1 < DEPTH && F.G != 256) { __syncthreads(); convert_layer_weights(F, l + 1, F.vcu, F.G, 15); }
        } PHASE_END

        PHASE_BEGIN SITE(12) { MAKE_FRAME
            phase_post(F, l, WSP(bf16_t, WS_F), mrows, true, false);
            if (l + 1 < DEPTH && win8(l + 1)) { __syncthreads(); quant_rows_i8(F, WSP(float, WS_FTMP) + (size_t)(l + 1) * 256 * 1024, F.ws + WS_W + (size_t)(l + 1) * W_LAYER + W_IN + (size_t)2048 * 1024, WSP(float, WS_WSCW) + (l + 1) * 2560 + 2048, 256, F.vcu, F.G); }
        } PHASE_END
    }
#undef PHASE_BEGIN
#undef PHASE_END
}

constexpr int N_PHASES = 32;

extern "C" void kernel_launch(void* const* d_in, const int* in_sizes, int n_in, void* d_out, int out_size, void* d_ws, size_t ws_size, hipStream_t stream) {
    static int grid = 0;
    if (grid == 0) {
        if (n_in != 26 || out_size != RL * D || ws_size < WS_END) { fprintf(stderr, "kernel_launch: unexpected problem (n_in %d out %d ws %zu need %zu)\n", n_in, out_size, ws_size, (size_t)WS_END); grid = -1; return; }
        int dev = 0, cus = 0;
        if (hipGetDevice(&dev) != hipSuccess || hipDeviceGetAttribute(&cus, hipDeviceAttributeMultiprocessorCount, dev) != hipSuccess) { grid = -1; return; }
        if (hipFuncSetAttribute((const void*)mk_fwd, hipFuncAttributeMaxDynamicSharedMemorySize, LDS_BYTES) != hipSuccess) { fprintf(stderr, "kernel_launch: hipFuncSetAttribute failed\n"); grid = -1; return; }
        int per_cu = 0;
        if (hipOccupancyMaxActiveBlocksPerMultiprocessor(&per_cu, (const void*)mk_fwd, NTHR, LDS_BYTES) != hipSuccess || per_cu < 1) { fprintf(stderr, "kernel_launch: occupancy query says %d\n", per_cu); (void)hipGetLastError(); grid = -1; return; }
        grid = cus;
    }
    if (grid < 0) return;
    (void)hipMemsetAsync((char*)d_ws + WS_CTL, 0, CTL_BYTES, stream);
    Params p{};
    for (int i = 0; i < 26; ++i) p.in[i] = (const float*)d_in[i];
    p.out = (float*)d_out; p.ws = (unsigned char*)d_ws; p.pad = 0;
#if MK_SINGLE_LAUNCH
    p.ph_lo = 0; p.ph_hi = N_PHASES; p.li = 0;
    hipLaunchKernelGGL(mk_fwd, dim3(grid), dim3(NTHR), LDS_BYTES, stream, p);
#else
    {
        int sites[N_PHASES]; int n = 0; sites[n++] = 0; sites[n++] = 1;
        for (int l = 0; l < DEPTH; ++l) { const bool co = l < DEPTH - 1; const int seq1[4] = {2, 3, 17, 18};
            for (int i = 0; i < 4; ++i) sites[n++] = seq1[i];
            for (int ch = 0; ch < (co ? 3 : 2); ++ch) { sites[n++] = 5; sites[n++] = 6; }
            sites[n++] = 7; sites[n++] = 8; sites[n++] = 9; sites[n++] = 10; sites[n++] = 11; sites[n++] = 12; }
        for (int i = 0; i < N_PHASES; ++i) { p.ph_lo = i; p.ph_hi = i + 1; p.li = i;
            const int reps = ((PROBE_DUP_SITES >> sites[i]) & 1) ? 2 : 1;
            for (int r = 0; r < reps; ++r) hipLaunchKernelGGL(mk_fwd, dim3(grid), dim3(NTHR), LDS_BYTES, stream, p); }
    }
#endif
}
```
